# Optimizing an MI355X kernel written in HIP

```python
import math
import jax, jax.numpy as jnp
from jax import lax
import numpy as np

D_MODEL = 1024
BATCH = 16
SEQ = 4096
DEPTH = 4
DEC_BATCH = 8
DEC_SEQ = 4096
PAST_LEN = 128

HEAD_DIM = 64
A_Q_HEADS = D_MODEL // 128
A_KV_HEADS = A_Q_HEADS // 4
B_GROUPS = ((128, 1), (512, 4), (2048, 16))
B_HEADS_PER_GROUP = D_MODEL // 256
B_HEADS = B_HEADS_PER_GROUP * len(B_GROUPS)
A_WIDTH = A_Q_HEADS * HEAD_DIM
A_KV_WIDTH = A_KV_HEADS * HEAD_DIM
B_QKV_WIDTH = B_HEADS * HEAD_DIM
B_WIDTH = B_HEADS_PER_GROUP * HEAD_DIM
PLE_DIM = 256
GRID_W = 64
ROPE_THETA = 10000.0
Q_BLOCK = 128
EPS = 1e-6
IN_SIZES = (A_WIDTH, A_KV_WIDTH, A_KV_WIDTH, A_WIDTH,
            B_QKV_WIDTH, B_QKV_WIDTH, B_QKV_WIDTH, B_WIDTH,
            D_MODEL, D_MODEL)
IN_WIDTH = sum(IN_SIZES)

kernel_name = "hybrid_axial_gqa_dilated_gated_encoder"


def rmsnorm(x, g):
    xf = x.astype(jnp.float32)
    y = xf * lax.rsqrt(jnp.mean(xf * xf, axis=-1, keepdims=True) + EPS)
    return (y * g.astype(jnp.float32)).astype(x.dtype)


def rope_table(pos, dim):
    freqs = ROPE_THETA ** (-jnp.arange(0, dim, 2, dtype=jnp.float32) / dim)
    ang = pos.astype(jnp.float32)[:, None] * freqs[None, :]
    ang = jnp.concatenate([ang, ang], axis=-1)
    return jnp.cos(ang), jnp.sin(ang)


def apply_rope(x, cos, sin):
    half = x.shape[-1] // 2
    x1, x2 = x[..., :half], x[..., half:]
    rot = jnp.concatenate([-x2, x1], axis=-1)
    y = x * cos[None, :, None, :] + rot * sin[None, :, None, :]
    return y.astype(x.dtype)


def split_points():
    pts, acc = [], 0
    for s in IN_SIZES[:-1]:
        acc += s
        pts.append(acc)
    return pts


def gqa_attention(q, k, v):
    bsz, s_len, hq, dh = q.shape
    hkv = k.shape[2]
    g = hq // hkv
    nblk = s_len // Q_BLOCK
    scale = 1.0 / math.sqrt(dh)
    qb = q.reshape(bsz, nblk, Q_BLOCK, hkv, g, dh).transpose(1, 0, 2, 3, 4, 5)

    def blk(qblk):
        s = jnp.einsum('bqkgd,bskd->bkgqs', qblk, k).astype(jnp.float32) * scale
        p = jax.nn.softmax(s, axis=-1).astype(v.dtype)
        return jnp.einsum('bkgqs,bskd->bqkgd', p, v)

    o = lax.map(blk, qb)
    return o.transpose(1, 0, 2, 3, 4, 5).reshape(bsz, s_len, hq * dh)


def dilated_group(q, k, v, window, dilation):
    bsz, s_len, h, dh = q.shape
    n_side = (window // 2) // dilation
    offs = dilation * jnp.arange(-n_side, n_side + 1)
    nblk = s_len // Q_BLOCK
    scale = 1.0 / math.sqrt(dh)
    qb = q.reshape(bsz, nblk, Q_BLOCK, h, dh).transpose(1, 0, 2, 3, 4)
    starts = jnp.arange(nblk) * Q_BLOCK

    def blk(args):
        qblk, s0 = args
        kpos = s0 + jnp.arange(Q_BLOCK)[:, None] + offs[None, :]
        valid = (kpos >= 0) & (kpos < s_len)
        kidx = jnp.clip(kpos, 0, s_len - 1)
        kg = jnp.take(k, kidx, axis=1)
        vg = jnp.take(v, kidx, axis=1)
        s = jnp.einsum('bqhd,bqjhd->bhqj', qblk, kg).astype(jnp.float32) * scale
        s = jnp.where(valid[None, None], s, -jnp.inf)
        lse = jax.nn.logsumexp(s, axis=-1)
        p = jnp.exp(s - lse[..., None]).astype(v.dtype)
        o = jnp.einsum('bhqj,bqjhd->bqhd', p, vg)
        return o, lse.transpose(0, 2, 1)

    o, lse = lax.map(blk, (qb, starts))
    o = o.transpose(1, 0, 2, 3, 4).reshape(bsz, s_len, h, dh)
    lse = lse.transpose(1, 0, 2, 3).reshape(bsz, s_len, h)
    return o, lse


def trunk(x, p, g_norm, w_in, g_q, g_k, w_a, w_b, w_o, w_ple, g_ple, w_pg, g_final):
    bsz, s_len, _ = x.shape
    rows = s_len // GRID_W
    r_idx, c_idx = jnp.meshgrid(jnp.arange(rows), jnp.arange(GRID_W), indexing='ij')
    cos_r, sin_r = rope_table(r_idx.reshape(-1), HEAD_DIM // 2)
    cos_c, sin_c = rope_table(c_idx.reshape(-1), HEAD_DIM // 2)
    cos_t, sin_t = rope_table(jnp.arange(s_len), HEAD_DIM)
    pts = split_points()
    half = HEAD_DIM // 2
    h = x
    for i in range(DEPTH):
        u = rmsnorm(h, g_norm[i])
        proj = u @ w_in[i]
        qa, ka, va, za, qb, kb, vb, zb, ga, gb = jnp.split(proj, pts, axis=-1)

        qa = rmsnorm(qa.reshape(bsz, s_len, A_Q_HEADS, HEAD_DIM), g_q[i])
        ka = rmsnorm(ka.reshape(bsz, s_len, A_KV_HEADS, HEAD_DIM), g_k[i])
        va = va.reshape(bsz, s_len, A_KV_HEADS, HEAD_DIM)
        qa = jnp.concatenate([apply_rope(qa[..., :half], cos_r, sin_r),
                              apply_rope(qa[..., half:], cos_c, sin_c)], axis=-1)
        ka = jnp.concatenate([apply_rope(ka[..., :half], cos_r, sin_r),
                              apply_rope(ka[..., half:], cos_c, sin_c)], axis=-1)
        ya = gqa_attention(qa, ka, va) * jax.nn.silu(za)
        ya = ya @ w_a[i]

        qb = apply_rope(qb.reshape(bsz, s_len, B_HEADS, HEAD_DIM), cos_t, sin_t)
        kb = apply_rope(kb.reshape(bsz, s_len, B_HEADS, HEAD_DIM), cos_t, sin_t)
        vb = vb.reshape(bsz, s_len, B_HEADS, HEAD_DIM)
        outs, lses = [], []
        for gi, (window, dilation) in enumerate(B_GROUPS):
            sl = slice(gi * B_HEADS_PER_GROUP, (gi + 1) * B_HEADS_PER_GROUP)
            o_g, lse_g = dilated_group(qb[:, :, sl], kb[:, :, sl], vb[:, :, sl], window, dilation)
            outs.append(o_g)
            lses.append(lse_g)
        wts = jax.nn.softmax(jnp.stack(lses, axis=0), axis=0)
        ob = jnp.sum(wts[..., None].astype(vb.dtype) * jnp.stack(outs, axis=0), axis=0)
        yb = ob.reshape(bsz, s_len, B_WIDTH) * jax.nn.silu(zb)
        yb = yb @ w_b[i]

        merged = jax.nn.sigmoid(ga) * ya + jax.nn.sigmoid(gb) * yb
        h = h + merged @ w_o[i]

        e = p[i] @ w_ple[i]
        gate = jax.nn.sigmoid(rmsnorm(h, g_ple[i]) @ w_pg[i])
        h = h + gate * e
    return rmsnorm(h, g_final)


def setup_inputs(seed: int = 0) -> dict:
    key = jax.random.key(seed)
    ks = jax.random.split(key, 16)
    f32 = jnp.float32

    def nrm(k, shape, fan_in):
        return jax.random.normal(k, shape, f32) * (fan_in ** -0.5)

    return {
        "x_prompt": jax.random.normal(ks[0], (BATCH, SEQ, D_MODEL), f32),
        "x_sample": jax.random.normal(ks[1], (DEC_BATCH, DEC_SEQ, D_MODEL), f32),
        "p_prompt": jax.random.normal(ks[2], (DEPTH, BATCH, SEQ, PLE_DIM), f32),
        "p_sample": jax.random.normal(ks[3], (DEPTH, DEC_BATCH, DEC_SEQ, PLE_DIM), f32),
        "g_norm": 1.0 + 0.02 * jax.random.normal(ks[4], (DEPTH, D_MODEL), f32),
        "w_in": nrm(ks[5], (DEPTH, D_MODEL, IN_WIDTH), D_MODEL),
        "g_q": 1.0 + 0.02 * jax.random.normal(ks[6], (DEPTH, HEAD_DIM), f32),
        "g_k": 1.0 + 0.02 * jax.random.normal(ks[7], (DEPTH, HEAD_DIM), f32),
        "w_a": nrm(ks[8], (DEPTH, A_WIDTH, D_MODEL), A_WIDTH),
        "w_b": nrm(ks[9], (DEPTH, B_WIDTH, D_MODEL), B_WIDTH),
        "w_o": nrm(ks[10], (DEPTH, D_MODEL, D_MODEL), D_MODEL),
        "w_ple": nrm(ks[11], (DEPTH, PLE_DIM, D_MODEL), PLE_DIM),
        "g_ple": 1.0 + 0.02 * jax.random.normal(ks[12], (DEPTH, D_MODEL), f32),
        "w_pg": nrm(ks[13], (DEPTH, D_MODEL, D_MODEL), D_MODEL),
        "g_final": 1.0 + 0.02 * jax.random.normal(ks[14], (D_MODEL,), f32),
    }


def reference(x_prompt, x_sample, p_prompt, p_sample, g_norm, w_in, g_q, g_k, w_a, w_b, w_o,
              w_ple, g_ple, w_pg, g_final):
    y_prompt = trunk(x_prompt, p_prompt, g_norm, w_in, g_q, g_k, w_a, w_b, w_o,
                     w_ple, g_ple, w_pg, g_final)
    y_sample = trunk(x_sample, p_sample, g_norm, w_in, g_q, g_k, w_a, w_b, w_o,
                     w_ple, g_ple, w_pg, g_final)
    return (y_prompt, y_sample)
```

```cpp
#include <hip/hip_runtime.h>
#include <hip/hip_cooperative_groups.h>
namespace cg = cooperative_groups;
__device__ __forceinline__ float shx(float v, int lane, int m) { return __builtin_bit_cast(float, __builtin_amdgcn_ds_bpermute((lane ^ m) << 2, __builtin_bit_cast(int, v))); }
__device__ __forceinline__ int lane_now() { int l; asm volatile("v_mbcnt_lo_u32_b32 %0, -1, 0\n\tv_mbcnt_hi_u32_b32 %0, -1, %0" : "=v"(l)); return l; }
#include <hip/hip_runtime.h>
#include <cstdio>
#include <cstdint>
namespace pg8 {
#define PG8_LAS __attribute__((address_space(3)))
typedef unsigned short bf16_t;
typedef short bf16x8 __attribute__((ext_vector_type(8)));
typedef float f32x4 __attribute__((ext_vector_type(4)));
typedef unsigned u32x4 __attribute__((ext_vector_type(4)));
constexpr int BM = 256, BK = 64, HALF = 128, HTB = HALF * BK * 2  , STAGE_BYTES = 8 * HTB, NXCD = 8, WGM = 8;

__host__ __device__ __forceinline__ int lds_byte(int r, int c) { const int st = (r >> 4) * 2 + (c >> 5), rr = r & 15, cc = c & 31, ob = rr * 64 + cc * 2; return st * 1024 + (ob ^ (((ob >> 9) & 1) << 5)); }
__host__ __device__ __forceinline__ void stage_rc(int b, int& R, int& C) { const int st = b / 1024, sb = b % 1024, swz = sb ^ (((sb >> 9) & 1) << 5); R = (st >> 1) * 16 + swz / 64; C = (st & 1) * 32 + (swz % 64) / 2; }
__host__ __device__ __forceinline__ int perm32(int rho) { const int n = rho >> 4, i = rho & 15; return 8 * (i >> 2) + 4 * n + (i & 3); }

struct Unit { int pm, pn; };
struct Gemm { const bf16_t* A; const bf16_t* Bt; int M, N, K, lda; };

struct StaticOrder {
    int nM, nN, nwg, G, c;
    __host__ __device__ void init(int M, int N, int G_, int c_) { nM = M / BM; nN = N / BM; nwg = nM * nN; G = G_; c = c_; }
    __host__ __device__ bool next(int i, Unit& u) const {
        const long L = (long)i * G + c; if (L >= nwg) return false;
        int wgid = (int)L; { const int q = nwg / NXCD, r = nwg % NXCD, xcd = wgid % NXCD, off = wgid / NXCD; wgid = (xcd < r ? xcd * (q + 1) : r * (q + 1) + (xcd - r) * q) + off; }
        const int nig = WGM * nN, gid = wgid / nig, fm = gid * WGM, gsz = (nM - fm) < WGM ? (nM - fm) : WGM;
        u.pm = fm + ((wgid % nig) % gsz); u.pn = (wgid % nig) / gsz; return true;
    }
    __device__ __forceinline__ void a_ready(const Unit&) const {}
    __device__ __forceinline__ void done(const Unit&) const {}
};

template <class Epi, class Sched, bool ALIGN_EPI = false, bool SP2 = false>
__device__ __forceinline__ void gemm_phase(PG8_LAS unsigned char* lds, const Gemm g, const Sched& S, const Epi& E, const int wave_id) {
    const int tid = wave_id * 64 + lane_now(), wid = wave_id, lane = tid & 63, wr = wid >> 2, wc = wid & 3, fr = lane & 15, fq = lane >> 4;
    const int K = g.K, nt = K / BK;
    unsigned voffA[2], voffB[2];
#pragma unroll
    for (int i = 0; i < 2; ++i) { int R, C; stage_rc(tid * 16 + i * 8192, R, C); const int Rb = Epi::PERM ? ((R & ~31) + perm32(R & 31)) : R;
        voffA[i] = (unsigned)(R * g.lda + C) * 2u; voffB[i] = (unsigned)(Rb * K + C) * 2u; }
    const size_t kstep = (size_t)(BK * 2);
    const size_t hstep = (size_t)HALF * K * 2;
    const size_t tstep = 2 * hstep; const size_t hstepA = (size_t)HALF * g.lda * 2, tstepA = 2 * hstepA;
    const unsigned ldsw = (unsigned)wid * 1024u;
    const int aoff = lds_byte(wr * 64 + fr, fq * 8), boff = lds_byte(wc * 32 + fr, fq * 8);
#define PG8_SA(b, h) (((b) * 2 + (h)) * HTB)
#define PG8_SB(b, h) ((4 + (b) * 2 + (h)) * HTB)
#define PG8_STAGE(bufoff, gbase, voff) do { _Pragma("unroll") for (int _i = 0; _i < 2; ++_i) \
        __builtin_amdgcn_global_load_lds((const unsigned*)((const char*)(gbase) + (voff)[_i]), (PG8_LAS unsigned*)(lds + (bufoff) + ldsw + _i * 8192), 16, 0, 0); } while (0)
#define PG8_LDA(dst, b, h) do { _Pragma("unroll") for (int m = 0; m < 4; ++m) _Pragma("unroll") for (int k = 0; k < 2; ++k) dst[m][k] = *(const PG8_LAS bf16x8*)(lds + PG8_SA(b, h) + aoff + m * 2048 + k * 1024); } while (0)
#define PG8_LDB(dst, b, h) do { _Pragma("unroll") for (int n = 0; n < 2; ++n) _Pragma("unroll") for (int k = 0; k < 2; ++k) dst[n][k] = *(const PG8_LAS bf16x8*)(lds + PG8_SB(b, h) + boff + n * 2048 + k * 1024); } while (0)
#define PG8_MMA(ai, bj, At, Bt) do { __builtin_amdgcn_s_setprio(1); _Pragma("unroll") for (int m = 0; m < 4; ++m) _Pragma("unroll") for (int n = 0; n < 2; ++n) _Pragma("unroll") for (int k = 0; k < 2; ++k) \
        acc[ai][bj][m][n] = __builtin_amdgcn_mfma_f32_16x16x32_bf16(Bt[n][k], At[m][k], acc[ai][bj][m][n], 0, 0, 0); __builtin_amdgcn_s_setprio(0); } while (0)
#define PG8_WAIT_V(n) asm volatile("s_waitcnt vmcnt(" #n ")" ::: "memory")
#define PG8_WAIT_L(n) asm volatile("s_waitcnt lgkmcnt(" #n ")" ::: "memory")
#define PG8_BAR __builtin_amdgcn_s_barrier()
#define PG8_SCHED __builtin_amdgcn_sched_barrier(0)
    Unit cur, nxt; int ui = 0;
    if (!S.next(0, cur)) return;
    f32x4 acc[2][2][4][2];
#pragma unroll
    for (int a = 0; a < 2; ++a)
#pragma unroll
        for (int b = 0; b < 2; ++b)
#pragma unroll
            for (int m = 0; m < 4; ++m)
#pragma unroll
                for (int n = 0; n < 2; ++n) acc[a][b][m][n] = (f32x4){0.f, 0.f, 0.f, 0.f};
    bf16x8 At[4][2], B0[2][2], B1[2][2];
    const char* cA = (const char*)g.A + (size_t)cur.pm * tstepA; const char* cB = (const char*)g.Bt + (size_t)cur.pn * tstep;
    S.a_ready(cur);
    if constexpr (SP2) {
        PG8_STAGE(PG8_SB(0, 0), cB, voffB); PG8_STAGE(PG8_SB(0, 1), cB + hstep, voffB); PG8_STAGE(PG8_SA(0, 0), cA, voffA); PG8_STAGE(PG8_SA(0, 1), cA + hstepA, voffA);
        if (wr == 1) PG8_BAR;
        PG8_WAIT_V(2); PG8_BAR;
        PG8_STAGE(PG8_SB(1, 0), cB + kstep, voffB); PG8_STAGE(PG8_SA(1, 0), cA + kstep, voffA); PG8_STAGE(PG8_SB(1, 1), cB + hstep + kstep, voffB);
        PG8_WAIT_V(6); PG8_BAR;
    } else {
        PG8_STAGE(PG8_SB(0, 0), cB, voffB); PG8_STAGE(PG8_SA(0, 0), cA, voffA); PG8_STAGE(PG8_SB(0, 1), cB + hstep, voffB); PG8_STAGE(PG8_SA(0, 1), cA + hstepA, voffA);
        if (wr == 1) PG8_BAR;
        PG8_WAIT_V(4); PG8_BAR;
        PG8_STAGE(PG8_SB(1, 0), cB + kstep, voffB); PG8_STAGE(PG8_SA(1, 0), cA + kstep, voffA); PG8_STAGE(PG8_SB(1, 1), cB + hstep + kstep, voffB);
        PG8_WAIT_V(6); PG8_BAR;
    }
    for (;;) {
        const bool has_next = S.next(ui + 1, nxt);
        const char* nA = has_next ? (const char*)g.A + (size_t)nxt.pm * tstepA : cA; const char* nB = has_next ? (const char*)g.Bt + (size_t)nxt.pn * tstep : cB;
        for (int t = 0; t < nt; t += 2) {
            const bool last = (t == nt - 2);
            const char* a1 = cA + (size_t)(t + 1) * kstep;
            const char* a2 = last ? nA : cA + (size_t)(t + 2) * kstep; const char* b2 = last ? nB : cB + (size_t)(t + 2) * kstep;
            const char* a3 = a2 + kstep; const char* b3 = b2 + kstep;
            if (last && has_next) S.a_ready(nxt);
            if constexpr (SP2) {
            PG8_LDB(B0, 0, 0); PG8_LDB(B1, 0, 1); PG8_SCHED; PG8_LDA(At, 0, 0); PG8_STAGE(PG8_SA(1, 1), a1 + hstepA, voffA);
            PG8_WAIT_V(8); PG8_WAIT_L(0); PG8_BAR; PG8_MMA(0, 0, At, B0); PG8_MMA(0, 1, At, B1); PG8_BAR; PG8_SCHED;
            PG8_LDA(At, 0, 1); PG8_STAGE(PG8_SB(0, 0), b2, voffB); PG8_STAGE(PG8_SB(0, 1), b2 + hstep, voffB); PG8_STAGE(PG8_SA(0, 0), a2, voffA);
            PG8_WAIT_V(8); PG8_WAIT_L(0); PG8_BAR; PG8_MMA(1, 0, At, B0); PG8_MMA(1, 1, At, B1); PG8_BAR; PG8_SCHED;
            PG8_LDB(B0, 1, 0); PG8_LDB(B1, 1, 1); PG8_SCHED; PG8_LDA(At, 1, 0); PG8_STAGE(PG8_SA(0, 1), a2 + hstepA, voffA);
            PG8_WAIT_V(8); PG8_WAIT_L(0); PG8_BAR; PG8_MMA(0, 0, At, B0); PG8_MMA(0, 1, At, B1); PG8_BAR; PG8_SCHED;
            PG8_LDA(At, 1, 1); PG8_STAGE(PG8_SB(1, 0), b3, voffB); PG8_STAGE(PG8_SB(1, 1), b3 + hstep, voffB); PG8_STAGE(PG8_SA(1, 0), a3, voffA);
            PG8_WAIT_V(8); PG8_WAIT_L(0); PG8_BAR; PG8_MMA(1, 0, At, B0); PG8_MMA(1, 1, At, B1); PG8_BAR; PG8_SCHED;
            } else {
            PG8_LDB(B0, 0, 0); PG8_SCHED; PG8_LDA(At, 0, 0); PG8_STAGE(PG8_SA(1, 1), a1 + hstepA, voffA);
            PG8_WAIT_L(8); PG8_BAR; PG8_WAIT_L(0); PG8_MMA(0, 0, At, B0); PG8_BAR; PG8_SCHED;
            PG8_LDB(B1, 0, 1); PG8_STAGE(PG8_SB(0, 0), b2, voffB);
            PG8_BAR; PG8_WAIT_L(0); PG8_MMA(0, 1, At, B1); PG8_BAR;
            PG8_LDA(At, 0, 1); PG8_STAGE(PG8_SA(0, 0), a2, voffA);
            PG8_BAR; PG8_WAIT_L(0); PG8_MMA(1, 0, At, B0); PG8_BAR; PG8_SCHED;
            PG8_STAGE(PG8_SB(0, 1), b2 + hstep, voffB);
            PG8_WAIT_V(6); PG8_BAR; PG8_MMA(1, 1, At, B1); PG8_BAR;
            PG8_LDB(B0, 1, 0); PG8_SCHED; PG8_LDA(At, 1, 0); PG8_STAGE(PG8_SA(0, 1), a2 + hstepA, voffA);
            PG8_WAIT_L(8); PG8_BAR; PG8_WAIT_L(0); PG8_MMA(0, 0, At, B0); PG8_BAR; PG8_SCHED;
            PG8_LDB(B1, 1, 1); PG8_STAGE(PG8_SB(1, 0), b3, voffB);
            PG8_BAR; PG8_WAIT_L(0); PG8_MMA(0, 1, At, B1); PG8_BAR;
            PG8_LDA(At, 1, 1); PG8_STAGE(PG8_SA(1, 0), a3, voffA);
            PG8_BAR; PG8_WAIT_L(0); PG8_MMA(1, 0, At, B0); PG8_BAR; PG8_SCHED;
            PG8_STAGE(PG8_SB(1, 1), b3 + hstep, voffB);
            PG8_WAIT_V(6); PG8_BAR; PG8_MMA(1, 1, At, B1); PG8_BAR;
            }
        }
        if constexpr (ALIGN_EPI) { if (wr == 0) PG8_BAR; }
        if constexpr (!Epi::AFTER_DRAIN) { E(acc, cur, wr, wc, fr, fq); S.done(cur); }
        if (!has_next) break;
#pragma unroll
        for (int a = 0; a < 2; ++a)
#pragma unroll
            for (int b = 0; b < 2; ++b)
#pragma unroll
                for (int m = 0; m < 4; ++m)
#pragma unroll
                    for (int n = 0; n < 2; ++n) acc[a][b][m][n] = (f32x4){0.f, 0.f, 0.f, 0.f};
        cur = nxt; cA = nA; cB = nB; ++ui;
        if constexpr (ALIGN_EPI) { if (wr == 1) PG8_BAR; }
    }
    PG8_WAIT_V(0);
    if constexpr (!ALIGN_EPI) { if (wr == 0) PG8_BAR; }
    PG8_BAR;
    if constexpr (Epi::AFTER_DRAIN) { E.fused(acc, cur, wr, wc, fr, fq, lds, wid, lane); S.done(cur); }
#undef PG8_SA
#undef PG8_SB
#undef PG8_STAGE
#undef PG8_LDA
#undef PG8_LDB
#undef PG8_MMA
#undef PG8_WAIT_V
#undef PG8_WAIT_L
#undef PG8_BAR
#undef PG8_SCHED
}
}
namespace pg8 {
__device__ __forceinline__ unsigned cvt_pk_bf16(float lo, float hi) { unsigned r; asm volatile("v_cvt_pk_bf16_f32 %0, %1, %2" : "=v"(r) : "v"(lo), "v"(hi)); return r; }
__device__ __forceinline__ float bf_lo(unsigned w) { return __uint_as_float(w << 16); }
__device__ __forceinline__ float bf_hi(unsigned w) { return __uint_as_float(w & 0xffff0000u); }
__device__ __forceinline__ float sigm(float x) { return __builtin_amdgcn_rcpf(1.f + __expf(-x)); }
#define EPI_ROWS_BEGIN \
    const int row0 = u.pm * BM + wr * 64 + fr; const int col0 = u.pn * BM + wc * 32 + 8 * fq; \
    _Pragma("unroll") for (int ai = 0; ai < 2; ++ai) _Pragma("unroll") for (int m = 0; m < 4; ++m) { const int lr = row0 + ai * HALF + m * 16;
#define EPI_ROWS_END }
struct EpiProj {
    static constexpr bool PERM = true, AFTER_DRAIN = false;
    bf16_t* O; int ldc; const float* ss; int grow0;
    __device__ __forceinline__ void operator()(const f32x4 (&acc)[2][2][4][2], const Unit& u, int wr, int wc, int fr_, int fq_) const { const int l_ = lane_now(), fr = l_ & 15, fq = l_ >> 4;
        EPI_ROWS_BEGIN
            const float rs = __builtin_amdgcn_rsqf(ss[grow0 + lr] * (1.f / 1024.f) + 1e-6f);
            bf16_t* rowp = O + (size_t)lr * ldc + col0;
#pragma unroll
            for (int bj = 0; bj < 2; ++bj) { const f32x4 v0 = acc[ai][bj][m][0] * rs, v1 = acc[ai][bj][m][1] * rs;
                u32x4 w; w.x = cvt_pk_bf16(v0[0], v0[1]); w.y = cvt_pk_bf16(v0[2], v0[3]); w.z = cvt_pk_bf16(v1[0], v1[1]); w.w = cvt_pk_bf16(v1[2], v1[3]);
                *(u32x4*)(rowp + bj * HALF) = w; }
        EPI_ROWS_END
    }
};
template <bool ADD> struct EpiGate {
    static constexpr bool PERM = true, AFTER_DRAIN = false;
    bf16_t* O; int ldc; const bf16_t* G; int ldg;
    __device__ __forceinline__ void operator()(const f32x4 (&acc)[2][2][4][2], const Unit& u, int wr, int wc, int fr_, int fq_) const { const int l_ = lane_now(), fr = l_ & 15, fq = l_ >> 4;
        EPI_ROWS_BEGIN
            bf16_t* rowp = O + (size_t)lr * ldc + col0; const bf16_t* gp = G + (size_t)lr * ldg + col0;
#pragma unroll
            for (int bj = 0; bj < 2; ++bj) { const u32x4 gw = *(const u32x4*)(gp + bj * HALF); u32x4 pv = (u32x4){0u, 0u, 0u, 0u}; if (ADD) pv = *(const u32x4*)(rowp + bj * HALF);
                const f32x4 a0 = acc[ai][bj][m][0], a1 = acc[ai][bj][m][1]; u32x4 w;
                w.x = cvt_pk_bf16(bf_lo(pv.x) + sigm(bf_lo(gw.x)) * a0[0], bf_hi(pv.x) + sigm(bf_hi(gw.x)) * a0[1]);
                w.y = cvt_pk_bf16(bf_lo(pv.y) + sigm(bf_lo(gw.y)) * a0[2], bf_hi(pv.y) + sigm(bf_hi(gw.y)) * a0[3]);
                w.z = cvt_pk_bf16(bf_lo(pv.z) + sigm(bf_lo(gw.z)) * a1[0], bf_hi(pv.z) + sigm(bf_hi(gw.z)) * a1[1]);
                w.w = cvt_pk_bf16(bf_lo(pv.w) + sigm(bf_lo(gw.w)) * a1[2], bf_hi(pv.w) + sigm(bf_hi(gw.w)) * a1[3]);
                *(u32x4*)(rowp + bj * HALF) = w; }
        EPI_ROWS_END
    }
};
struct EpiPlain {
    static constexpr bool PERM = true, AFTER_DRAIN = false;
    bf16_t* O; int ldc;
    __device__ __forceinline__ void operator()(const f32x4 (&acc)[2][2][4][2], const Unit& u, int wr, int wc, int fr_, int fq_) const { const int l_ = lane_now(), fr = l_ & 15, fq = l_ >> 4;
        EPI_ROWS_BEGIN
            bf16_t* rowp = O + (size_t)lr * ldc + col0;
#pragma unroll
            for (int bj = 0; bj < 2; ++bj) { const f32x4 v0 = acc[ai][bj][m][0], v1 = acc[ai][bj][m][1];
                u32x4 w; w.x = cvt_pk_bf16(v0[0], v0[1]); w.y = cvt_pk_bf16(v0[2], v0[3]); w.z = cvt_pk_bf16(v1[0], v1[1]); w.w = cvt_pk_bf16(v1[2], v1[3]);
                *(u32x4*)(rowp + bj * HALF) = w; }
        EPI_ROWS_END
    }
};
template <bool GATED> struct EpiResid {
    static constexpr bool PERM = true, AFTER_DRAIN = false;
    float* H; const float* ss_in; float* ss_out; const bf16_t* E; bf16_t* XO; const float* gvec; int grow0;
    __device__ __forceinline__ void operator()(const f32x4 (&acc)[2][2][4][2], const Unit& u, int wr, int wc, int fr_, int fq_) const { const int l_ = lane_now(), fr = l_ & 15, fq = l_ >> 4;
        f32x4 gv[2][2];
#pragma unroll
        for (int bj = 0; bj < 2; ++bj)
#pragma unroll
            for (int n = 0; n < 2; ++n) gv[bj][n] = XO ? *(const f32x4*)(gvec + u.pn * BM + wc * 32 + 8 * fq + bj * HALF + 4 * n) : (f32x4){0.f, 0.f, 0.f, 0.f};
        EPI_ROWS_BEGIN
            const int gr = grow0 + lr; float* hp = H + (size_t)gr * 1024 + col0;
            float rs = 1.f; if (GATED) rs = __builtin_amdgcn_rsqf(ss_in[gr] * (1.f / 1024.f) + 1e-6f);
            float sq = 0.f;
#pragma unroll
            for (int bj = 0; bj < 2; ++bj) {
                f32x4 h0 = *(const f32x4*)(hp + bj * HALF), h1 = *(const f32x4*)(hp + bj * HALF + 4);
                f32x4 a0 = acc[ai][bj][m][0], a1 = acc[ai][bj][m][1];
                if (GATED) { const u32x4 ew = *(const u32x4*)(E + (size_t)lr * 1024 + col0 + bj * HALF);
                    a0[0] = sigm(a0[0] * rs) * bf_lo(ew.x); a0[1] = sigm(a0[1] * rs) * bf_hi(ew.x); a0[2] = sigm(a0[2] * rs) * bf_lo(ew.y); a0[3] = sigm(a0[3] * rs) * bf_hi(ew.y);
                    a1[0] = sigm(a1[0] * rs) * bf_lo(ew.z); a1[1] = sigm(a1[1] * rs) * bf_hi(ew.z); a1[2] = sigm(a1[2] * rs) * bf_lo(ew.w); a1[3] = sigm(a1[3] * rs) * bf_hi(ew.w); }
                h0 = h0 + a0; h1 = h1 + a1;
                *(f32x4*)(hp + bj * HALF) = h0; *(f32x4*)(hp + bj * HALF + 4) = h1;
                sq += (h0[0] * h0[0] + h0[1] * h0[1]) + (h0[2] * h0[2] + h0[3] * h0[3]) + (h1[0] * h1[0] + h1[1] * h1[1]) + (h1[2] * h1[2] + h1[3] * h1[3]);
                if (XO) { const f32x4 x0 = h0 * gv[bj][0], x1 = h1 * gv[bj][1];
                    u32x4 w; w.x = cvt_pk_bf16(x0[0], x0[1]); w.y = cvt_pk_bf16(x0[2], x0[3]); w.z = cvt_pk_bf16(x1[0], x1[1]); w.w = cvt_pk_bf16(x1[2], x1[3]);
                    *(u32x4*)(XO + (size_t)lr * 1024 + col0 + bj * HALF) = w; }
            }
            sq += shx(sq, fr + 16 * fq, 16); sq += shx(sq, fr + 16 * fq, 32);
            if (fq == 0) unsafeAtomicAdd(ss_out + gr, sq);
        EPI_ROWS_END
    }
};
}
#include <hip/hip_bf16.h>
#include <cmath>
namespace attn_body {
using bf16=__hip_bfloat16;
using bf16x8=__attribute__((ext_vector_type(8)))short;
using s16x4=__attribute__((ext_vector_type(4)))short;
using f32x16=__attribute__((ext_vector_type(16)))float;
using u32x4=__attribute__((ext_vector_type(4)))unsigned;
constexpr int NHEAD=8,SEQ=4096,D=64,DM=5888;
constexpr int NW=8,QBLK=32,QB=QBLK*NW,KVBLK=64,NQB=SEQ/QB;
constexpr int ATTN_PITCH=DM, ATTN_UNIT_ROWS=QB;
__device__ __forceinline__ int crow(int r,int hi){return (r&3)+8*(r>>2)+4*hi;}
#define SBAR() __builtin_amdgcn_sched_barrier(0)
__device__ __forceinline__ void cmask(f32x16&p0,f32x16&p1,int jb,int qrel,int hi){
  const float NEG=-INFINITY; int kb=64*jb+4*hi;
  #pragma unroll
  for(int r=0;r<16;++r){int kv=kb+(r&3)+8*(r>>2); if(kv>qrel)p0[r]=NEG; if(kv+32>qrel)p1[r]=NEG;}
}

constexpr int NSLOT=3, SLOTB=8192;
constexpr int LDS_K=0, LDS_V=NSLOT*SLOTB, LDS_WS=2*NSLOT*SLOTB, LDS_OST=LDS_WS+NW*64*4, LDS_BYTES=LDS_OST+NW*4096;
constexpr float C2=0.125f*1.4426950408889634f;
__device__ __forceinline__ void glds16(const void*gsrc,unsigned lds_dst){unsigned keep;
  asm volatile("s_mov_b32 %0, m0\n\ts_mov_b32 m0, %2\n\ts_nop 0\n\tglobal_load_lds_dwordx4 %1, off\n\ts_mov_b32 m0, %0":"=&s"(keep):"v"(gsrc),"s"(lds_dst):"memory");}
__device__ __forceinline__ float max3f(float a,float b,float c){float r;asm("v_max3_f32 %0, %1, %2, %3":"=v"(r):"v"(a),"v"(b),"v"(c));return r;}
__device__ __forceinline__ float max2f(float a,float b){float r;asm("v_max_f32_e32 %0, %1, %2":"=v"(r):"v"(a),"v"(b));return r;}
__device__ __forceinline__ float fadd_s(float a,float b){float r;asm("v_add_f32_e32 %0, %1, %2":"=v"(r):"v"(a),"v"(b));return r;}
__device__ __forceinline__ float fsub_s(float a,float b){float r;asm("v_sub_f32_e32 %0, %1, %2":"=v"(r):"v"(a),"v"(b));return r;}
typedef float f32x2_t __attribute__((ext_vector_type(2))); typedef __bf16 bf16x2_t __attribute__((ext_vector_type(2)));
__device__ __forceinline__ unsigned cvtpk_s(float lo,float hi){f32x2_t v={lo,hi};bf16x2_t b=__builtin_convertvector(v,bf16x2_t);return __builtin_bit_cast(unsigned,b);}
#define WAIT_BAR(N) asm volatile("s_waitcnt vmcnt(" #N ") lgkmcnt(0)\n\ts_barrier":::"memory")

__device__ __forceinline__ void qkt(f32x16&p0,f32x16&p1,const char*Kslot,const bf16x8*qr,const f32x16&negm,int r32,int hi){
  const char*kb=Kslot+hi*1024+r32*16;
  #pragma unroll
  for(int d0=0;d0<4;++d0){
    const bf16x8 b0=*reinterpret_cast<const bf16x8*>(kb+d0*2048);
    const bf16x8 b1=*reinterpret_cast<const bf16x8*>(kb+d0*2048+512);
    if(d0==0){p0=__builtin_amdgcn_mfma_f32_32x32x16_bf16(b0,qr[0],negm,0,0,0);p1=__builtin_amdgcn_mfma_f32_32x32x16_bf16(b1,qr[0],negm,0,0,0);}
    else{p0=__builtin_amdgcn_mfma_f32_32x32x16_bf16(b0,qr[d0],p0,0,0,0);p1=__builtin_amdgcn_mfma_f32_32x32x16_bf16(b1,qr[d0],p1,0,0,0);}}
}
typedef __attribute__((address_space(3))) const char* lds_cptr;
typedef short v4i16_t __attribute__((ext_vector_type(4)));
__device__ __forceinline__ void kload8(bf16x8*kf,lds_cptr kp){
  kf[0]=*(const __attribute__((address_space(3))) bf16x8*)(kp);      kf[1]=*(const __attribute__((address_space(3))) bf16x8*)(kp+512);
  kf[2]=*(const __attribute__((address_space(3))) bf16x8*)(kp+2048); kf[3]=*(const __attribute__((address_space(3))) bf16x8*)(kp+2560);
  kf[4]=*(const __attribute__((address_space(3))) bf16x8*)(kp+4096); kf[5]=*(const __attribute__((address_space(3))) bf16x8*)(kp+4608);
  kf[6]=*(const __attribute__((address_space(3))) bf16x8*)(kp+6144); kf[7]=*(const __attribute__((address_space(3))) bf16x8*)(kp+6656);
}
__device__ __forceinline__ void kload2(bf16x8*kf,lds_cptr kp,int j){ kf[2*j]=*(const __attribute__((address_space(3))) bf16x8*)(kp+j*2048); kf[2*j+1]=*(const __attribute__((address_space(3))) bf16x8*)(kp+j*2048+512); }
__device__ __forceinline__ s16x4 vtr(lds_cptr p){ return __builtin_bit_cast(s16x4,__builtin_amdgcn_ds_read_tr16_b64_v4i16((__attribute__((address_space(3))) v4i16_t*)p)); }
__device__ __forceinline__ float rowmax(const f32x16&p0,const f32x16&p1){
  float a=max3f(p0[0],p0[1],p1[0]),b=max3f(p0[2],p0[3],p1[1]);a=max3f(a,p1[2],p1[3]);
  #pragma unroll
  for(int r=4;r<16;r+=4){a=max3f(a,p0[r],p0[r+1]);b=max3f(b,p0[r+2],p0[r+3]);a=max3f(a,p1[r],p1[r+1]);b=max3f(b,p1[r+2],p1[r+3]);}
  const float m=max2f(a,b);
  auto rr=__builtin_amdgcn_permlane32_swap(__float_as_uint(m),__float_as_uint(m),false,false);
  return max2f(__uint_as_float(rr[0]),__uint_as_float(rr[1]));
}
__device__ __forceinline__ void pv(f32x16*o,int vb,bf16x8 pa0,bf16x8 pa1,bf16x8 pa2,bf16x8 pa3){
  #pragma unroll
  for(int d0=0;d0<2;++d0){s16x4 lo[4],hi[4];
    #pragma unroll
    for(int ks=0;ks<4;++ks){
      asm volatile("ds_read_b64_tr_b16 %0,%1 offset:%c2":"=&v"(lo[ks]):"v"(vb),"i"(d0*4096+ks*1024):"memory");
      asm volatile("ds_read_b64_tr_b16 %0,%1 offset:%c2":"=&v"(hi[ks]):"v"(vb),"i"(d0*4096+ks*1024+512):"memory");}
    asm volatile("s_waitcnt lgkmcnt(0)":::"memory");SBAR();
    #define PK(k) (bf16x8){lo[k][0],lo[k][1],lo[k][2],lo[k][3],hi[k][0],hi[k][1],hi[k][2],hi[k][3]}
    o[d0]=__builtin_amdgcn_mfma_f32_32x32x16_bf16(pa0,PK(0),o[d0],0,0,0);
    o[d0]=__builtin_amdgcn_mfma_f32_32x32x16_bf16(pa1,PK(1),o[d0],0,0,0);
    o[d0]=__builtin_amdgcn_mfma_f32_32x32x16_bf16(pa2,PK(2),o[d0],0,0,0);
    o[d0]=__builtin_amdgcn_mfma_f32_32x32x16_bf16(pa3,PK(3),o[d0],0,0,0);
    #undef PK
  }
}

#ifndef ATTN_STORE16
#define ATTN_STORE16(p,v) (*(u32x4*)(p)=(v))
#endif
template<int THRL> __device__ __forceinline__ void attn_unit(int b,int h,int qb,const bf16*Q,const bf16*__restrict__ K,const bf16*__restrict__ V,bf16*O,const bf16*__restrict__ Z,char*shm,const int wave_id){
  const int lane=lane_now(),tid=wave_id*64+lane,r32=lane&31,hi=lane>>5; const int wid=wave_id;
  const long rowbase=(long)b*SEQ; const int q0=qb*QB;
  const bf16*Qw=Q+(rowbase+q0+wid*QBLK)*DM+h*D;
  const bf16*Kh=K+rowbase*DM+(h>>2)*D,*Vh=V+rowbase*DM+(h>>2)*D;
  const unsigned lds0=(unsigned)(uintptr_t)shm;
  float*wsf=(float*)(shm+LDS_WS)+wid*64;
  const bf16*ksrc=Kh+(long)lane*DM+wid*8;
  const bf16*vsrc=Vh+(long)(16*(wid&3)+(lane>>2))*DM+(wid>>2)*32+(lane&3)*8;
  const unsigned kdst=lds0+LDS_K+wid*1024, vdst=lds0+LDS_V+wid*1024;
  #define DMA_K(t,slot) glds16(ksrc+(long)(t)*KVBLK*DM,(unsigned)__builtin_amdgcn_readfirstlane(kdst+(slot)))
  #define DMA_V(t,slot) glds16(vsrc+(long)(t)*KVBLK*DM,(unsigned)__builtin_amdgcn_readfirstlane(vdst+(slot)))
  const int vb0=(int)(lds0+LDS_V)+((lane>>4)&1)*32+(lane&3)*8+(4*hi+((lane&15)>>2))*64;
  const char*Kbase=shm+LDS_K; bf16x8 kf[8];
  const lds_cptr shm3=(lds_cptr)shm; const lds_cptr kp0=shm3+LDS_K+hi*1024+r32*16; const lds_cptr vp0=shm3+LDS_V+((lane>>4)&1)*32+(lane&3)*8+(4*hi+((lane&15)>>2))*64;
  constexpr int NT=SEQ/KVBLK;
  DMA_K(0,0);DMA_V(0,0);DMA_K(1,SLOTB);
  bf16x8 qr[4];
  #pragma unroll
  for(int d0=0;d0<4;++d0)qr[d0]=*reinterpret_cast<const bf16x8*>(&Qw[(long)r32*DM+d0*16+hi*8]);
  float mhat=0.f,l_reg=0.f;f32x16 o[2];{float zz=0.f;asm volatile("":"+v"(zz));_Pragma("unroll") for(int r=0;r<16;++r){o[0][r]=zz;o[1][r]=zz;}}f32x16 negm;{float zz=0.f;asm volatile("":"+v"(zz));_Pragma("unroll") for(int r=0;r<16;++r)negm[r]=zz;}asm volatile("":"+v"(negm));
  const int qrel=wid*QBLK+r32;
  #define CMASK(P0,P1,t) do{}while(0)
  bool resc=false;
  #define START(P0,P1) do{ const float rm=rowmax(P0,P1); resc=false; \
    { const float dl=rm; mhat=fadd_s(mhat,dl); \
      _Pragma("unroll") for(int r=0;r<16;++r){P0[r]=fsub_s(P0[r],dl);P1[r]=fsub_s(P1[r],dl);} \
      _Pragma("unroll") for(int r=0;r<16;++r)negm[r]=-mhat; asm volatile("":"+v"(negm)); } \
    _Pragma("unroll") for(int r=0;r<16;++r)P0[r]=__builtin_amdgcn_exp2f(P0[r]); }while(0)
  #define RESC() do{ if(resc){ asm volatile("s_waitcnt lgkmcnt(0)":::"memory"); \
      _Pragma("unroll") for(int d_=0;d_<2;++d_) _Pragma("unroll") for(int r=0;r<16;++r)o[d_][r]*=wsf[crow(r,hi)]; } }while(0)
  f32x16 pA0,pA1,pB0,pB1;
  int sl_prev=0,sl_cur=0,sl_next=SLOTB;
  #define ROT() do{sl_prev=sl_cur;sl_cur=sl_next;sl_next=(sl_next==(NSLOT-1)*SLOTB)?0:sl_next+SLOTB;}while(0)
  DMA_K(2,2*SLOTB);
  WAIT_BAR(3);
  qkt(pA0,pA1,Kbase,qr,negm,r32,hi);asm volatile("s_nop 15\n\ts_nop 7":"+v"(pA0),"+v"(pA1));CMASK(pA0,pA1,0);
  START(pA0,pA1);
  _Pragma("unroll") for(int r=0;r<16;++r)pA1[r]=__builtin_amdgcn_exp2f(pA1[r]);
  WAIT_BAR(0);
  DMA_K(3,0);DMA_V(1,SLOTB);
  ROT();
  kload8(kf,kp0+sl_cur);
  WAIT_BAR(2);
  s16x4 vlo[8],vhi[8]; u32x4 pw0,pw1,pw2,pw3;
  #define PKW(P,B) cvtpk_s(P[B],P[B+1])
  #define PAF(k) __builtin_bit_cast(bf16x8,pw##k)
  #define VFR(i) (bf16x8){vlo[i][0],vlo[i][1],vlo[i][2],vlo[i][3],vhi[i][0],vhi[i][1],vhi[i][2],vhi[i][3]}
  #define PIN(x) asm volatile("":"+v"(x))
  #define MX3(a,b,c) __builtin_fmaxf(__builtin_fmaxf((a),(b)),(c))
  #define GAPA(MF,A0,A1,A2,A3,W0,W1,PW) do{ MF; sacc+=A0; sacc+=A1; sacc+=A2; sacc+=A3; PIN(sacc); W0; W1; PIN(PW); SBAR(); }while(0)
  #define EX(v) __builtin_amdgcn_exp2f(v)
  #define GAPB(MF,X,B) do{ MF; X[B]=EX(X[B]); X[B+1]=EX(X[B+1]); X[B+2]=EX(X[B+2]); X[B+3]=EX(X[B+3]); PIN(X); SBAR(); }while(0)
  #define VRD(i) do{ vlo[i]=vtr(vp_+(((i)>>2)*4096+((i)&3)*1024)); vhi[i]=vtr(vp_+(((i)>>2)*4096+((i)&3)*1024+512)); }while(0)
  #define KRD(G,j) do{ if(G){ kload2(kf,kp0+sl_next,j); SBAR(); } }while(0)
  #define STEP(C0,C1,P0,P1,t,GK,GV,GL) do{ SBAR(); \
    const lds_cptr vp_=vp0+sl_prev; \
    VRD(0); SBAR(); float sacc=(P0[0]+P0[1]); \
    GAPA(C0=__builtin_amdgcn_mfma_f32_32x32x16_bf16(kf[0],qr[0],negm,0,0,0), P0[2],P0[3],P0[4],P0[5],     pw0[0]=PKW(P0,0), pw0[1]=PKW(P0,2), pw0); \
    VRD(4); SBAR(); GAPA(C1=__builtin_amdgcn_mfma_f32_32x32x16_bf16(kf[1],qr[0],negm,0,0,0), P0[6],P0[7],P0[8],P0[9],     pw0[2]=PKW(P0,4), pw0[3]=PKW(P0,6), pw0); \
    VRD(1); SBAR(); GAPA(C0=__builtin_amdgcn_mfma_f32_32x32x16_bf16(kf[2],qr[1],C0,0,0,0),   P0[10],P0[11],P0[12],P0[13], pw1[0]=PKW(P0,8), pw1[1]=PKW(P0,10), pw1); \
    VRD(5); SBAR(); GAPA(C1=__builtin_amdgcn_mfma_f32_32x32x16_bf16(kf[3],qr[1],C1,0,0,0),   P0[14],P0[15],P1[0],P1[1],   pw1[2]=PKW(P0,12),pw1[3]=PKW(P0,14), pw1); \
    VRD(2); SBAR(); GAPA(C0=__builtin_amdgcn_mfma_f32_32x32x16_bf16(kf[4],qr[2],C0,0,0,0),   P1[2],P1[3],P1[4],P1[5],     pw2[0]=PKW(P1,0), pw2[1]=PKW(P1,2), pw2); \
    VRD(6); SBAR(); GAPA(C1=__builtin_amdgcn_mfma_f32_32x32x16_bf16(kf[5],qr[2],C1,0,0,0),   P1[6],P1[7],P1[8],P1[9],     pw2[2]=PKW(P1,4), pw2[3]=PKW(P1,6), pw2); \
    VRD(3); SBAR(); GAPA(C0=__builtin_amdgcn_mfma_f32_32x32x16_bf16(kf[6],qr[3],C0,0,0,0),   P1[10],P1[11],P1[12],P1[13], pw3[0]=PKW(P1,8), pw3[1]=PKW(P1,10), pw3); \
    VRD(7); SBAR(); GAPA(C1=__builtin_amdgcn_mfma_f32_32x32x16_bf16(kf[7],qr[3],C1,0,0,0),   P1[14],P1[15],0.f,0.f,       pw3[2]=PKW(P1,12),pw3[3]=PKW(P1,14), pw3); \
    l_reg+=sacc; \
    if(GK){DMA_K((t)+3,sl_cur);} if(GV){DMA_V((t)+1,sl_next);} \
    CMASK(C0,C1,t); \
    { float a=MX3(C0[0],C0[1],C1[0]),b=MX3(C0[2],C0[3],C1[1]); a=MX3(a,C1[2],C1[3]); \
      _Pragma("unroll") for(int r=4;r<16;r+=4){a=MX3(a,C0[r],C0[r+1]);b=MX3(b,C0[r+2],C0[r+3]);a=MX3(a,C1[r],C1[r+1]);b=MX3(b,C1[r+2],C1[r+3]);} \
      float rm=__builtin_fmaxf(a,b); { auto rr=__builtin_amdgcn_permlane32_swap(__float_as_uint(rm),__float_as_uint(rm),false,false); rm=__builtin_fmaxf(__uint_as_float(rr[0]),__uint_as_float(rr[1])); } \
      resc=false; \
      if(__builtin_expect(__any(rm>(float)THRL),0)){ const float dl=__builtin_fmaxf(rm,0.f); mhat+=dl; \
        _Pragma("unroll") for(int r=0;r<16;++r){C0[r]-=dl;C1[r]-=dl;} \
        _Pragma("unroll") for(int r=0;r<16;++r)negm[r]=-mhat; asm volatile("":"+v"(negm)); \
        const float f=__builtin_amdgcn_exp2f(-dl); l_reg*=f; if(hi==0)wsf[r32]=f; resc=true; } } \
    SBAR(); \
    GAPB(o[0]=__builtin_amdgcn_mfma_f32_32x32x16_bf16(PAF(0),VFR(0),o[0],0,0,0), C0,0); \
    GAPB(o[1]=__builtin_amdgcn_mfma_f32_32x32x16_bf16(PAF(0),VFR(4),o[1],0,0,0), C0,4); \
    KRD(GL,0); GAPB(o[0]=__builtin_amdgcn_mfma_f32_32x32x16_bf16(PAF(1),VFR(1),o[0],0,0,0), C0,8); \
    KRD(GL,1); GAPB(o[1]=__builtin_amdgcn_mfma_f32_32x32x16_bf16(PAF(1),VFR(5),o[1],0,0,0), C0,12); \
    KRD(GL,2); GAPB(o[0]=__builtin_amdgcn_mfma_f32_32x32x16_bf16(PAF(2),VFR(2),o[0],0,0,0), C1,0); \
    KRD(GL,3); GAPB(o[1]=__builtin_amdgcn_mfma_f32_32x32x16_bf16(PAF(2),VFR(6),o[1],0,0,0), C1,4); \
    GAPB(o[0]=__builtin_amdgcn_mfma_f32_32x32x16_bf16(PAF(3),VFR(3),o[0],0,0,0), C1,8); \
    GAPB(o[1]=__builtin_amdgcn_mfma_f32_32x32x16_bf16(PAF(3),VFR(7),o[1],0,0,0), C1,12); \
    }while(0)
  int t=1;
  #undef CMASK
  #define CMASK(P0,P1,t) do{}while(0)
  for(;t+5<NT;t+=2){
    STEP(pB0,pB1,pA0,pA1,t,true,true,true);     WAIT_BAR(2); RESC(); ROT();
    STEP(pA0,pA1,pB0,pB1,t+1,true,true,true);   WAIT_BAR(2); RESC(); ROT();
  }
  #undef CMASK
  #define CMASK(P0,P1,t) do{}while(0)
  #define ENDW(tt) do{ if((tt)+3<NT){WAIT_BAR(2);} else if((tt)+2<NT){WAIT_BAR(1);} else {WAIT_BAR(0);} }while(0)
  for(;t+1<NT;t+=2){
    STEP(pB0,pB1,pA0,pA1,t,(t+3<NT),(t+1<NT),(t+1<NT));       ENDW(t);   RESC(); ROT();
    STEP(pA0,pA1,pB0,pB1,t+1,(t+4<NT),(t+2<NT),(t+2<NT));     ENDW(t+1); RESC(); ROT();
  }
  STEP(pB0,pB1,pA0,pA1,NT-1,false,false,false); RESC();
  { float sacc=pB0[0]+pB0[1]; _Pragma("unroll") for(int r=2;r<16;++r)sacc+=pB0[r]; _Pragma("unroll") for(int r=0;r<16;++r)sacc+=pB1[r]; l_reg+=sacc;
    pw0=(u32x4){PKW(pB0,0),PKW(pB0,2),PKW(pB0,4),PKW(pB0,6)};pw1=(u32x4){PKW(pB0,8),PKW(pB0,10),PKW(pB0,12),PKW(pB0,14)};pw2=(u32x4){PKW(pB1,0),PKW(pB1,2),PKW(pB1,4),PKW(pB1,6)};pw3=(u32x4){PKW(pB1,8),PKW(pB1,10),PKW(pB1,12),PKW(pB1,14)};
    SBAR(); pv(o,vb0+sl_cur,PAF(0),PAF(1),PAF(2),PAF(3)); }
  #undef PKW
  #undef PAF
  #undef VFR
  #undef PIN
  #undef MX3
  #undef GAPA
  #undef GAPB
  #undef EX
  #undef VRD
  #undef KRD
  #undef STEP
  #undef ENDW
  {auto rr=__builtin_amdgcn_permlane32_swap(__float_as_uint(l_reg),__float_as_uint(l_reg),false,false);l_reg=__uint_as_float(rr[0])+__uint_as_float(rr[1]);}
  if(hi==0)wsf[32+r32]=l_reg;asm volatile("s_waitcnt lgkmcnt(0)":::"memory");
  float rli[16];
  #pragma unroll
  for(int r=0;r<16;++r)rli[r]=__builtin_amdgcn_rcpf(wsf[32+crow(r,hi)]);
  bf16*Ow=O+(rowbase+q0+wid*QBLK)*DM+h*D;
  { bf16*stg=(bf16*)(shm+LDS_OST)+wid*2048;
    #pragma unroll
    for(int r=0;r<16;++r){const int orow=crow(r,hi);
      #pragma unroll
      for(int d0=0;d0<2;++d0)stg[orow*64+d0*32+r32]=__float2bfloat16(o[d0][r]*rli[r]);}
    asm volatile("s_waitcnt lgkmcnt(0)":::"memory");
    const bf16*Zw=Z+(rowbase+q0+wid*QBLK)*DM+h*D;
    #pragma unroll
    for(int i=0;i<4;++i){const int row=i*8+(lane>>3),ch=lane&7; u32x4 v=*(const u32x4*)(stg+row*64+ch*8); const u32x4 z=*(const u32x4*)(Zw+(long)row*DM+ch*8);
      _Pragma("unroll") for(int e=0;e<4;++e){ const float z0=__uint_as_float(z[e]<<16), z1=__uint_as_float(z[e]&0xffff0000u); const float v0=__uint_as_float(v[e]<<16), v1=__uint_as_float(v[e]&0xffff0000u);
        const float g0=z0*__builtin_amdgcn_rcpf(1.f+__expf(-z0)), g1=z1*__builtin_amdgcn_rcpf(1.f+__expf(-z1)); v[e]=cvtpk_s(v0*g0,v1*g1); }
      ATTN_STORE16(Ow+(long)row*DM+ch*8,v);} }
  asm volatile("s_waitcnt lgkmcnt(0)\n\ts_barrier":::"memory");
  #undef DMA_K
  #undef DMA_V
  #undef CMASK
  #undef START
  #undef RESC
  #undef ROT
}
constexpr int ATTN_LDS_BYTES=LDS_BYTES;
struct AttnTensors { const bf16* Q; const bf16* K; const bf16* V; bf16* O; const bf16* Z; };
struct AttnUnit { int b; int h; int qb; };
template<int THRL=8> __device__ __forceinline__ void attn_phase(char*lds,const AttnTensors&T,int vcu,int G,const int wave_id){
  const int x=vcu>>5,c=vcu&31;
  #pragma unroll 1
  for(int i=0;i<6;++i){ const int pair=x*3+(i>>1),u=(i&1)*32+c; attn_unit<THRL>(pair>>1,(pair&1)*4+(u>>4),u&15,T.Q,T.K,T.V,T.O,T.Z,lds,wave_id); }
}
#undef SBAR
#undef WAIT_BAR
}
constexpr int NWAVES = 8;
constexpr int DM_ = 1024, DEPTH = 4, SEQ_ = 4096, MTOT = 98304, MH = 49152, NPROMPT = 65536, PITCH = 5888, PLE = 256;
constexpr int C_QA = 0, C_KA = 512, C_VA = 640, C_ZA = 768, C_QB = 1280, C_KB = 2048, C_VB = 2816, C_ZB = 3584, C_GA = 3840, C_GB = 4864;
constexpr size_t MiB = 1u << 20;
constexpr size_t WS_SS = 0;
constexpr size_t WS_TAX = 4 * MiB;
constexpr size_t WS_T1D = 4 * MiB + 65536;
constexpr size_t WS_W = 8 * MiB;
constexpr size_t WL_IN = 0, WL_A = (size_t)5888 * 1024 * 2, WL_B = WL_A + 1 * MiB, WL_O = WL_B + MiB / 2, WL_PLE = WL_O + 2 * MiB, WL_PG = WL_PLE + MiB / 2, WL_STRIDE = WL_PG + 2 * MiB;
constexpr size_t WS_LSE = 80 * MiB;
constexpr size_t WS_OBG = 84 * MiB;
constexpr size_t WS_PB = 108 * MiB;
constexpr size_t WS_BUFA = 132 * MiB;
constexpr size_t WS_PROJ = 228 * MiB;
constexpr size_t WS_HG = 780 * MiB;
constexpr size_t WS_EB = 876 * MiB;
constexpr size_t WS_END = 972 * MiB;
static_assert(WS_W + 4 * WL_STRIDE <= WS_LSE, "weights");
constexpr int LDS_BYTES = 147456;
#define LAS __attribute__((address_space(3)))
typedef unsigned short bf16;
typedef unsigned v4u __attribute__((ext_vector_type(4)));
typedef float f32x4 __attribute__((ext_vector_type(4)));
typedef float f32x16 __attribute__((ext_vector_type(16)));
typedef short bf16x8 __attribute__((ext_vector_type(8)));
typedef short s16x4 __attribute__((ext_vector_type(4)));
typedef float f32x2 __attribute__((ext_vector_type(2)));
__device__ __forceinline__ unsigned f2bf(float f) { unsigned u = __builtin_bit_cast(unsigned, f); return (u + 0x7fffu + ((u >> 16) & 1u)) >> 16; }
__device__ __forceinline__ unsigned pk2(float lo, float hi) { return f2bf(lo) | (f2bf(hi) << 16); }
__device__ __forceinline__ float blo(unsigned w) { return __uint_as_float(w << 16); }
__device__ __forceinline__ float bhi(unsigned w) { return __uint_as_float(w & 0xffff0000u); }
__device__ __forceinline__ float wave_sum(float v, int lane) {
#pragma unroll
    for (int o = 1; o < 64; o <<= 1) v += shx(v, lane, o);
    return v;
}
constexpr float C2F = 0.125f * 1.4426950408889634f;

struct Args { const float* in[15]; float* out; unsigned char* ws; };

__device__ __forceinline__ void transpose_item(const float* W, int K, int N, bf16* WT, LAS float* scr, int item, int lane) {
    const int nblk = N / 32, kb = item / nblk, nb = item % nblk, k0 = 64 * kb, n0 = 32 * nb;
#pragma unroll 8
    for (int i = 0; i < 32; ++i) { const int kk = 2 * i + (lane >> 5); scr[kk * 33 + (lane & 31)] = W[(size_t)(k0 + kk) * N + n0 + (lane & 31)]; }
    asm volatile("s_waitcnt lgkmcnt(0)" ::: "memory");
    const int c = lane & 7;
#pragma unroll
    for (int j = 0; j < 4; ++j) { const int n = (lane >> 3) + 8 * j; const LAS float* s = scr + (8 * c) * 33 + n;
        v4u o; o.x = pk2(s[0 * 33], s[1 * 33]); o.y = pk2(s[2 * 33], s[3 * 33]); o.z = pk2(s[4 * 33], s[5 * 33]); o.w = pk2(s[6 * 33], s[7 * 33]);
        *(v4u*)(WT + (size_t)(n0 + n) * K + k0 + 8 * c) = o; }
    asm volatile("s_waitcnt lgkmcnt(0)" ::: "memory");
}

__device__ __forceinline__ int crow(int r, int hi) { return (r & 3) + 8 * (r >> 2) + 4 * hi; }
__device__ __forceinline__ s16x4 vtr(const LAS char* p) { typedef short v4i16_t __attribute__((ext_vector_type(4))); return __builtin_bit_cast(s16x4, __builtin_amdgcn_ds_read_tr16_b64_v4i16((LAS v4i16_t*)p)); }
__device__ __forceinline__ unsigned cvtpk(float lo, float hi) { typedef __bf16 bf16x2_t __attribute__((ext_vector_type(2))); f32x2 v = {lo, hi}; bf16x2_t b = __builtin_convertvector(v, bf16x2_t); return __builtin_bit_cast(unsigned, b); }
__device__ __forceinline__ void attnb_unit(bf16* P, float* LSE, int b, int hb, int tau, LAS char* wl, int lane) {
    const int g = hb >> 2, sh = 2 * g, L = 4096 >> sh, tprs = 7 - sh;
    const int r = tau >> tprs, m0 = 32 * (tau & ((1 << tprs) - 1));
    const int r32 = lane & 31, hi = lane >> 5;
    const size_t rowbase = (size_t)b * 4096;
    const int tq = r + ((m0 + r32) << sh);
    bf16x8 qf[4];
    { const bf16* qp = P + (rowbase + tq) * PITCH + C_QB + hb * 64 + hi * 8;
#pragma unroll
      for (int d0 = 0; d0 < 4; ++d0) qf[d0] = *(const bf16x8*)(qp + d0 * 16); }
    f32x16 S[5];
#pragma unroll
    for (int kb = 0; kb < 5; ++kb) {
        int mk = m0 - 64 + 32 * kb + r32; mk = mk < 0 ? 0 : (mk > L - 1 ? L - 1 : mk);
        const bf16* kp = P + (rowbase + r + (mk << sh)) * PITCH + C_KB + hb * 64 + hi * 8;
        bf16x8 kf[4];
#pragma unroll
        for (int d0 = 0; d0 < 4; ++d0) kf[d0] = *(const bf16x8*)(kp + d0 * 16);
        f32x16 s = {};
#pragma unroll
        for (int d0 = 0; d0 < 4; ++d0) s = __builtin_amdgcn_mfma_f32_32x32x16_bf16(kf[d0], qf[d0], s, 0, 0, 0);
        S[kb] = s;
    }
    const int mq = m0 + r32; float mx = -INFINITY;
#pragma unroll
    for (int kb = 0; kb < 5; ++kb)
#pragma unroll
        for (int q = 0; q < 16; ++q) { const int mk = m0 - 64 + 32 * kb + crow(q, hi); const int dd = mk - mq; const bool ok = (mk >= 0) && (mk < L) && (dd <= 64) && (dd >= -64);
            const float v = ok ? S[kb][q] : -INFINITY; S[kb][q] = v; mx = fmaxf(mx, v); }
    mx = fmaxf(mx, shx(mx, lane, 32));
    float l = 0.f;
#pragma unroll
    for (int kb = 0; kb < 5; ++kb)
#pragma unroll
        for (int q = 0; q < 16; ++q) { const float p = __builtin_amdgcn_exp2f(S[kb][q] - mx); S[kb][q] = p; l += p; }
    l += shx(l, lane, 32);
    f32x16 o0 = {}, o1 = {};
    const LAS char* vrd = wl + ((lane >> 4) & 1) * 32 + (lane & 3) * 8 + (4 * hi + ((lane & 15) >> 2)) * 64;
#pragma unroll
    for (int kb = 0; kb < 5; ++kb) {
        asm volatile("" ::: "memory");
#pragma unroll
        for (int j = 0; j < 4; ++j) { const int idx = lane + 64 * j, key = idx >> 3, c = idx & 7;
            int mk = m0 - 64 + 32 * kb + key; mk = mk < 0 ? 0 : (mk > L - 1 ? L - 1 : mk);
            const v4u vv = *(const v4u*)(P + (rowbase + r + (mk << sh)) * PITCH + C_VB + hb * 64 + c * 8);
            *(LAS v4u*)(wl + (c >> 2) * 2048 + (key >> 3) * 512 + (key & 7) * 64 + (c & 3) * 16) = vv; }
        asm volatile("s_waitcnt lgkmcnt(0)" ::: "memory");
#pragma unroll
        for (int s = 0; s < 2; ++s) {
            v4u pw; pw.x = cvtpk(S[kb][8 * s + 0], S[kb][8 * s + 1]); pw.y = cvtpk(S[kb][8 * s + 2], S[kb][8 * s + 3]); pw.z = cvtpk(S[kb][8 * s + 4], S[kb][8 * s + 5]); pw.w = cvtpk(S[kb][8 * s + 6], S[kb][8 * s + 7]);
            const bf16x8 pa = __builtin_bit_cast(bf16x8, pw);
            { const s16x4 lo = vtr(vrd + (2 * s) * 512), hh = vtr(vrd + (2 * s + 1) * 512);
              const bf16x8 vf = (bf16x8){lo[0], lo[1], lo[2], lo[3], hh[0], hh[1], hh[2], hh[3]};
              o0 = __builtin_amdgcn_mfma_f32_32x32x16_bf16(pa, vf, o0, 0, 0, 0); }
            { const s16x4 lo = vtr(vrd + 2048 + (2 * s) * 512), hh = vtr(vrd + 2048 + (2 * s + 1) * 512);
              const bf16x8 vf = (bf16x8){lo[0], lo[1], lo[2], lo[3], hh[0], hh[1], hh[2], hh[3]};
              o1 = __builtin_amdgcn_mfma_f32_32x32x16_bf16(pa, vf, o1, 0, 0, 0); }
        }
        asm volatile("s_waitcnt lgkmcnt(0)" ::: "memory");
    }
    LAS float* wsf = (LAS float*)(wl + 4096);
    if (hi == 0) { wsf[r32] = l; LSE[(rowbase + tq) * 12 + hb] = mx + __builtin_amdgcn_logf(l); }
    asm volatile("s_waitcnt lgkmcnt(0)" ::: "memory");
    LAS bf16* stg = (LAS bf16*)wl;
#pragma unroll
    for (int q = 0; q < 16; ++q) { const int orow = crow(q, hi); const float rl = __builtin_amdgcn_rcpf(wsf[orow]);
        stg[orow * 64 + r32] = (bf16)f2bf(o0[q] * rl); stg[orow * 64 + 32 + r32] = (bf16)f2bf(o1[q] * rl); }
    asm volatile("s_waitcnt lgkmcnt(0)" ::: "memory");
#pragma unroll
    for (int i = 0; i < 4; ++i) { const int row = i * 8 + (lane >> 3), ch = lane & 7; const v4u v = *(const LAS v4u*)(wl + row * 128 + ch * 16);
        *(v4u*)(P + (rowbase + r + ((m0 + row) << sh)) * PITCH + C_QB + hb * 64 + ch * 8) = v; }
    asm volatile("s_waitcnt lgkmcnt(0)" ::: "memory");
}

__global__ void __launch_bounds__(NWAVES * 64, 2) fwd_mega(Args args) {
    extern __shared__ __attribute__((aligned(16))) unsigned char lds[];
    cg::grid_group grid = cg::this_grid();
    LAS unsigned char* ldsl = (LAS unsigned char*)lds;
    const int wave = __builtin_amdgcn_readfirstlane(threadIdx.x >> 6); int tidv = wave * 64 + lane_now();
#define LAUNDER() do { tidv = wave * 64 + lane_now(); asm volatile("" : "+s"(bxv)); } while (0)
#define lane (tidv & 63)
#define gt (bx * (NWAVES * 64) + tidv)
    const int G = gridDim.x; int bxv = blockIdx.x; asm volatile("" : "+s"(bxv));
#define bx bxv
#define vcu ((bxv % 8) * (G / 8) + bxv / 8)
#define gw (vcu * NWAVES + wave)
    const int NGW = G * NWAVES;
    const int NGT = G * NWAVES * 64;
    unsigned char* ws = args.ws;
    const float* x_prompt = args.in[0]; const float* x_sample = args.in[1]; const float* p_prompt = args.in[2]; const float* p_sample = args.in[3];
    const float* g_norm = args.in[4]; const float* w_in = args.in[5]; const float* g_q = args.in[6]; const float* g_k = args.in[7];
    const float* w_a = args.in[8]; const float* w_b = args.in[9]; const float* w_o = args.in[10]; const float* w_ple = args.in[11];
    const float* g_ple = args.in[12]; const float* w_pg = args.in[13]; const float* g_final = args.in[14];
    float* H = args.out;
    float* SS = (float*)(ws + WS_SS);
    f32x2* TAX = (f32x2*)(ws + WS_TAX); f32x2* T1D = (f32x2*)(ws + WS_T1D);
    float* LSE = (float*)(ws + WS_LSE);
    bf16* OBG = (bf16*)(ws + WS_OBG); bf16* PB = (bf16*)(ws + WS_PB); bf16* BUFA = (bf16*)(ws + WS_BUFA); bf16* PROJ = (bf16*)(ws + WS_PROJ);
    bf16* HG = (bf16*)(ws + WS_HG); bf16* EB = (bf16*)(ws + WS_EB);

    for (int i = gt + MTOT / 4; i < 9 * MTOT / 4; i += NGT) ((f32x4*)SS)[i] = (f32x4){0.f, 0.f, 0.f, 0.f};
    for (int i = gt; i < 64 * 16 + 4096 * 32; i += NGT) {
        int pos, k; float ex; f32x2* dst;
        if (i < 1024) { pos = i >> 4; k = i & 15; ex = (float)(2 * k) / 32.f; dst = TAX + i; }
        else { const int j = i - 1024; pos = j >> 5; k = j & 31; ex = (float)(2 * k) / 64.f; dst = T1D + j; }
        const float freq = exp2f(-ex * 13.287712379549449f);
        double rev = (double)pos * (double)freq * 0.15915494309189535; rev -= floor(rev);
        const float rf = (float)rev;
        *dst = (f32x2){__builtin_amdgcn_cosf(rf), __builtin_amdgcn_sinf(rf)};
    }
    {
        LAS float* scr = (LAS float*)(ldsl + wave * 16384);
        constexpr int I_IN = 16 * 184, I_A = 8 * 32, I_B = 4 * 32, I_O = 16 * 32, I_PLE = 4 * 32, I_PG = 16 * 32, I_L = I_IN + I_A + I_B + I_O + I_PLE + I_PG;
        for (int it = gw; it < DEPTH * I_L; it += NGW) {
            const int layer = it / I_L; int r = it % I_L; unsigned char* wl = ws + WS_W + (size_t)layer * WL_STRIDE;
            if (r < I_IN) { transpose_item(w_in + (size_t)layer * 1024 * 5888, 1024, 5888, (bf16*)(wl + WL_IN), scr, r, lane); continue; } r -= I_IN;
            if (r < I_A) { transpose_item(w_a + (size_t)layer * 512 * 1024, 512, 1024, (bf16*)(wl + WL_A), scr, r, lane); continue; } r -= I_A;
            if (r < I_B) { transpose_item(w_b + (size_t)layer * 256 * 1024, 256, 1024, (bf16*)(wl + WL_B), scr, r, lane); continue; } r -= I_B;
            if (r < I_O) { transpose_item(w_o + (size_t)layer * 1024 * 1024, 1024, 1024, (bf16*)(wl + WL_O), scr, r, lane); continue; } r -= I_O;
            if (r < I_PLE) { transpose_item(w_ple + (size_t)layer * 256 * 1024, 256, 1024, (bf16*)(wl + WL_PLE), scr, r, lane); continue; } r -= I_PLE;
            transpose_item(w_pg + (size_t)layer * 1024 * 1024, 1024, 1024, (bf16*)(wl + WL_PG), scr, r, lane);
        }
    }

#pragma unroll 1
    for (int half = 0; half < 2; ++half) {
        const int grow0 = half * MH;
            LAUNDER();
        for (int lr = gw; lr < MH; lr += NGW) {
            const int gr = grow0 + lr; const float* xr = gr < NPROMPT ? x_prompt + (size_t)gr * 1024 : x_sample + (size_t)(gr - NPROMPT) * 1024;
            f32x4 v[4]; float s = 0.f;
#pragma unroll
            for (int j = 0; j < 4; ++j) { v[j] = ((const f32x4*)xr)[lane + 64 * j]; s += (v[j].x * v[j].x + v[j].y * v[j].y) + (v[j].z * v[j].z + v[j].w * v[j].w); }
            s = wave_sum(s, lane); if (lane == 0) SS[gr] = s;
#pragma unroll
            for (int j = 0; j < 4; ++j) { ((f32x4*)(H + (size_t)gr * 1024))[lane + 64 * j] = v[j]; const f32x4 gg = ((const f32x4*)g_norm)[lane + 64 * j];
                ((unsigned long long*)(BUFA + (size_t)lr * 1024))[lane + 64 * j] = (unsigned long long)pk2(v[j].x * gg.x, v[j].y * gg.y) | ((unsigned long long)pk2(v[j].z * gg.z, v[j].w * gg.w) << 32); }
        }
        grid.sync();
#pragma unroll 1
        for (int layer = 0; layer < DEPTH; ++layer) {
            unsigned char* wl = ws + WS_W + (size_t)layer * WL_STRIDE;
            LAUNDER();
            { pg8::Gemm g{BUFA, (const bf16*)(wl + WL_IN), MH, PITCH, 1024, 1024}; pg8::StaticOrder S; S.init(MH, PITCH, G, bx);
              pg8::EpiProj E{PROJ, PITCH, SS + (size_t)layer * MTOT, grow0};
              pg8::gemm_phase<pg8::EpiProj, pg8::StaticOrder, true, true>(ldsl, g, S, E, wave); }
            grid.sync();
            LAUNDER();
            for (int it0 = 0; it0 < MH * 272; it0 += NGT) {
                const int it = it0 + gt; const bool live = it < MH * 272; const int itc = live ? it : 0;
                const int lr = itc / 272, cid = itc - lr * 272, hd = cid >> 3, c = cid & 7, t = lr & 4095;
                const int col = hd < 8 ? hd * 64 : hd < 10 ? C_KA + (hd - 8) * 64 : hd < 22 ? C_QB + (hd - 10) * 64 : C_KB + (hd - 22) * 64;
                bf16* ptr = PROJ + (size_t)lr * PITCH + col + c * 8;
                const v4u w = *(const v4u*)ptr; float v[8] = {blo(w.x), bhi(w.x), blo(w.y), bhi(w.y), blo(w.z), bhi(w.z), blo(w.w), bhi(w.w)};
                const bool isA = hd < 10;
                float ssq = 0.f;
#pragma unroll
                for (int i = 0; i < 8; ++i) ssq += v[i] * v[i];
                ssq += shx(ssq, lane, 1); ssq += shx(ssq, lane, 2); ssq += shx(ssq, lane, 4);
                const float rs = isA ? __builtin_amdgcn_rsqf(ssq * (1.f / 64.f) + 1e-6f) : 1.f;
                const float* gvp = (hd < 8 ? g_q : g_k) + layer * 64 + 8 * c;
                const f32x2* tab = isA ? TAX + ((c < 4) ? (t >> 6) : (t & 63)) * 16 + 8 * (c & 1) : T1D + t * 32 + 8 * (c & 3);
                const bool neg = isA ? ((c & 2) == 0) : (c < 4);
                const float osc = (hd < 8 || (hd >= 10 && hd < 22)) ? C2F : 1.f;
                float y[8];
#pragma unroll
                for (int i = 0; i < 8; ++i) { const float vi = isA ? v[i] * rs * gvp[i] : v[i];
                    const float pa = shx(vi, lane, 2), pb = shx(vi, lane, 4); const float pr = isA ? pa : pb;
                    const f32x2 cs = tab[i]; y[i] = (vi * cs.x + (neg ? -pr : pr) * cs.y) * osc; }
                if (live) { v4u o; o.x = pk2(y[0], y[1]); o.y = pk2(y[2], y[3]); o.z = pk2(y[4], y[5]); o.w = pk2(y[6], y[7]); *(v4u*)ptr = o; }
            }
            for (int it = gt; it < MH * 32; it += NGT) {
                const int lr = it >> 5, c = it & 31, gr = grow0 + lr;
                const float* pr = gr < NPROMPT ? p_prompt + ((size_t)layer * NPROMPT + gr) * PLE : p_sample + ((size_t)layer * (MTOT - NPROMPT) + (gr - NPROMPT)) * PLE;
                const f32x4 a = ((const f32x4*)pr)[2 * c], bq = ((const f32x4*)pr)[2 * c + 1];
                v4u o; o.x = pk2(a.x, a.y); o.y = pk2(a.z, a.w); o.z = pk2(bq.x, bq.y); o.w = pk2(bq.z, bq.w); *(v4u*)(PB + (size_t)lr * PLE + c * 8) = o;
            }
            grid.sync();
            LAUNDER();
            { const attn_body::AttnTensors AT{(const attn_body::bf16*)(PROJ + C_QA), (const attn_body::bf16*)(PROJ + C_KA), (const attn_body::bf16*)(PROJ + C_VA), (attn_body::bf16*)(PROJ + C_QA), (const attn_body::bf16*)(PROJ + C_ZA)};
              attn_body::attn_phase<8>((char*)lds, AT, vcu, G, wave); }
            __syncthreads();
            LAUNDER();
            { LAS char* wlds = (LAS char*)(ldsl + wave * 8448);
              for (int u = gw; u < 12 * 12 * 128; u += NGW) { const int b = u / 1536, rem = u - b * 1536; attnb_unit(PROJ, LSE, b, rem >> 7, rem & 127, wlds, lane); } }
            grid.sync();
            LAUNDER();
            for (int it = gt; it < MH * 32; it += NGT) {
                const int lr = it >> 5, cc = it & 31, hh = cc >> 3, c = cc & 7;
                const float l0 = LSE[(size_t)lr * 12 + hh], l1 = LSE[(size_t)lr * 12 + 4 + hh], l2 = LSE[(size_t)lr * 12 + 8 + hh];
                const float mx = fmaxf(l0, fmaxf(l1, l2)); float w0 = __builtin_amdgcn_exp2f(l0 - mx), w1 = __builtin_amdgcn_exp2f(l1 - mx), w2 = __builtin_amdgcn_exp2f(l2 - mx);
                const float inv = __builtin_amdgcn_rcpf(w0 + w1 + w2); w0 *= inv; w1 *= inv; w2 *= inv;
                const bf16* rp = PROJ + (size_t)lr * PITCH;
                const v4u a = *(const v4u*)(rp + C_QB + hh * 64 + c * 8), bq = *(const v4u*)(rp + C_QB + (4 + hh) * 64 + c * 8), cq = *(const v4u*)(rp + C_QB + (8 + hh) * 64 + c * 8), z = *(const v4u*)(rp + C_ZB + hh * 64 + c * 8);
                v4u o;
#pragma unroll
                for (int e = 0; e < 4; ++e) { const float z0 = blo(z[e]), z1 = bhi(z[e]);
                    const float s0 = z0 * __builtin_amdgcn_rcpf(1.f + __expf(-z0)), s1 = z1 * __builtin_amdgcn_rcpf(1.f + __expf(-z1));
                    o[e] = pk2((w0 * blo(a[e]) + w1 * blo(bq[e]) + w2 * blo(cq[e])) * s0, (w0 * bhi(a[e]) + w1 * bhi(bq[e]) + w2 * bhi(cq[e])) * s1); }
                *(v4u*)(OBG + (size_t)lr * 256 + hh * 64 + c * 8) = o;
            }
            grid.sync();
            LAUNDER();
            { pg8::Gemm g{PROJ + C_QA, (const bf16*)(wl + WL_A), MH, 1024, 512, PITCH}; pg8::StaticOrder S; S.init(MH, 1024, G, bx);
              pg8::EpiGate<false> E{BUFA, 1024, PROJ + C_GA, PITCH};
              pg8::gemm_phase<pg8::EpiGate<false>, pg8::StaticOrder, true, true>(ldsl, g, S, E, wave); }
            LAUNDER();
            { pg8::Gemm g{OBG, (const bf16*)(wl + WL_B), MH, 1024, 256, 256}; pg8::StaticOrder S; S.init(MH, 1024, G, bx);
              pg8::EpiGate<true> E{BUFA, 1024, PROJ + C_GB, PITCH};
              pg8::gemm_phase<pg8::EpiGate<true>, pg8::StaticOrder, true, true>(ldsl, g, S, E, wave); }
            grid.sync();
            LAUNDER();
            { pg8::Gemm g{BUFA, (const bf16*)(wl + WL_O), MH, 1024, 1024, 1024}; pg8::StaticOrder S; S.init(MH, 1024, G, bx);
              pg8::EpiResid<false> E{H, nullptr, SS + (size_t)(5 + layer) * MTOT, nullptr, HG, g_ple + layer * 1024, grow0};
              pg8::gemm_phase<pg8::EpiResid<false>, pg8::StaticOrder, true, true>(ldsl, g, S, E, wave); }
            LAUNDER();
            { pg8::Gemm g{PB, (const bf16*)(wl + WL_PLE), MH, 1024, 256, 256}; pg8::StaticOrder S; S.init(MH, 1024, G, bx);
              pg8::EpiPlain E{EB, 1024};
              pg8::gemm_phase<pg8::EpiPlain, pg8::StaticOrder, true, true>(ldsl, g, S, E, wave); }
            grid.sync();
            LAUNDER();
            { pg8::Gemm g{HG, (const bf16*)(wl + WL_PG), MH, 1024, 1024, 1024}; pg8::StaticOrder S; S.init(MH, 1024, G, bx);
              pg8::EpiResid<true> E{H, SS + (size_t)(5 + layer) * MTOT, SS + (size_t)(layer + 1) * MTOT, EB, layer < DEPTH - 1 ? BUFA : nullptr, g_norm + (layer < DEPTH - 1 ? layer + 1 : 0) * 1024, grow0};
              pg8::gemm_phase<pg8::EpiResid<true>, pg8::StaticOrder, true, true>(ldsl, g, S, E, wave); }
            grid.sync();
        }
    }
            LAUNDER();
    for (int gr = gw; gr < MTOT; gr += NGW) {
        const float rs = __builtin_amdgcn_rsqf(SS[(size_t)4 * MTOT + gr] * (1.f / 1024.f) + 1e-6f);
#pragma unroll
        for (int j = 0; j < 4; ++j) { f32x4 v = ((const f32x4*)(H + (size_t)gr * 1024))[lane + 64 * j]; const f32x4 gg = ((const f32x4*)g_final)[lane + 64 * j];
            v = v * gg * rs; ((f32x4*)(H + (size_t)gr * 1024))[lane + 64 * j] = v; }
    }
}

#undef lane
#undef gt
#undef bx
#undef vcu
#undef gw
extern "C" void kernel_launch(void* const* d_in, const int* in_sizes, int n_in, void* d_out, int out_size, void* d_ws, size_t ws_size, hipStream_t stream) {
    static int grid = 0;
    if (grid == 0) {
        if (n_in != 15 || out_size != MTOT * DM_ || ws_size < WS_END) { fprintf(stderr, "kernel_launch: unexpected shapes (n_in %d out %d ws %zu)\n", n_in, out_size, ws_size); grid = -1; return; }
        int dev = 0, cus = 0, per_cu = 0;
        (void)hipGetDevice(&dev); (void)hipDeviceGetAttribute(&cus, hipDeviceAttributeMultiprocessorCount, dev);
        (void)hipFuncSetAttribute((const void*)fwd_mega, hipFuncAttributeMaxDynamicSharedMemorySize, LDS_BYTES);
        (void)hipOccupancyMaxActiveBlocksPerMultiprocessor(&per_cu, (const void*)fwd_mega, NWAVES * 64, LDS_BYTES);
        if (per_cu < 1) per_cu = 1;
        grid = cus * per_cu;
        (void)hipGetLastError();
    }
    if (grid < 0) return;
    Args a{};
    for (int i = 0; i < 15; ++i) a.in[i] = (const float*)d_in[i];
    a.out = (float*)d_out; a.ws = (unsigned char*)d_ws;
    void* kargs[] = {&a};
    hipError_t e = hipLaunchCooperativeKernel((const void*)fwd_mega, dim3(grid), dim3(NWAVES * 64), kargs, LDS_BYTES, stream);
    if (e != hipSuccess) fprintf(stderr, "cooperative launch failed: %s (grid %d)\n", hipGetErrorString(e), grid);
}
```

```cpp
#include <hip/hip_runtime.h>
#include <hip/hip_cooperative_groups.h>
namespace cg = cooperative_groups;
__device__ __forceinline__ float shx(float v, int lane, int m) { return __builtin_bit_cast(float, __builtin_amdgcn_ds_bpermute((lane ^ m) << 2, __builtin_bit_cast(int, v))); }
__device__ __forceinline__ int lane_now() { int l; asm volatile("v_mbcnt_lo_u32_b32 %0, -1, 0\n\tv_mbcnt_hi_u32_b32 %0, -1, %0" : "=v"(l)); return l; }
#include <hip/hip_runtime.h>
#include <cstdio>
#include <cstdint>
namespace pg8 {
#define PG8_LAS __attribute__((address_space(3)))
typedef unsigned short bf16_t;
typedef short bf16x8 __attribute__((ext_vector_type(8)));
typedef float f32x4 __attribute__((ext_vector_type(4)));
typedef unsigned u32x4 __attribute__((ext_vector_type(4)));
constexpr int BM = 256, BK = 64, HALF = 128, HTB = HALF * BK * 2  , STAGE_BYTES = 8 * HTB, NXCD = 8, WGM = 8;

__host__ __device__ __forceinline__ int lds_byte(int r, int c) { const int st = (r >> 4) * 2 + (c >> 5), rr = r & 15, cc = c & 31, ob = rr * 64 + cc * 2; return st * 1024 + (ob ^ (((ob >> 9) & 1) << 5)); }
__host__ __device__ __forceinline__ void stage_rc(int b, int& R, int& C) { const int st = b / 1024, sb = b % 1024, swz = sb ^ (((sb >> 9) & 1) << 5); R = (st >> 1) * 16 + swz / 64; C = (st & 1) * 32 + (swz % 64) / 2; }
__host__ __device__ __forceinline__ int perm32(int rho) { const int n = rho >> 4, i = rho & 15; return 8 * (i >> 2) + 4 * n + (i & 3); }

struct Unit { int pm, pn; };
struct Gemm { const bf16_t* A; const bf16_t* Bt; int M, N, K, lda; };

struct StaticOrder {
    int nM, nN, nwg, G, c;
    __host__ __device__ void init(int M, int N, int G_, int c_) { nM = M / BM; nN = N / BM; nwg = nM * nN; G = G_; c = c_; }
    __host__ __device__ bool next(int i, Unit& u) const {
        const long L = (long)i * G + c; if (L >= nwg) return false;
        int wgid = (int)L; { const int q = nwg / NXCD, r = nwg % NXCD, xcd = wgid % NXCD, off = wgid / NXCD; wgid = (xcd < r ? xcd * (q + 1) : r * (q + 1) + (xcd - r) * q) + off; }
        const int nig = WGM * nN, gid = wgid / nig, fm = gid * WGM, gsz = (nM - fm) < WGM ? (nM - fm) : WGM;
        u.pm = fm + ((wgid % nig) % gsz); u.pn = (wgid % nig) / gsz; return true;
    }
    __device__ __forceinline__ void a_ready(const Unit&) const {}
    __device__ __forceinline__ void done(const Unit&) const {}
};

template <class Epi, class Sched, bool ALIGN_EPI = false, bool SP2 = false>
__device__ __forceinline__ void gemm_phase(PG8_LAS unsigned char* lds, const Gemm g, const Sched& S, const Epi& E, const int wave_id) {
    const int tid = wave_id * 64 + lane_now(), wid = wave_id, lane = tid & 63, wr = wid >> 2, wc = wid & 3, fr = lane & 15, fq = lane >> 4;
    const int K = g.K, nt = K / BK;
    unsigned voffA[2], voffB[2];
#pragma unroll
    for (int i = 0; i < 2; ++i) { int R, C; stage_rc(tid * 16 + i * 8192, R, C); const int Rb = Epi::PERM ? ((R & ~31) + perm32(R & 31)) : R;
        voffA[i] = (unsigned)(R * g.lda + C) * 2u; voffB[i] = (unsigned)(Rb * K + C) * 2u; }
    const size_t kstep = (size_t)(BK * 2);
    const size_t hstep = (size_t)HALF * K * 2;
    const size_t tstep = 2 * hstep; const size_t hstepA = (size_t)HALF * g.lda * 2, tstepA = 2 * hstepA;
    const unsigned ldsw = (unsigned)wid * 1024u;
    const int aoff = lds_byte(wr * 64 + fr, fq * 8), boff = lds_byte(wc * 32 + fr, fq * 8);
#define PG8_SA(b, h) (((b) * 2 + (h)) * HTB)
#define PG8_SB(b, h) ((4 + (b) * 2 + (h)) * HTB)
#define PG8_STAGE(bufoff, gbase, voff) do { _Pragma("unroll") for (int _i = 0; _i < 2; ++_i) \
        __builtin_amdgcn_global_load_lds((const unsigned*)((const char*)(gbase) + (voff)[_i]), (PG8_LAS unsigned*)(lds + (bufoff) + ldsw + _i * 8192), 16, 0, 0); } while (0)
#define PG8_LDA(dst, b, h) do { _Pragma("unroll") for (int m = 0; m < 4; ++m) _Pragma("unroll") for (int k = 0; k < 2; ++k) dst[m][k] = *(const PG8_LAS bf16x8*)(lds + PG8_SA(b, h) + aoff + m * 2048 + k * 1024); } while (0)
#define PG8_LDB(dst, b, h) do { _Pragma("unroll") for (int n = 0; n < 2; ++n) _Pragma("unroll") for (int k = 0; k < 2; ++k) dst[n][k] = *(const PG8_LAS bf16x8*)(lds + PG8_SB(b, h) + boff + n * 2048 + k * 1024); } while (0)
#define PG8_MMA(ai, bj, At, Bt) do { __builtin_amdgcn_s_setprio(1); _Pragma("unroll") for (int m = 0; m < 4; ++m) _Pragma("unroll") for (int n = 0; n < 2; ++n) _Pragma("unroll") for (int k = 0; k < 2; ++k) \
        acc[ai][bj][m][n] = __builtin_amdgcn_mfma_f32_16x16x32_bf16(Bt[n][k], At[m][k], acc[ai][bj][m][n], 0, 0, 0); __builtin_amdgcn_s_setprio(0); } while (0)
#define PG8_WAIT_V(n) asm volatile("s_waitcnt vmcnt(" #n ")" ::: "memory")
#define PG8_WAIT_L(n) asm volatile("s_waitcnt lgkmcnt(" #n ")" ::: "memory")
#define PG8_BAR __builtin_amdgcn_s_barrier()
#define PG8_SCHED __builtin_amdgcn_sched_barrier(0)
    Unit cur, nxt; int ui = 0;
    if (!S.next(0, cur)) return;
    f32x4 acc[2][2][4][2];
#pragma unroll
    for (int a = 0; a < 2; ++a)
#pragma unroll
        for (int b = 0; b < 2; ++b)
#pragma unroll
            for (int m = 0; m < 4; ++m)
#pragma unroll
                for (int n = 0; n < 2; ++n) acc[a][b][m][n] = (f32x4){0.f, 0.f, 0.f, 0.f};
    bf16x8 At[4][2], B0[2][2], B1[2][2];
    const char* cA = (const char*)g.A + (size_t)cur.pm * tstepA; const char* cB = (const char*)g.Bt + (size_t)cur.pn * tstep;
    S.a_ready(cur);
    if constexpr (SP2) {
        PG8_STAGE(PG8_SB(0, 0), cB, voffB); PG8_STAGE(PG8_SB(0, 1), cB + hstep, voffB); PG8_STAGE(PG8_SA(0, 0), cA, voffA); PG8_STAGE(PG8_SA(0, 1), cA + hstepA, voffA);
        if (wr == 1) PG8_BAR;
        PG8_WAIT_V(2); PG8_BAR;
        PG8_STAGE(PG8_SB(1, 0), cB + kstep, voffB); PG8_STAGE(PG8_SA(1, 0), cA + kstep, voffA); PG8_STAGE(PG8_SB(1, 1), cB + hstep + kstep, voffB);
        PG8_WAIT_V(6); PG8_BAR;
    } else {
        PG8_STAGE(PG8_SB(0, 0), cB, voffB); PG8_STAGE(PG8_SA(0, 0), cA, voffA); PG8_STAGE(PG8_SB(0, 1), cB + hstep, voffB); PG8_STAGE(PG8_SA(0, 1), cA + hstepA, voffA);
        if (wr == 1) PG8_BAR;
        PG8_WAIT_V(4); PG8_BAR;
        PG8_STAGE(PG8_SB(1, 0), cB + kstep, voffB); PG8_STAGE(PG8_SA(1, 0), cA + kstep, voffA); PG8_STAGE(PG8_SB(1, 1), cB + hstep + kstep, voffB);
        PG8_WAIT_V(6); PG8_BAR;
    }
    for (;;) {
        const bool has_next = S.next(ui + 1, nxt);
        const char* nA = has_next ? (const char*)g.A + (size_t)nxt.pm * tstepA : cA; const char* nB = has_next ? (const char*)g.Bt + (size_t)nxt.pn * tstep : cB;
        for (int t = 0; t < nt; t += 2) {
            const bool last = (t == nt - 2);
            const char* a1 = cA + (size_t)(t + 1) * kstep;
            const char* a2 = last ? nA : cA + (size_t)(t + 2) * kstep; const char* b2 = last ? nB : cB + (size_t)(t + 2) * kstep;
            const char* a3 = a2 + kstep; const char* b3 = b2 + kstep;
            if (last && has_next) S.a_ready(nxt);
            if constexpr (SP2) {
            PG8_LDB(B0, 0, 0); PG8_LDB(B1, 0, 1); PG8_SCHED; PG8_LDA(At, 0, 0); PG8_STAGE(PG8_SA(1, 1), a1 + hstepA, voffA);
            PG8_WAIT_V(8); PG8_WAIT_L(0); PG8_BAR; PG8_MMA(0, 0, At, B0); PG8_MMA(0, 1, At, B1); PG8_BAR; PG8_SCHED;
            PG8_LDA(At, 0, 1); PG8_STAGE(PG8_SB(0, 0), b2, voffB); PG8_STAGE(PG8_SB(0, 1), b2 + hstep, voffB); PG8_STAGE(PG8_SA(0, 0), a2, voffA);
            PG8_WAIT_V(8); PG8_WAIT_L(0); PG8_BAR; PG8_MMA(1, 0, At, B0); PG8_MMA(1, 1, At, B1); PG8_BAR; PG8_SCHED;
            PG8_LDB(B0, 1, 0); PG8_LDB(B1, 1, 1); PG8_SCHED; PG8_LDA(At, 1, 0); PG8_STAGE(PG8_SA(0, 1), a2 + hstepA, voffA);
            PG8_WAIT_V(8); PG8_WAIT_L(0); PG8_BAR; PG8_MMA(0, 0, At, B0); PG8_MMA(0, 1, At, B1); PG8_BAR; PG8_SCHED;
            PG8_LDA(At, 1, 1); PG8_STAGE(PG8_SB(1, 0), b3, voffB); PG8_STAGE(PG8_SB(1, 1), b3 + hstep, voffB); PG8_STAGE(PG8_SA(1, 0), a3, voffA);
            PG8_WAIT_V(8); PG8_WAIT_L(0); PG8_BAR; PG8_MMA(1, 0, At, B0); PG8_MMA(1, 1, At, B1); PG8_BAR; PG8_SCHED;
            } else {
            PG8_LDB(B0, 0, 0); PG8_SCHED; PG8_LDA(At, 0, 0); PG8_STAGE(PG8_SA(1, 1), a1 + hstepA, voffA);
            PG8_WAIT_L(8); PG8_BAR; PG8_WAIT_L(0); PG8_MMA(0, 0, At, B0); PG8_BAR; PG8_SCHED;
            PG8_LDB(B1, 0, 1); PG8_STAGE(PG8_SB(0, 0), b2, voffB);
            PG8_BAR; PG8_WAIT_L(0); PG8_MMA(0, 1, At, B1); PG8_BAR;
            PG8_LDA(At, 0, 1); PG8_STAGE(PG8_SA(0, 0), a2, voffA);
            PG8_BAR; PG8_WAIT_L(0); PG8_MMA(1, 0, At, B0); PG8_BAR; PG8_SCHED;
            PG8_STAGE(PG8_SB(0, 1), b2 + hstep, voffB);
            PG8_WAIT_V(6); PG8_BAR; PG8_MMA(1, 1, At, B1); PG8_BAR;
            PG8_LDB(B0, 1, 0); PG8_SCHED; PG8_LDA(At, 1, 0); PG8_STAGE(PG8_SA(0, 1), a2 + hstepA, voffA);
            PG8_WAIT_L(8); PG8_BAR; PG8_WAIT_L(0); PG8_MMA(0, 0, At, B0); PG8_BAR; PG8_SCHED;
            PG8_LDB(B1, 1, 1); PG8_STAGE(PG8_SB(1, 0), b3, voffB);
            PG8_BAR; PG8_WAIT_L(0); PG8_MMA(0, 1, At, B1); PG8_BAR;
            PG8_LDA(At, 1, 1); PG8_STAGE(PG8_SA(1, 0), a3, voffA);
            PG8_BAR; PG8_WAIT_L(0); PG8_MMA(1, 0, At, B0); PG8_BAR; PG8_SCHED;
            PG8_STAGE(PG8_SB(1, 1), b3 + hstep, voffB);
            PG8_WAIT_V(6); PG8_BAR; PG8_MMA(1, 1, At, B1); PG8_BAR;
            }
        }
        if constexpr (ALIGN_EPI) { if (wr == 0) PG8_BAR; }
        if constexpr (!Epi::AFTER_DRAIN) { E(acc, cur, wr, wc, fr, fq); S.done(cur); }
        if (!has_next) break;
#pragma unroll
        for (int a = 0; a < 2; ++a)
#pragma unroll
            for (int b = 0; b < 2; ++b)
#pragma unroll
                for (int m = 0; m < 4; ++m)
#pragma unroll
                    for (int n = 0; n < 2; ++n) acc[a][b][m][n] = (f32x4){0.f, 0.f, 0.f, 0.f};
        cur = nxt; cA = nA; cB = nB; ++ui;
        if constexpr (ALIGN_EPI) { if (wr == 1) PG8_BAR; }
    }
    PG8_WAIT_V(0);
    if constexpr (!ALIGN_EPI) { if (wr == 0) PG8_BAR; }
    PG8_BAR;
    if constexpr (Epi::AFTER_DRAIN) { E.fused(acc, cur, wr, wc, fr, fq, lds, wid, lane); S.done(cur); }
#undef PG8_SA
#undef PG8_SB
#undef PG8_STAGE
#undef PG8_LDA
#undef PG8_LDB
#undef PG8_MMA
#undef PG8_WAIT_V
#undef PG8_WAIT_L
#undef PG8_BAR
#undef PG8_SCHED
}
}
namespace pg8 {
__device__ __forceinline__ unsigned cvt_pk_bf16(float lo, float hi) { unsigned r; asm volatile("v_cvt_pk_bf16_f32 %0, %1, %2" : "=v"(r) : "v"(lo), "v"(hi)); return r; }
__device__ __forceinline__ float bf_lo(unsigned w) { return __uint_as_float(w << 16); }
__device__ __forceinline__ float bf_hi(unsigned w) { return __uint_as_float(w & 0xffff0000u); }
__device__ __forceinline__ float sigm(float x) { return __builtin_amdgcn_rcpf(1.f + __expf(-x)); }
#define EPI_ROWS_BEGIN \
    const int row0 = u.pm * BM + wr * 64 + fr; const int col0 = u.pn * BM + wc * 32 + 8 * fq; \
    _Pragma("unroll") for (int ai = 0; ai < 2; ++ai) _Pragma("unroll") for (int m = 0; m < 4; ++m) { const int lr = row0 + ai * HALF + m * 16;
#define EPI_ROWS_END }
typedef float f32x2e __attribute__((ext_vector_type(2)));
struct EpiProj {
    static constexpr bool PERM = true, AFTER_DRAIN = false;
    bf16_t* O; int ldc; const float* ss; int grow0; const float* gq; const float* gk; const f32x2e* tax; const f32x2e* t1d;
    __device__ __forceinline__ void operator()(const f32x4 (&acc)[2][2][4][2], const Unit& u, int wr, int wc, int fr_, int fq_) const {
        const int l_ = lane_now(), fr = l_ & 15, fq = l_ >> 4;
        const int pn = u.pn;
        const int kind = pn < 2 ? 1 : (pn == 2 ? (wc < 2 ? 2 : 0) : (pn < 5 ? 0 : (pn < 8 ? 3 : (pn < 11 ? 4 : 0))));
        const int row0 = u.pm * BM + wr * 64 + fr; const int ocol = pn * BM + wc * 64 + 8 * fq;
        const float C2v = 0.125f * 1.4426950408889634f;
        if (kind == 0) {
#pragma unroll
            for (int ai = 0; ai < 2; ++ai)
#pragma unroll
                for (int m = 0; m < 4; ++m) { const int lr = row0 + ai * HALF + m * 16;
                    const float rs = __builtin_amdgcn_rsqf(ss[grow0 + lr] * (1.f / 1024.f) + 1e-6f);
                    bf16_t* rowp = O + (size_t)lr * ldc + ocol;
#pragma unroll
                    for (int bj = 0; bj < 2; ++bj) { const f32x4 v0 = acc[ai][bj][m][0] * rs, v1 = acc[ai][bj][m][1] * rs;
                        u32x4 w; w.x = cvt_pk_bf16(v0[0], v0[1]); w.y = cvt_pk_bf16(v0[2], v0[3]); w.z = cvt_pk_bf16(v1[0], v1[1]); w.w = cvt_pk_bf16(v1[2], v1[3]);
                        *(u32x4*)(rowp + bj * 32) = w; } }
        } else if (kind <= 2) {
            const float* gp = (kind == 1 ? gq : gk) + 8 * fq; const float osc = kind == 1 ? C2v : 1.f;
            float gv[2][8];
#pragma unroll
            for (int bj = 0; bj < 2; ++bj)
#pragma unroll
                for (int i = 0; i < 8; ++i) gv[bj][i] = gp[bj * 32 + i] * osc;
            const float sgn = fq < 2 ? -1.f : 1.f;
#pragma unroll
            for (int ai = 0; ai < 2; ++ai)
#pragma unroll
                for (int m = 0; m < 4; ++m) { const int lr = row0 + ai * HALF + m * 16; const int t = lr & 4095;
                    const float rs = __builtin_amdgcn_rsqf(ss[grow0 + lr] * (1.f / 1024.f) + 1e-6f);
                    float x[2][8]; float sq = 0.f;
#pragma unroll
                    for (int bj = 0; bj < 2; ++bj)
#pragma unroll
                        for (int i = 0; i < 8; ++i) { x[bj][i] = acc[ai][bj][m][i >> 2][i & 3] * rs; sq += x[bj][i] * x[bj][i]; }
                    sq += shx(sq, l_, 16); sq += shx(sq, l_, 32);
                    const float rn = __builtin_amdgcn_rsqf(sq * (1.f / 64.f) + 1e-6f);
                    bf16_t* rowp = O + (size_t)lr * ldc + ocol;
#pragma unroll
                    for (int bj = 0; bj < 2; ++bj) { const f32x2e* tb = tax + (bj == 0 ? (t >> 6) : (t & 63)) * 16 + 8 * (fq & 1);
                        float y[8];
#pragma unroll
                        for (int i = 0; i < 8; ++i) { const float xv = x[bj][i] * rn * gv[bj][i]; const float xp = shx(xv, l_, 32); const f32x2e cs = tb[i]; y[i] = xv * cs.x + sgn * xp * cs.y; }
                        u32x4 w; w.x = cvt_pk_bf16(y[0], y[1]); w.y = cvt_pk_bf16(y[2], y[3]); w.z = cvt_pk_bf16(y[4], y[5]); w.w = cvt_pk_bf16(y[6], y[7]);
                        *(u32x4*)(rowp + bj * 32) = w; } }
        } else {
            const float osc = kind == 3 ? C2v : 1.f;
#pragma unroll
            for (int ai = 0; ai < 2; ++ai)
#pragma unroll
                for (int m = 0; m < 4; ++m) { const int lr = row0 + ai * HALF + m * 16; const int t = lr & 4095;
                    const float rs = __builtin_amdgcn_rsqf(ss[grow0 + lr] * (1.f / 1024.f) + 1e-6f) * osc;
                    const f32x2e* tb = t1d + t * 32 + 8 * fq;
                    float y0[8], y1[8];
#pragma unroll
                    for (int i = 0; i < 8; ++i) { const float x0 = acc[ai][0][m][i >> 2][i & 3] * rs, x1 = acc[ai][1][m][i >> 2][i & 3] * rs; const f32x2e cs = tb[i];
                        y0[i] = x0 * cs.x - x1 * cs.y; y1[i] = x1 * cs.x + x0 * cs.y; }
                    bf16_t* rowp = O + (size_t)lr * ldc + ocol;
                    u32x4 w; w.x = cvt_pk_bf16(y0[0], y0[1]); w.y = cvt_pk_bf16(y0[2], y0[3]); w.z = cvt_pk_bf16(y0[4], y0[5]); w.w = cvt_pk_bf16(y0[6], y0[7]);
                    *(u32x4*)(rowp) = w;
                    w.x = cvt_pk_bf16(y1[0], y1[1]); w.y = cvt_pk_bf16(y1[2], y1[3]); w.z = cvt_pk_bf16(y1[4], y1[5]); w.w = cvt_pk_bf16(y1[6], y1[7]);
                    *(u32x4*)(rowp + 32) = w; }
        }
    }
};
template <bool ADD> struct EpiGate {
    static constexpr bool PERM = true, AFTER_DRAIN = false;
    bf16_t* O; int ldc; const bf16_t* G; int ldg;
    __device__ __forceinline__ void operator()(const f32x4 (&acc)[2][2][4][2], const Unit& u, int wr, int wc, int fr_, int fq_) const { const int l_ = lane_now(), fr = l_ & 15, fq = l_ >> 4;
        EPI_ROWS_BEGIN
            bf16_t* rowp = O + (size_t)lr * ldc + col0; const bf16_t* gp = G + (size_t)lr * ldg + col0;
#pragma unroll
            for (int bj = 0; bj < 2; ++bj) { const u32x4 gw = *(const u32x4*)(gp + bj * HALF); u32x4 pv = (u32x4){0u, 0u, 0u, 0u}; if (ADD) pv = *(const u32x4*)(rowp + bj * HALF);
                const f32x4 a0 = acc[ai][bj][m][0], a1 = acc[ai][bj][m][1]; u32x4 w;
                w.x = cvt_pk_bf16(bf_lo(pv.x) + sigm(bf_lo(gw.x)) * a0[0], bf_hi(pv.x) + sigm(bf_hi(gw.x)) * a0[1]);
                w.y = cvt_pk_bf16(bf_lo(pv.y) + sigm(bf_lo(gw.y)) * a0[2], bf_hi(pv.y) + sigm(bf_hi(gw.y)) * a0[3]);
                w.z = cvt_pk_bf16(bf_lo(pv.z) + sigm(bf_lo(gw.z)) * a1[0], bf_hi(pv.z) + sigm(bf_hi(gw.z)) * a1[1]);
                w.w = cvt_pk_bf16(bf_lo(pv.w) + sigm(bf_lo(gw.w)) * a1[2], bf_hi(pv.w) + sigm(bf_hi(gw.w)) * a1[3]);
                *(u32x4*)(rowp + bj * HALF) = w; }
        EPI_ROWS_END
    }
};
struct EpiPlain {
    static constexpr bool PERM = true, AFTER_DRAIN = false;
    bf16_t* O; int ldc;
    __device__ __forceinline__ void operator()(const f32x4 (&acc)[2][2][4][2], const Unit& u, int wr, int wc, int fr_, int fq_) const { const int l_ = lane_now(), fr = l_ & 15, fq = l_ >> 4;
        EPI_ROWS_BEGIN
            bf16_t* rowp = O + (size_t)lr * ldc + col0;
#pragma unroll
            for (int bj = 0; bj < 2; ++bj) { const f32x4 v0 = acc[ai][bj][m][0], v1 = acc[ai][bj][m][1];
                u32x4 w; w.x = cvt_pk_bf16(v0[0], v0[1]); w.y = cvt_pk_bf16(v0[2], v0[3]); w.z = cvt_pk_bf16(v1[0], v1[1]); w.w = cvt_pk_bf16(v1[2], v1[3]);
                *(u32x4*)(rowp + bj * HALF) = w; }
        EPI_ROWS_END
    }
};
template <bool GATED> struct EpiResid {
    static constexpr bool PERM = true, AFTER_DRAIN = false;
    float* H; const float* ss_in; float* ss_out; const bf16_t* E; bf16_t* XO; const float* gvec; int grow0; bool st;
    __device__ __forceinline__ void operator()(const f32x4 (&acc)[2][2][4][2], const Unit& u, int wr, int wc, int fr_, int fq_) const { const int l_ = lane_now(), fr = l_ & 15, fq = l_ >> 4;
        f32x4 gv[2][2];
#pragma unroll
        for (int bj = 0; bj < 2; ++bj)
#pragma unroll
            for (int n = 0; n < 2; ++n) gv[bj][n] = XO ? *(const f32x4*)(gvec + u.pn * BM + wc * 32 + 8 * fq + bj * HALF + 4 * n) : (f32x4){0.f, 0.f, 0.f, 0.f};
        EPI_ROWS_BEGIN
            const int gr = grow0 + lr; float* hp = H + (size_t)gr * 1024 + col0;
            float rs = 1.f; if (GATED) rs = __builtin_amdgcn_rsqf(ss_in[gr] * (1.f / 1024.f) + 1e-6f);
            float sq = 0.f;
#pragma unroll
            for (int bj = 0; bj < 2; ++bj) {
                f32x4 h0 = *(const f32x4*)(hp + bj * HALF), h1 = *(const f32x4*)(hp + bj * HALF + 4);
                f32x4 a0 = acc[ai][bj][m][0], a1 = acc[ai][bj][m][1];
                if (GATED) { const u32x4 ew = *(const u32x4*)(E + (size_t)lr * 1024 + col0 + bj * HALF);
                    a0[0] = sigm(a0[0] * rs) * bf_lo(ew.x); a0[1] = sigm(a0[1] * rs) * bf_hi(ew.x); a0[2] = sigm(a0[2] * rs) * bf_lo(ew.y); a0[3] = sigm(a0[3] * rs) * bf_hi(ew.y);
                    a1[0] = sigm(a1[0] * rs) * bf_lo(ew.z); a1[1] = sigm(a1[1] * rs) * bf_hi(ew.z); a1[2] = sigm(a1[2] * rs) * bf_lo(ew.w); a1[3] = sigm(a1[3] * rs) * bf_hi(ew.w); }
                h0 = h0 + a0; h1 = h1 + a1;
                if (st) { *(f32x4*)(hp + bj * HALF) = h0; *(f32x4*)(hp + bj * HALF + 4) = h1; }
                sq += (h0[0] * h0[0] + h0[1] * h0[1]) + (h0[2] * h0[2] + h0[3] * h0[3]) + (h1[0] * h1[0] + h1[1] * h1[1]) + (h1[2] * h1[2] + h1[3] * h1[3]);
                if (XO) { const f32x4 x0 = h0 * gv[bj][0], x1 = h1 * gv[bj][1];
                    u32x4 w; w.x = cvt_pk_bf16(x0[0], x0[1]); w.y = cvt_pk_bf16(x0[2], x0[3]); w.z = cvt_pk_bf16(x1[0], x1[1]); w.w = cvt_pk_bf16(x1[2], x1[3]);
                    if (st) *(u32x4*)(XO + (size_t)lr * 1024 + col0 + bj * HALF) = w; }
            }
            sq += shx(sq, fr + 16 * fq, 16); sq += shx(sq, fr + 16 * fq, 32);
            if (fq == 0 && st) unsafeAtomicAdd(ss_out + gr, sq);
        EPI_ROWS_END
    }
};
}
#include <hip/hip_bf16.h>
#include <cmath>
namespace attn_body {
using bf16=__hip_bfloat16;
using bf16x8=__attribute__((ext_vector_type(8)))short;
using s16x4=__attribute__((ext_vector_type(4)))short;
using f32x16=__attribute__((ext_vector_type(16)))float;
using u32x4=__attribute__((ext_vector_type(4)))unsigned;
constexpr int NHEAD=8,SEQ=4096,D=64,DM=5888;
constexpr int NW=8,QBLK=32,QB=QBLK*NW,KVBLK=64,NQB=SEQ/QB;
constexpr int ATTN_PITCH=DM, ATTN_UNIT_ROWS=QB;
__device__ __forceinline__ int crow(int r,int hi){return (r&3)+8*(r>>2)+4*hi;}
#define SBAR() __builtin_amdgcn_sched_barrier(0)
__device__ __forceinline__ void cmask(f32x16&p0,f32x16&p1,int jb,int qrel,int hi){
  const float NEG=-INFINITY; int kb=64*jb+4*hi;
  #pragma unroll
  for(int r=0;r<16;++r){int kv=kb+(r&3)+8*(r>>2); if(kv>qrel)p0[r]=NEG; if(kv+32>qrel)p1[r]=NEG;}
}

constexpr int NSLOT=3, SLOTB=8192;
constexpr int LDS_K=0, LDS_V=NSLOT*SLOTB, LDS_WS=2*NSLOT*SLOTB, LDS_OST=LDS_WS+NW*64*4, LDS_BYTES=LDS_OST+NW*4096;
constexpr float C2=0.125f*1.4426950408889634f;
__device__ __forceinline__ void glds16(const void*gsrc,unsigned lds_dst){unsigned keep;
  asm volatile("s_mov_b32 %0, m0\n\ts_mov_b32 m0, %2\n\ts_nop 0\n\tglobal_load_lds_dwordx4 %1, off\n\ts_mov_b32 m0, %0":"=&s"(keep):"v"(gsrc),"s"(lds_dst):"memory");}
__device__ __forceinline__ float max3f(float a,float b,float c){float r;asm("v_max3_f32 %0, %1, %2, %3":"=v"(r):"v"(a),"v"(b),"v"(c));return r;}
__device__ __forceinline__ float max2f(float a,float b){float r;asm("v_max_f32_e32 %0, %1, %2":"=v"(r):"v"(a),"v"(b));return r;}
__device__ __forceinline__ float fadd_s(float a,float b){float r;asm("v_add_f32_e32 %0, %1, %2":"=v"(r):"v"(a),"v"(b));return r;}
__device__ __forceinline__ float fsub_s(float a,float b){float r;asm("v_sub_f32_e32 %0, %1, %2":"=v"(r):"v"(a),"v"(b));return r;}
typedef float f32x2_t __attribute__((ext_vector_type(2))); typedef __bf16 bf16x2_t __attribute__((ext_vector_type(2)));
__device__ __forceinline__ unsigned cvtpk_s(float lo,float hi){f32x2_t v={lo,hi};bf16x2_t b=__builtin_convertvector(v,bf16x2_t);return __builtin_bit_cast(unsigned,b);}
#define WAIT_BAR(N) asm volatile("s_waitcnt vmcnt(" #N ") lgkmcnt(0)\n\ts_barrier":::"memory")

__device__ __forceinline__ void qkt(f32x16&p0,f32x16&p1,const char*Kslot,const bf16x8*qr,const f32x16&negm,int r32,int hi){
  const char*kb=Kslot+hi*1024+r32*16;
  #pragma unroll
  for(int d0=0;d0<4;++d0){
    const bf16x8 b0=*reinterpret_cast<const bf16x8*>(kb+d0*2048);
    const bf16x8 b1=*reinterpret_cast<const bf16x8*>(kb+d0*2048+512);
    if(d0==0){p0=__builtin_amdgcn_mfma_f32_32x32x16_bf16(b0,qr[0],negm,0,0,0);p1=__builtin_amdgcn_mfma_f32_32x32x16_bf16(b1,qr[0],negm,0,0,0);}
    else{p0=__builtin_amdgcn_mfma_f32_32x32x16_bf16(b0,qr[d0],p0,0,0,0);p1=__builtin_amdgcn_mfma_f32_32x32x16_bf16(b1,qr[d0],p1,0,0,0);}}
}
typedef __attribute__((address_space(3))) const char* lds_cptr;
typedef short v4i16_t __attribute__((ext_vector_type(4)));
__device__ __forceinline__ void kload8(bf16x8*kf,lds_cptr kp){
  kf[0]=*(const __attribute__((address_space(3))) bf16x8*)(kp);      kf[1]=*(const __attribute__((address_space(3))) bf16x8*)(kp+512);
  kf[2]=*(const __attribute__((address_space(3))) bf16x8*)(kp+2048); kf[3]=*(const __attribute__((address_space(3))) bf16x8*)(kp+2560);
  kf[4]=*(const __attribute__((address_space(3))) bf16x8*)(kp+4096); kf[5]=*(const __attribute__((address_space(3))) bf16x8*)(kp+4608);
  kf[6]=*(const __attribute__((address_space(3))) bf16x8*)(kp+6144); kf[7]=*(const __attribute__((address_space(3))) bf16x8*)(kp+6656);
}
__device__ __forceinline__ void kload2(bf16x8*kf,lds_cptr kp,int j){ kf[2*j]=*(const __attribute__((address_space(3))) bf16x8*)(kp+j*2048); kf[2*j+1]=*(const __attribute__((address_space(3))) bf16x8*)(kp+j*2048+512); }
__device__ __forceinline__ s16x4 vtr(lds_cptr p){ return __builtin_bit_cast(s16x4,__builtin_amdgcn_ds_read_tr16_b64_v4i16((__attribute__((address_space(3))) v4i16_t*)p)); }
__device__ __forceinline__ float rowmax(const f32x16&p0,const f32x16&p1){
  float a=max3f(p0[0],p0[1],p1[0]),b=max3f(p0[2],p0[3],p1[1]);a=max3f(a,p1[2],p1[3]);
  #pragma unroll
  for(int r=4;r<16;r+=4){a=max3f(a,p0[r],p0[r+1]);b=max3f(b,p0[r+2],p0[r+3]);a=max3f(a,p1[r],p1[r+1]);b=max3f(b,p1[r+2],p1[r+3]);}
  const float m=max2f(a,b);
  auto rr=__builtin_amdgcn_permlane32_swap(__float_as_uint(m),__float_as_uint(m),false,false);
  return max2f(__uint_as_float(rr[0]),__uint_as_float(rr[1]));
}
__device__ __forceinline__ void pv(f32x16*o,int vb,bf16x8 pa0,bf16x8 pa1,bf16x8 pa2,bf16x8 pa3){
  #pragma unroll
  for(int d0=0;d0<2;++d0){s16x4 lo[4],hi[4];
    #pragma unroll
    for(int ks=0;ks<4;++ks){
      asm volatile("ds_read_b64_tr_b16 %0,%1 offset:%c2":"=&v"(lo[ks]):"v"(vb),"i"(d0*4096+ks*1024):"memory");
      asm volatile("ds_read_b64_tr_b16 %0,%1 offset:%c2":"=&v"(hi[ks]):"v"(vb),"i"(d0*4096+ks*1024+512):"memory");}
    asm volatile("s_waitcnt lgkmcnt(0)":::"memory");SBAR();
    #define PK(k) (bf16x8){lo[k][0],lo[k][1],lo[k][2],lo[k][3],hi[k][0],hi[k][1],hi[k][2],hi[k][3]}
    o[d0]=__builtin_amdgcn_mfma_f32_32x32x16_bf16(pa0,PK(0),o[d0],0,0,0);
    o[d0]=__builtin_amdgcn_mfma_f32_32x32x16_bf16(pa1,PK(1),o[d0],0,0,0);
    o[d0]=__builtin_amdgcn_mfma_f32_32x32x16_bf16(pa2,PK(2),o[d0],0,0,0);
    o[d0]=__builtin_amdgcn_mfma_f32_32x32x16_bf16(pa3,PK(3),o[d0],0,0,0);
    #undef PK
  }
}

#ifndef ATTN_STORE16
#define ATTN_STORE16(p,v) (*(u32x4*)(p)=(v))
#endif
template<int THRL> __device__ __forceinline__ void attn_unit(int b,int h,int qb,const bf16*Q,const bf16*__restrict__ K,const bf16*__restrict__ V,bf16*O,const bf16*__restrict__ Z,char*shm,const int wave_id,const bool st_){
  const int lane=lane_now(),tid=wave_id*64+lane,r32=lane&31,hi=lane>>5; const int wid=wave_id;
  const long rowbase=(long)b*SEQ; const int q0=qb*QB;
  const bf16*Qw=Q+(rowbase+q0+wid*QBLK)*DM+h*D;
  const bf16*Kh=K+rowbase*DM+(h>>2)*D,*Vh=V+rowbase*DM+(h>>2)*D;
  const unsigned lds0=(unsigned)(uintptr_t)shm;
  float*wsf=(float*)(shm+LDS_WS)+wid*64;
  const bf16*ksrc=Kh+(long)lane*DM+wid*8;
  const bf16*vsrc=Vh+(long)(16*(wid&3)+(lane>>2))*DM+(wid>>2)*32+(lane&3)*8;
  const unsigned kdst=lds0+LDS_K+wid*1024, vdst=lds0+LDS_V+wid*1024;
  #define DMA_K(t,slot) glds16(ksrc+(long)(t)*KVBLK*DM,(unsigned)__builtin_amdgcn_readfirstlane(kdst+(slot)))
  #define DMA_V(t,slot) glds16(vsrc+(long)(t)*KVBLK*DM,(unsigned)__builtin_amdgcn_readfirstlane(vdst+(slot)))
  const int vb0=(int)(lds0+LDS_V)+((lane>>4)&1)*32+(lane&3)*8+(4*hi+((lane&15)>>2))*64;
  const char*Kbase=shm+LDS_K; bf16x8 kf[8];
  const lds_cptr shm3=(lds_cptr)shm; const lds_cptr kp0=shm3+LDS_K+hi*1024+r32*16; const lds_cptr vp0=shm3+LDS_V+((lane>>4)&1)*32+(lane&3)*8+(4*hi+((lane&15)>>2))*64;
  constexpr int NT=SEQ/KVBLK;
  DMA_K(0,0);DMA_V(0,0);DMA_K(1,SLOTB);
  bf16x8 qr[4];
  #pragma unroll
  for(int d0=0;d0<4;++d0)qr[d0]=*reinterpret_cast<const bf16x8*>(&Qw[(long)r32*DM+d0*16+hi*8]);
  float mhat=0.f,l_reg=0.f;f32x16 o[2];{float zz=0.f;asm volatile("":"+v"(zz));_Pragma("unroll") for(int r=0;r<16;++r){o[0][r]=zz;o[1][r]=zz;}}f32x16 negm;{float zz=0.f;asm volatile("":"+v"(zz));_Pragma("unroll") for(int r=0;r<16;++r)negm[r]=zz;}asm volatile("":"+v"(negm));
  const int qrel=wid*QBLK+r32;
  #define CMASK(P0,P1,t) do{}while(0)
  bool resc=false;
  #define START(P0,P1) do{ const float rm=rowmax(P0,P1); resc=false; \
    { const float dl=rm; mhat=fadd_s(mhat,dl); \
      _Pragma("unroll") for(int r=0;r<16;++r){P0[r]=fsub_s(P0[r],dl);P1[r]=fsub_s(P1[r],dl);} \
      _Pragma("unroll") for(int r=0;r<16;++r)negm[r]=-mhat; asm volatile("":"+v"(negm)); } \
    _Pragma("unroll") for(int r=0;r<16;++r)P0[r]=__builtin_amdgcn_exp2f(P0[r]); }while(0)
  #define RESC() do{ if(resc){ asm volatile("s_waitcnt lgkmcnt(0)":::"memory"); \
      _Pragma("unroll") for(int d_=0;d_<2;++d_) _Pragma("unroll") for(int r=0;r<16;++r)o[d_][r]*=wsf[crow(r,hi)]; } }while(0)
  f32x16 pA0,pA1,pB0,pB1;
  int sl_prev=0,sl_cur=0,sl_next=SLOTB;
  #define ROT() do{sl_prev=sl_cur;sl_cur=sl_next;sl_next=(sl_next==(NSLOT-1)*SLOTB)?0:sl_next+SLOTB;}while(0)
  DMA_K(2,2*SLOTB);
  WAIT_BAR(3);
  qkt(pA0,pA1,Kbase,qr,negm,r32,hi);asm volatile("s_nop 15\n\ts_nop 7":"+v"(pA0),"+v"(pA1));CMASK(pA0,pA1,0);
  START(pA0,pA1);
  _Pragma("unroll") for(int r=0;r<16;++r)pA1[r]=__builtin_amdgcn_exp2f(pA1[r]);
  WAIT_BAR(0);
  DMA_K(3,0);DMA_V(1,SLOTB);
  ROT();
  kload8(kf,kp0+sl_cur);
  WAIT_BAR(2);
  s16x4 vlo[8],vhi[8]; u32x4 pw0,pw1,pw2,pw3;
  #define PKW(P,B) cvtpk_s(P[B],P[B+1])
  #define PAF(k) __builtin_bit_cast(bf16x8,pw##k)
  #define VFR(i) (bf16x8){vlo[i][0],vlo[i][1],vlo[i][2],vlo[i][3],vhi[i][0],vhi[i][1],vhi[i][2],vhi[i][3]}
  #define PIN(x) asm volatile("":"+v"(x))
  #define MX3(a,b,c) __builtin_fmaxf(__builtin_fmaxf((a),(b)),(c))
  #define GAPA(MF,A0,A1,A2,A3,W0,W1,PW) do{ MF; sacc+=A0; sacc+=A1; sacc+=A2; sacc+=A3; PIN(sacc); W0; W1; PIN(PW); SBAR(); }while(0)
  #define EX(v) __builtin_amdgcn_exp2f(v)
  #define GAPB(MF,X,B) do{ MF; X[B]=EX(X[B]); X[B+1]=EX(X[B+1]); X[B+2]=EX(X[B+2]); X[B+3]=EX(X[B+3]); PIN(X); SBAR(); }while(0)
  #define VRD(i) do{ vlo[i]=vtr(vp_+(((i)>>2)*4096+((i)&3)*1024)); vhi[i]=vtr(vp_+(((i)>>2)*4096+((i)&3)*1024+512)); }while(0)
  #define KRD(G,j) do{ if(G){ kload2(kf,kp0+sl_next,j); SBAR(); } }while(0)
  #define STEP(C0,C1,P0,P1,t,GK,GV,GL) do{ SBAR(); \
    const lds_cptr vp_=vp0+sl_prev; \
    VRD(0); SBAR(); float sacc=(P0[0]+P0[1]); \
    GAPA(C0=__builtin_amdgcn_mfma_f32_32x32x16_bf16(kf[0],qr[0],negm,0,0,0), P0[2],P0[3],P0[4],P0[5],     pw0[0]=PKW(P0,0), pw0[1]=PKW(P0,2), pw0); \
    VRD(4); SBAR(); GAPA(C1=__builtin_amdgcn_mfma_f32_32x32x16_bf16(kf[1],qr[0],negm,0,0,0), P0[6],P0[7],P0[8],P0[9],     pw0[2]=PKW(P0,4), pw0[3]=PKW(P0,6), pw0); \
    VRD(1); SBAR(); GAPA(C0=__builtin_amdgcn_mfma_f32_32x32x16_bf16(kf[2],qr[1],C0,0,0,0),   P0[10],P0[11],P0[12],P0[13], pw1[0]=PKW(P0,8), pw1[1]=PKW(P0,10), pw1); \
    VRD(5); SBAR(); GAPA(C1=__builtin_amdgcn_mfma_f32_32x32x16_bf16(kf[3],qr[1],C1,0,0,0),   P0[14],P0[15],P1[0],P1[1],   pw1[2]=PKW(P0,12),pw1[3]=PKW(P0,14), pw1); \
    VRD(2); SBAR(); GAPA(C0=__builtin_amdgcn_mfma_f32_32x32x16_bf16(kf[4],qr[2],C0,0,0,0),   P1[2],P1[3],P1[4],P1[5],     pw2[0]=PKW(P1,0), pw2[1]=PKW(P1,2), pw2); \
    VRD(6); SBAR(); GAPA(C1=__builtin_amdgcn_mfma_f32_32x32x16_bf16(kf[5],qr[2],C1,0,0,0),   P1[6],P1[7],P1[8],P1[9],     pw2[2]=PKW(P1,4), pw2[3]=PKW(P1,6), pw2); \
    VRD(3); SBAR(); GAPA(C0=__builtin_amdgcn_mfma_f32_32x32x16_bf16(kf[6],qr[3],C0,0,0,0),   P1[10],P1[11],P1[12],P1[13], pw3[0]=PKW(P1,8), pw3[1]=PKW(P1,10), pw3); \
    VRD(7); SBAR(); GAPA(C1=__builtin_amdgcn_mfma_f32_32x32x16_bf16(kf[7],qr[3],C1,0,0,0),   P1[14],P1[15],0.f,0.f,       pw3[2]=PKW(P1,12),pw3[3]=PKW(P1,14), pw3); \
    l_reg+=sacc; \
    if(GK){DMA_K((t)+3,sl_cur);} if(GV){DMA_V((t)+1,sl_next);} \
    CMASK(C0,C1,t); \
    { float a=MX3(C0[0],C0[1],C1[0]),b=MX3(C0[2],C0[3],C1[1]); a=MX3(a,C1[2],C1[3]); \
      _Pragma("unroll") for(int r=4;r<16;r+=4){a=MX3(a,C0[r],C0[r+1]);b=MX3(b,C0[r+2],C0[r+3]);a=MX3(a,C1[r],C1[r+1]);b=MX3(b,C1[r+2],C1[r+3]);} \
      float rm=__builtin_fmaxf(a,b); { auto rr=__builtin_amdgcn_permlane32_swap(__float_as_uint(rm),__float_as_uint(rm),false,false); rm=__builtin_fmaxf(__uint_as_float(rr[0]),__uint_as_float(rr[1])); } \
      resc=false; \
      if(__builtin_expect(__any(rm>(float)THRL),0)){ const float dl=__builtin_fmaxf(rm,0.f); mhat+=dl; \
        _Pragma("unroll") for(int r=0;r<16;++r){C0[r]-=dl;C1[r]-=dl;} \
        _Pragma("unroll") for(int r=0;r<16;++r)negm[r]=-mhat; asm volatile("":"+v"(negm)); \
        const float f=__builtin_amdgcn_exp2f(-dl); l_reg*=f; if(hi==0)wsf[r32]=f; resc=true; } } \
    SBAR(); \
    GAPB(o[0]=__builtin_amdgcn_mfma_f32_32x32x16_bf16(PAF(0),VFR(0),o[0],0,0,0), C0,0); \
    GAPB(o[1]=__builtin_amdgcn_mfma_f32_32x32x16_bf16(PAF(0),VFR(4),o[1],0,0,0), C0,4); \
    KRD(GL,0); GAPB(o[0]=__builtin_amdgcn_mfma_f32_32x32x16_bf16(PAF(1),VFR(1),o[0],0,0,0), C0,8); \
    KRD(GL,1); GAPB(o[1]=__builtin_amdgcn_mfma_f32_32x32x16_bf16(PAF(1),VFR(5),o[1],0,0,0), C0,12); \
    KRD(GL,2); GAPB(o[0]=__builtin_amdgcn_mfma_f32_32x32x16_bf16(PAF(2),VFR(2),o[0],0,0,0), C1,0); \
    KRD(GL,3); GAPB(o[1]=__builtin_amdgcn_mfma_f32_32x32x16_bf16(PAF(2),VFR(6),o[1],0,0,0), C1,4); \
    GAPB(o[0]=__builtin_amdgcn_mfma_f32_32x32x16_bf16(PAF(3),VFR(3),o[0],0,0,0), C1,8); \
    GAPB(o[1]=__builtin_amdgcn_mfma_f32_32x32x16_bf16(PAF(3),VFR(7),o[1],0,0,0), C1,12); \
    }while(0)
  int t=1;
  #undef CMASK
  #define CMASK(P0,P1,t) do{}while(0)
  for(;t+5<NT;t+=2){
    STEP(pB0,pB1,pA0,pA1,t,true,true,true);     WAIT_BAR(2); RESC(); ROT();
    STEP(pA0,pA1,pB0,pB1,t+1,true,true,true);   WAIT_BAR(2); RESC(); ROT();
  }
  #undef CMASK
  #define CMASK(P0,P1,t) do{}while(0)
  #define ENDW(tt) do{ if((tt)+3<NT){WAIT_BAR(2);} else if((tt)+2<NT){WAIT_BAR(1);} else {WAIT_BAR(0);} }while(0)
  for(;t+1<NT;t+=2){
    STEP(pB0,pB1,pA0,pA1,t,(t+3<NT),(t+1<NT),(t+1<NT));       ENDW(t);   RESC(); ROT();
    STEP(pA0,pA1,pB0,pB1,t+1,(t+4<NT),(t+2<NT),(t+2<NT));     ENDW(t+1); RESC(); ROT();
  }
  STEP(pB0,pB1,pA0,pA1,NT-1,false,false,false); RESC();
  { float sacc=pB0[0]+pB0[1]; _Pragma("unroll") for(int r=2;r<16;++r)sacc+=pB0[r]; _Pragma("unroll") for(int r=0;r<16;++r)sacc+=pB1[r]; l_reg+=sacc;
    pw0=(u32x4){PKW(pB0,0),PKW(pB0,2),PKW(pB0,4),PKW(pB0,6)};pw1=(u32x4){PKW(pB0,8),PKW(pB0,10),PKW(pB0,12),PKW(pB0,14)};pw2=(u32x4){PKW(pB1,0),PKW(pB1,2),PKW(pB1,4),PKW(pB1,6)};pw3=(u32x4){PKW(pB1,8),PKW(pB1,10),PKW(pB1,12),PKW(pB1,14)};
    SBAR(); pv(o,vb0+sl_cur,PAF(0),PAF(1),PAF(2),PAF(3)); }
  #undef PKW
  #undef PAF
  #undef VFR
  #undef PIN
  #undef MX3
  #undef GAPA
  #undef GAPB
  #undef EX
  #undef VRD
  #undef KRD
  #undef STEP
  #undef ENDW
  {auto rr=__builtin_amdgcn_permlane32_swap(__float_as_uint(l_reg),__float_as_uint(l_reg),false,false);l_reg=__uint_as_float(rr[0])+__uint_as_float(rr[1]);}
  if(hi==0)wsf[32+r32]=l_reg;asm volatile("s_waitcnt lgkmcnt(0)":::"memory");
  float rli[16];
  #pragma unroll
  for(int r=0;r<16;++r)rli[r]=__builtin_amdgcn_rcpf(wsf[32+crow(r,hi)]);
  bf16*Ow=O+(rowbase+q0+wid*QBLK)*DM+h*D;
  { bf16*stg=(bf16*)(shm+LDS_OST)+wid*2048;
    #pragma unroll
    for(int r=0;r<16;++r){const int orow=crow(r,hi);
      #pragma unroll
      for(int d0=0;d0<2;++d0)stg[orow*64+d0*32+r32]=__float2bfloat16(o[d0][r]*rli[r]);}
    asm volatile("s_waitcnt lgkmcnt(0)":::"memory");
    const bf16*Zw=Z+(rowbase+q0+wid*QBLK)*DM+h*D;
    #pragma unroll
    for(int i=0;i<4;++i){const int row=i*8+(lane>>3),ch=lane&7; u32x4 v=*(const u32x4*)(stg+row*64+ch*8); const u32x4 z=*(const u32x4*)(Zw+(long)row*DM+ch*8);
      _Pragma("unroll") for(int e=0;e<4;++e){ const float z0=__uint_as_float(z[e]<<16), z1=__uint_as_float(z[e]&0xffff0000u); const float v0=__uint_as_float(v[e]<<16), v1=__uint_as_float(v[e]&0xffff0000u);
        const float g0=z0*__builtin_amdgcn_rcpf(1.f+__expf(-z0)), g1=z1*__builtin_amdgcn_rcpf(1.f+__expf(-z1)); v[e]=cvtpk_s(v0*g0,v1*g1); }
      if(st_)ATTN_STORE16(Ow+(long)row*DM+ch*8,v);} }
  asm volatile("s_waitcnt lgkmcnt(0)\n\ts_barrier":::"memory");
  #undef DMA_K
  #undef DMA_V
  #undef CMASK
  #undef START
  #undef RESC
  #undef ROT
}
constexpr int ATTN_LDS_BYTES=LDS_BYTES;
struct AttnTensors { const bf16* Q; const bf16* K; const bf16* V; bf16* O; const bf16* Z; };
struct AttnUnit { int b; int h; int qb; };
template<int THRL=8> __device__ __forceinline__ void attn_phase(char*lds,const AttnTensors&T,int vcu,int G,const int wave_id,const bool st_){
  const int x=vcu>>5,c=vcu&31;
  #pragma unroll 1
  for(int i=0;i<6;++i){ const int pair=x*3+(i>>1),u=(i&1)*32+c; attn_unit<THRL>(pair>>1,(pair&1)*4+(u>>4),u&15,T.Q,T.K,T.V,T.O,T.Z,lds,wave_id,st_); }
}
#undef SBAR
#undef WAIT_BAR
}
constexpr int NWAVES = 8;
constexpr int DM_ = 1024, DEPTH = 4, SEQ_ = 4096, MTOT = 98304, MH = 49152, NPROMPT = 65536, PITCH = 5888, PLE = 256;
constexpr int C_QA = 0, C_KA = 512, C_VA = 640, C_ZA = 768, C_QB = 1280, C_KB = 2048, C_VB = 2816, C_ZB = 3584, C_GA = 3840, C_GB = 4864;
constexpr size_t MiB = 1u << 20;
constexpr size_t WS_SS = 0;
constexpr size_t WS_TAX = 4 * MiB;
constexpr size_t WS_T1D = 4 * MiB + 65536;
constexpr size_t WS_W = 8 * MiB;
constexpr size_t WL_IN = 0, WL_A = (size_t)5888 * 1024 * 2, WL_B = WL_A + 1 * MiB, WL_O = WL_B + MiB / 2, WL_PLE = WL_O + 2 * MiB, WL_PG = WL_PLE + MiB / 2, WL_STRIDE = WL_PG + 2 * MiB;
constexpr size_t WS_LSE = 80 * MiB;
constexpr size_t WS_OBG = 84 * MiB;
constexpr size_t WS_PB = 108 * MiB;
constexpr size_t WS_BUFA = 132 * MiB;
constexpr size_t WS_PROJ = 228 * MiB;
constexpr size_t WS_HG = 780 * MiB;
constexpr size_t WS_EB = 876 * MiB;
constexpr size_t WS_END = 972 * MiB;
static_assert(WS_W + 4 * WL_STRIDE <= WS_LSE, "weights");
constexpr int LDS_BYTES = 147456;
#define LAS __attribute__((address_space(3)))
typedef unsigned short bf16;
typedef unsigned v4u __attribute__((ext_vector_type(4)));
typedef float f32x4 __attribute__((ext_vector_type(4)));
typedef float f32x16 __attribute__((ext_vector_type(16)));
typedef short bf16x8 __attribute__((ext_vector_type(8)));
typedef short s16x4 __attribute__((ext_vector_type(4)));
typedef float f32x2 __attribute__((ext_vector_type(2)));
__device__ __forceinline__ unsigned f2bf(float f) { unsigned u = __builtin_bit_cast(unsigned, f); return (u + 0x7fffu + ((u >> 16) & 1u)) >> 16; }
__device__ __forceinline__ unsigned pk2(float lo, float hi) { return f2bf(lo) | (f2bf(hi) << 16); }
__device__ __forceinline__ float blo(unsigned w) { return __uint_as_float(w << 16); }
__device__ __forceinline__ float bhi(unsigned w) { return __uint_as_float(w & 0xffff0000u); }
__device__ __forceinline__ float wave_sum(float v, int lane) {
#pragma unroll
    for (int o = 1; o < 64; o <<= 1) v += shx(v, lane, o);
    return v;
}
constexpr float C2F = 0.125f * 1.4426950408889634f;

#ifndef PROBE_P1
#define PROBE_P1 0
#endif
#ifndef PROBE_AA
#define PROBE_AA 0
#endif
#ifndef PROBE_AB
#define PROBE_AB 0
#endif
#ifndef PROBE_P2
#define PROBE_P2 0
#endif
#ifndef PROBE_P4
#define PROBE_P4 0
#endif
#ifndef PROBE_P5
#define PROBE_P5 0
#endif
#ifndef PROBE_P6
#define PROBE_P6 0
#endif
#ifndef PROBE_P7
#define PROBE_P7 0
#endif
struct Args { const float* in[15]; float* out; unsigned char* ws; };

template <bool HEADPERM> __device__ __forceinline__ void transpose_item(const float* W, int K, int N, bf16* WT, LAS float* scr, int item, int lane) {
    const int nblk = N / 32, kb = item / nblk, nb = item % nblk, k0 = 64 * kb, n0 = 32 * nb;
#pragma unroll 8
    for (int i = 0; i < 32; ++i) { const int kk = 2 * i + (lane >> 5); scr[kk * 33 + (lane & 31)] = W[(size_t)(k0 + kk) * N + n0 + (lane & 31)]; }
    asm volatile("s_waitcnt lgkmcnt(0)" ::: "memory");
    const int c = lane & 7;
#pragma unroll
    for (int j = 0; j < 4; ++j) { const int n = (lane >> 3) + 8 * j; const LAS float* s = scr + (8 * c) * 33 + n;
        v4u o; o.x = pk2(s[0 * 33], s[1 * 33]); o.y = pk2(s[2 * 33], s[3 * 33]); o.z = pk2(s[4 * 33], s[5 * 33]); o.w = pk2(s[6 * 33], s[7 * 33]);
        int nr = n0 + n; if (HEADPERM) { const int w_ = nr & 255; nr = (nr & ~255) + ((w_ >> 5) & 1) * 128 + (w_ >> 6) * 32 + (w_ & 31); }
        *(v4u*)(WT + (size_t)nr * K + k0 + 8 * c) = o; }
    asm volatile("s_waitcnt lgkmcnt(0)" ::: "memory");
}

__device__ __forceinline__ int crow(int r, int hi) { return (r & 3) + 8 * (r >> 2) + 4 * hi; }
__device__ __forceinline__ s16x4 vtr(const LAS char* p) { typedef short v4i16_t __attribute__((ext_vector_type(4))); return __builtin_bit_cast(s16x4, __builtin_amdgcn_ds_read_tr16_b64_v4i16((LAS v4i16_t*)p)); }
__device__ __forceinline__ unsigned cvtpk(float lo, float hi) { typedef __bf16 bf16x2_t __attribute__((ext_vector_type(2))); f32x2 v = {lo, hi}; bf16x2_t b = __builtin_convertvector(v, bf16x2_t); return __builtin_bit_cast(unsigned, b); }
__device__ __forceinline__ void attnb_unit(bf16* P, float* LSE, int b, int hb, int tau, LAS char* wl, int lane, const bool st_) {
    const int g = hb >> 2, sh = 2 * g, L = 4096 >> sh, tprs = 7 - sh;
    const int r = tau >> tprs, m0 = 32 * (tau & ((1 << tprs) - 1));
    const int r32 = lane & 31, hi = lane >> 5;
    const size_t rowbase = (size_t)b * 4096;
    const int tq = r + ((m0 + r32) << sh);
    bf16x8 qf[4];
    { const bf16* qp = P + (rowbase + tq) * PITCH + C_QB + hb * 64 + hi * 8;
#pragma unroll
      for (int d0 = 0; d0 < 4; ++d0) qf[d0] = *(const bf16x8*)(qp + d0 * 16); }
    f32x16 S[5];
#pragma unroll
    for (int kb = 0; kb < 5; ++kb) {
        int mk = m0 - 64 + 32 * kb + r32; mk = mk < 0 ? 0 : (mk > L - 1 ? L - 1 : mk);
        const bf16* kp = P + (rowbase + r + (mk << sh)) * PITCH + C_KB + hb * 64 + hi * 8;
        bf16x8 kf[4];
#pragma unroll
        for (int d0 = 0; d0 < 4; ++d0) kf[d0] = *(const bf16x8*)(kp + d0 * 16);
        f32x16 s = {};
#pragma unroll
        for (int d0 = 0; d0 < 4; ++d0) s = __builtin_amdgcn_mfma_f32_32x32x16_bf16(kf[d0], qf[d0], s, 0, 0, 0);
        S[kb] = s;
    }
    const int mq = m0 + r32; float mx = -INFINITY;
#pragma unroll
    for (int kb = 0; kb < 5; ++kb)
#pragma unroll
        for (int q = 0; q < 16; ++q) { const int mk = m0 - 64 + 32 * kb + crow(q, hi); const int dd = mk - mq; const bool ok = (mk >= 0) && (mk < L) && (dd <= 64) && (dd >= -64);
            const float v = ok ? S[kb][q] : -INFINITY; S[kb][q] = v; mx = fmaxf(mx, v); }
    mx = fmaxf(mx, shx(mx, lane, 32));
    float l = 0.f;
#pragma unroll
    for (int kb = 0; kb < 5; ++kb)
#pragma unroll
        for (int q = 0; q < 16; ++q) { const float p = __builtin_amdgcn_exp2f(S[kb][q] - mx); S[kb][q] = p; l += p; }
    l += shx(l, lane, 32);
    f32x16 o0 = {}, o1 = {};
    const LAS char* vrd = wl + ((lane >> 4) & 1) * 32 + (lane & 3) * 8 + (4 * hi + ((lane & 15) >> 2)) * 64;
#pragma unroll
    for (int kb = 0; kb < 5; ++kb) {
        asm volatile("" ::: "memory");
#pragma unroll
        for (int j = 0; j < 4; ++j) { const int idx = lane + 64 * j, key = idx >> 3, c = idx & 7;
            int mk = m0 - 64 + 32 * kb + key; mk = mk < 0 ? 0 : (mk > L - 1 ? L - 1 : mk);
            const v4u vv = *(const v4u*)(P + (rowbase + r + (mk << sh)) * PITCH + C_VB + hb * 64 + c * 8);
            *(LAS v4u*)(wl + (c >> 2) * 2048 + (key >> 3) * 512 + (key & 7) * 64 + (c & 3) * 16) = vv; }
        asm volatile("s_waitcnt lgkmcnt(0)" ::: "memory");
#pragma unroll
        for (int s = 0; s < 2; ++s) {
            v4u pw; pw.x = cvtpk(S[kb][8 * s + 0], S[kb][8 * s + 1]); pw.y = cvtpk(S[kb][8 * s + 2], S[kb][8 * s + 3]); pw.z = cvtpk(S[kb][8 * s + 4], S[kb][8 * s + 5]); pw.w = cvtpk(S[kb][8 * s + 6], S[kb][8 * s + 7]);
            const bf16x8 pa = __builtin_bit_cast(bf16x8, pw);
            { const s16x4 lo = vtr(vrd + (2 * s) * 512), hh = vtr(vrd + (2 * s + 1) * 512);
              const bf16x8 vf = (bf16x8){lo[0], lo[1], lo[2], lo[3], hh[0], hh[1], hh[2], hh[3]};
              o0 = __builtin_amdgcn_mfma_f32_32x32x16_bf16(pa, vf, o0, 0, 0, 0); }
            { const s16x4 lo = vtr(vrd + 2048 + (2 * s) * 512), hh = vtr(vrd + 2048 + (2 * s + 1) * 512);
              const bf16x8 vf = (bf16x8){lo[0], lo[1], lo[2], lo[3], hh[0], hh[1], hh[2], hh[3]};
              o1 = __builtin_amdgcn_mfma_f32_32x32x16_bf16(pa, vf, o1, 0, 0, 0); }
        }
        asm volatile("s_waitcnt lgkmcnt(0)" ::: "memory");
    }
    LAS float* wsf = (LAS float*)(wl + 4096);
    if (hi == 0) { wsf[r32] = l; if (st_) LSE[(rowbase + tq) * 12 + hb] = mx + __builtin_amdgcn_logf(l); }
    asm volatile("s_waitcnt lgkmcnt(0)" ::: "memory");
    LAS bf16* stg = (LAS bf16*)wl;
#pragma unroll
    for (int q = 0; q < 16; ++q) { const int orow = crow(q, hi); const float rl = __builtin_amdgcn_rcpf(wsf[orow]);
        stg[orow * 64 + r32] = (bf16)f2bf(o0[q] * rl); stg[orow * 64 + 32 + r32] = (bf16)f2bf(o1[q] * rl); }
    asm volatile("s_waitcnt lgkmcnt(0)" ::: "memory");
#pragma unroll
    for (int i = 0; i < 4; ++i) { const int row = i * 8 + (lane >> 3), ch = lane & 7; const v4u v = *(const LAS v4u*)(wl + row * 128 + ch * 16);
        if (st_) *(v4u*)(P + (rowbase + r + ((m0 + row) << sh)) * PITCH + C_QB + hb * 64 + ch * 8) = v; }
    asm volatile("s_waitcnt lgkmcnt(0)" ::: "memory");
}

__global__ void __launch_bounds__(NWAVES * 64, 2) fwd_mega(Args args) {
    extern __shared__ __attribute__((aligned(16))) unsigned char lds[];
    cg::grid_group grid = cg::this_grid();
    LAS unsigned char* ldsl = (LAS unsigned char*)lds;
    const int wave = __builtin_amdgcn_readfirstlane(threadIdx.x >> 6); int tidv = wave * 64 + lane_now();
#define LAUNDER() do { tidv = wave * 64 + lane_now(); asm volatile("" : "+s"(bxv)); } while (0)
#define lane (tidv & 63)
#define gt (bx * (NWAVES * 64) + tidv)
    const int G = gridDim.x; int bxv = blockIdx.x; asm volatile("" : "+s"(bxv));
#define bx bxv
#define vcu ((bxv % 8) * (G / 8) + bxv / 8)
#define gw (vcu * NWAVES + wave)
    const int NGW = G * NWAVES;
    const int NGT = G * NWAVES * 64;
    unsigned char* ws = args.ws;
    const float* x_prompt = args.in[0]; const float* x_sample = args.in[1]; const float* p_prompt = args.in[2]; const float* p_sample = args.in[3];
    const float* g_norm = args.in[4]; const float* w_in = args.in[5]; const float* g_q = args.in[6]; const float* g_k = args.in[7];
    const float* w_a = args.in[8]; const float* w_b = args.in[9]; const float* w_o = args.in[10]; const float* w_ple = args.in[11];
    const float* g_ple = args.in[12]; const float* w_pg = args.in[13]; const float* g_final = args.in[14];
    float* H = args.out;
    const bool never = (args.ws == nullptr);
    float* SS = (float*)(ws + WS_SS);
    f32x2* TAX = (f32x2*)(ws + WS_TAX); f32x2* T1D = (f32x2*)(ws + WS_T1D);
    float* LSE = (float*)(ws + WS_LSE);
    bf16* OBG = (bf16*)(ws + WS_OBG); bf16* PB = (bf16*)(ws + WS_PB); bf16* BUFA = (bf16*)(ws + WS_BUFA); bf16* PROJ = (bf16*)(ws + WS_PROJ);
    bf16* HG = (bf16*)(ws + WS_HG); bf16* EB = (bf16*)(ws + WS_EB);

    for (int i = gt + MTOT / 4; i < 9 * MTOT / 4; i += NGT) ((f32x4*)SS)[i] = (f32x4){0.f, 0.f, 0.f, 0.f};
    for (int i = gt; i < 64 * 16 + 4096 * 32; i += NGT) {
        int pos, k; float ex; f32x2* dst;
        if (i < 1024) { pos = i >> 4; k = i & 15; ex = (float)(2 * k) / 32.f; dst = TAX + i; }
        else { const int j = i - 1024; pos = j >> 5; k = j & 31; ex = (float)(2 * k) / 64.f; dst = T1D + j; }
        const float freq = exp2f(-ex * 13.287712379549449f);
        double rev = (double)pos * (double)freq * 0.15915494309189535; rev -= floor(rev);
        const float rf = (float)rev;
        *dst = (f32x2){__builtin_amdgcn_cosf(rf), __builtin_amdgcn_sinf(rf)};
    }
    {
        LAS float* scr = (LAS float*)(ldsl + wave * 16384);
        constexpr int I_IN = 16 * 184, I_A = 8 * 32, I_B = 4 * 32, I_O = 16 * 32, I_PLE = 4 * 32, I_PG = 16 * 32, I_L = I_IN + I_A + I_B + I_O + I_PLE + I_PG;
        for (int it = gw; it < DEPTH * I_L; it += NGW) {
            const int layer = it / I_L; int r = it % I_L; unsigned char* wl = ws + WS_W + (size_t)layer * WL_STRIDE;
            if (r < I_IN) { transpose_item<true>(w_in + (size_t)layer * 1024 * 5888, 1024, 5888, (bf16*)(wl + WL_IN), scr, r, lane); continue; } r -= I_IN;
            if (r < I_A) { transpose_item<false>(w_a + (size_t)layer * 512 * 1024, 512, 1024, (bf16*)(wl + WL_A), scr, r, lane); continue; } r -= I_A;
            if (r < I_B) { transpose_item<false>(w_b + (size_t)layer * 256 * 1024, 256, 1024, (bf16*)(wl + WL_B), scr, r, lane); continue; } r -= I_B;
            if (r < I_O) { transpose_item<false>(w_o + (size_t)layer * 1024 * 1024, 1024, 1024, (bf16*)(wl + WL_O), scr, r, lane); continue; } r -= I_O;
            if (r < I_PLE) { transpose_item<false>(w_ple + (size_t)layer * 256 * 1024, 256, 1024, (bf16*)(wl + WL_PLE), scr, r, lane); continue; } r -= I_PLE;
            transpose_item<false>(w_pg + (size_t)layer * 1024 * 1024, 1024, 1024, (bf16*)(wl + WL_PG), scr, r, lane);
        }
    }

#pragma unroll 1
    for (int half = 0; half < 2; ++half) {
        const int grow0 = half * MH;
            LAUNDER();
        for (int lr0 = gw; lr0 < MH; lr0 += 2 * NGW) {
            f32x4 v[2][4]; const f32x4* xr[2];
#pragma unroll
            for (int k = 0; k < 2; ++k) { const int lr = lr0 + k * NGW < MH ? lr0 + k * NGW : lr0; const int gr = grow0 + lr;
                xr[k] = (const f32x4*)(gr < NPROMPT ? x_prompt + (size_t)gr * 1024 : x_sample + (size_t)(gr - NPROMPT) * 1024); }
#pragma unroll
            for (int k = 0; k < 2; ++k)
#pragma unroll
                for (int j = 0; j < 4; ++j) v[k][j] = __builtin_nontemporal_load(xr[k] + lane + 64 * j);
#pragma unroll
            for (int k = 0; k < 2; ++k) { const int lr = lr0 + k * NGW; if (lr < MH) { const int gr = grow0 + lr; float s = 0.f;
#pragma unroll
                for (int j = 0; j < 4; ++j) s += (v[k][j].x * v[k][j].x + v[k][j].y * v[k][j].y) + (v[k][j].z * v[k][j].z + v[k][j].w * v[k][j].w);
                s = wave_sum(s, lane); if (lane == 0) SS[gr] = s;
#pragma unroll
                for (int j = 0; j < 4; ++j) { ((f32x4*)(H + (size_t)gr * 1024))[lane + 64 * j] = v[k][j]; const f32x4 gg = ((const f32x4*)g_norm)[lane + 64 * j];
                    ((unsigned long long*)(BUFA + (size_t)lr * 1024))[lane + 64 * j] = (unsigned long long)pk2(v[k][j].x * gg.x, v[k][j].y * gg.y) | ((unsigned long long)pk2(v[k][j].z * gg.z, v[k][j].w * gg.w) << 32); } } }
        }
        grid.sync();
#pragma unroll 1
        for (int layer = 0; layer < DEPTH; ++layer) {
            unsigned char* wl = ws + WS_W + (size_t)layer * WL_STRIDE;
            LAUNDER();
            { pg8::Gemm g{BUFA, (const bf16*)(wl + WL_IN), MH, PITCH, 1024, 1024}; pg8::StaticOrder S; S.init(MH, PITCH, G, bx);
              pg8::EpiProj E{PROJ, PITCH, SS + (size_t)layer * MTOT, grow0, g_q + layer * 64, g_k + layer * 64, (const pg8::f32x2e*)TAX, (const pg8::f32x2e*)T1D};
              for (int rep_ = 0; rep_ < 1 + PROBE_P1; ++rep_) { LAUNDER(); pg8::gemm_phase<pg8::EpiProj, pg8::StaticOrder, true, true>(ldsl, g, S, E, wave); } }
            grid.sync();
            LAUNDER();
            { const attn_body::AttnTensors AT{(const attn_body::bf16*)(PROJ + C_QA), (const attn_body::bf16*)(PROJ + C_KA), (const attn_body::bf16*)(PROJ + C_VA), (attn_body::bf16*)(PROJ + C_QA), (const attn_body::bf16*)(PROJ + C_ZA)};
              for (int rep_ = PROBE_AA ? 0 : 1; rep_ < 2; ++rep_) { LAUNDER(); attn_body::attn_phase<8>((char*)lds, AT, vcu, G, wave, rep_ == 1 || never); } }
            __syncthreads();
            LAUNDER();
            { LAS char* wlds = (LAS char*)(ldsl + wave * 8448);
              for (int rep_ = PROBE_AB ? 0 : 1; rep_ < 2; ++rep_) { LAUNDER();
              for (int u = gw; u < 12 * 12 * 128; u += NGW) { const int b = u / 1536, rem = u - b * 1536; attnb_unit(PROJ, LSE, b, rem >> 7, rem & 127, wlds, lane, rep_ == 1 || never); } } }
            grid.sync();
            LAUNDER();
            for (int rep_ = 0; rep_ < 1 + PROBE_P4; ++rep_) { LAUNDER();
            for (int it0 = gt; it0 < MH * 32; it0 += 4 * NGT) {
                v4u a[4], bq[4], cq[4], z[4]; float l0[4], l1[4], l2[4];
#pragma unroll
                for (int k = 0; k < 4; ++k) { const int it = it0 + k * NGT < MH * 32 ? it0 + k * NGT : it0; const int lr = it >> 5, cc = it & 31, hh = cc >> 3, c = cc & 7;
                    const bf16* rp = PROJ + (size_t)lr * PITCH;
                    a[k] = *(const v4u*)(rp + C_QB + hh * 64 + c * 8); bq[k] = *(const v4u*)(rp + C_QB + (4 + hh) * 64 + c * 8); cq[k] = *(const v4u*)(rp + C_QB + (8 + hh) * 64 + c * 8); z[k] = *(const v4u*)(rp + C_ZB + hh * 64 + c * 8);
                    l0[k] = LSE[(size_t)lr * 12 + hh]; l1[k] = LSE[(size_t)lr * 12 + 4 + hh]; l2[k] = LSE[(size_t)lr * 12 + 8 + hh]; }
#pragma unroll
                for (int k = 0; k < 4; ++k) { const int it = it0 + k * NGT; if (it < MH * 32) { const int lr = it >> 5, cc = it & 31;
                    const float mx = fmaxf(l0[k], fmaxf(l1[k], l2[k])); float w0 = __builtin_amdgcn_exp2f(l0[k] - mx), w1 = __builtin_amdgcn_exp2f(l1[k] - mx), w2 = __builtin_amdgcn_exp2f(l2[k] - mx);
                    const float inv = __builtin_amdgcn_rcpf(w0 + w1 + w2); w0 *= inv; w1 *= inv; w2 *= inv;
                    v4u o;
#pragma unroll
                    for (int e = 0; e < 4; ++e) { const float z0 = blo(z[k][e]), z1 = bhi(z[k][e]);
                        const float s0 = z0 * __builtin_amdgcn_rcpf(1.f + __expf(-z0)), s1 = z1 * __builtin_amdgcn_rcpf(1.f + __expf(-z1));
                        o[e] = pk2((w0 * blo(a[k][e]) + w1 * blo(bq[k][e]) + w2 * blo(cq[k][e])) * s0, (w0 * bhi(a[k][e]) + w1 * bhi(bq[k][e]) + w2 * bhi(cq[k][e])) * s1); }
                    *(v4u*)(OBG + (size_t)lr * 256 + cc * 8) = o; } }
            } }
            LAUNDER();
            for (int it0 = gt; it0 < MH * 32; it0 += 4 * NGT) {
                f32x4 a[4], bq[4];
#pragma unroll
                for (int k = 0; k < 4; ++k) { const int it = it0 + k * NGT < MH * 32 ? it0 + k * NGT : it0; const int lr = it >> 5, c = it & 31, gr = grow0 + lr;
                    const float* pr = gr < NPROMPT ? p_prompt + ((size_t)layer * NPROMPT + gr) * PLE : p_sample + ((size_t)layer * (MTOT - NPROMPT) + (gr - NPROMPT)) * PLE;
                    a[k] = __builtin_nontemporal_load((const f32x4*)pr + 2 * c); bq[k] = __builtin_nontemporal_load((const f32x4*)pr + 2 * c + 1); }
#pragma unroll
                for (int k = 0; k < 4; ++k) { const int it = it0 + k * NGT; if (it < MH * 32) { const int lr = it >> 5, c = it & 31;
                    v4u o; o.x = pk2(a[k].x, a[k].y); o.y = pk2(a[k].z, a[k].w); o.z = pk2(bq[k].x, bq[k].y); o.w = pk2(bq[k].z, bq[k].w); *(v4u*)(PB + (size_t)lr * PLE + c * 8) = o; } }
            }
            grid.sync();
            LAUNDER();
            for (int rep_ = 0; rep_ < 1 + PROBE_P5; ++rep_) {
            LAUNDER();
            { pg8::Gemm g{PROJ + C_QA, (const bf16*)(wl + WL_A), MH, 1024, 512, PITCH}; pg8::StaticOrder S; S.init(MH, 1024, G, bx);
              pg8::EpiGate<false> E{BUFA, 1024, PROJ + C_GA, PITCH};
              pg8::gemm_phase<pg8::EpiGate<false>, pg8::StaticOrder, true, true>(ldsl, g, S, E, wave); }
            LAUNDER();
            { pg8::Gemm g{OBG, (const bf16*)(wl + WL_B), MH, 1024, 256, 256}; pg8::StaticOrder S; S.init(MH, 1024, G, bx);
              pg8::EpiGate<true> E{BUFA, 1024, PROJ + C_GB, PITCH};
              pg8::gemm_phase<pg8::EpiGate<true>, pg8::StaticOrder, true, true>(ldsl, g, S, E, wave); } }
            grid.sync();
            LAUNDER();
            for (int rep_ = PROBE_P6 ? 0 : 1; rep_ < 2; ++rep_) {
            LAUNDER();
            { pg8::Gemm g{BUFA, (const bf16*)(wl + WL_O), MH, 1024, 1024, 1024}; pg8::StaticOrder S; S.init(MH, 1024, G, bx);
              pg8::EpiResid<false> E{H, nullptr, SS + (size_t)(5 + layer) * MTOT, nullptr, HG, g_ple + layer * 1024, grow0, rep_ == 1 || never};
              pg8::gemm_phase<pg8::EpiResid<false>, pg8::StaticOrder, true, true>(ldsl, g, S, E, wave); }
            LAUNDER();
            { pg8::Gemm g{PB, (const bf16*)(wl + WL_PLE), MH, 1024, 256, 256}; pg8::StaticOrder S; S.init(MH, 1024, G, bx);
              pg8::EpiPlain E{EB, 1024};
              pg8::gemm_phase<pg8::EpiPlain, pg8::StaticOrder, true, true>(ldsl, g, S, E, wave); } }
            grid.sync();
            LAUNDER();
            for (int rep_ = PROBE_P7 ? 0 : 1; rep_ < 2; ++rep_) {
            LAUNDER();
            { pg8::Gemm g{HG, (const bf16*)(wl + WL_PG), MH, 1024, 1024, 1024}; pg8::StaticOrder S; S.init(MH, 1024, G, bx);
              pg8::EpiResid<true> E{H, SS + (size_t)(5 + layer) * MTOT, SS + (size_t)(layer + 1) * MTOT, EB, layer < DEPTH - 1 ? BUFA : nullptr, g_norm + (layer < DEPTH - 1 ? layer + 1 : 0) * 1024, grow0, rep_ == 1 || never};
              pg8::gemm_phase<pg8::EpiResid<true>, pg8::StaticOrder, true, true>(ldsl, g, S, E, wave); } }
            grid.sync();
        }
    }
            LAUNDER();
    for (int gr0 = gw; gr0 < MTOT; gr0 += 4 * NGW) {
        f32x4 v[4][4]; float rs[4];
#pragma unroll
        for (int k = 0; k < 4; ++k) { const int gr = gr0 + k * NGW < MTOT ? gr0 + k * NGW : gr0; rs[k] = SS[(size_t)4 * MTOT + gr];
#pragma unroll
            for (int j = 0; j < 4; ++j) v[k][j] = ((const f32x4*)(H + (size_t)gr * 1024))[lane + 64 * j]; }
#pragma unroll
        for (int k = 0; k < 4; ++k) { const int gr = gr0 + k * NGW; if (gr < MTOT) { const float r_ = __builtin_amdgcn_rsqf(rs[k] * (1.f / 1024.f) + 1e-6f);
#pragma unroll
            for (int j = 0; j < 4; ++j) { const f32x4 gg = ((const f32x4*)g_final)[lane + 64 * j]; __builtin_nontemporal_store(v[k][j] * gg * r_, (f32x4*)(H + (size_t)gr * 1024) + lane + 64 * j); } } }
    }
}

#undef lane
#undef gt
#undef bx
#undef vcu
#undef gw
extern "C" void kernel_launch(void* const* d_in, const int* in_sizes, int n_in, void* d_out, int out_size, void* d_ws, size_t ws_size, hipStream_t stream) {
    static int grid = 0;
    if (grid == 0) {
        if (n_in != 15 || out_size != MTOT * DM_ || ws_size < WS_END) { fprintf(stderr, "kernel_launch: unexpected shapes (n_in %d out %d ws %zu)\n", n_in, out_size, ws_size); grid = -1; return; }
        int dev = 0, cus = 0, per_cu = 0;
        (void)hipGetDevice(&dev); (void)hipDeviceGetAttribute(&cus, hipDeviceAttributeMultiprocessorCount, dev);
        (void)hipFuncSetAttribute((const void*)fwd_mega, hipFuncAttributeMaxDynamicSharedMemorySize, LDS_BYTES);
        (void)hipOccupancyMaxActiveBlocksPerMultiprocessor(&per_cu, (const void*)fwd_mega, NWAVES * 64, LDS_BYTES);
        if (per_cu < 1) per_cu = 1;
        grid = cus * per_cu;
        (void)hipGetLastError();
    }
    if (grid < 0) return;
    Args a{};
    for (int i = 0; i < 15; ++i) a.in[i] = (const float*)d_in[i];
    a.out = (float*)d_out; a.ws = (unsigned char*)d_ws;
    void* kargs[] = {&a};
    hipError_t e = hipLaunchCooperativeKernel((const void*)fwd_mega, dim3(grid), dim3(NWAVES * 64), kargs, LDS_BYTES, stream);
    if (e != hipSuccess) fprintf(stderr, "cooperative launch failed: %s (grid %d)\n", hipGetErrorString(e), grid);
}
```

```cpp
#include <hip/hip_runtime.h>
#include <hip/hip_cooperative_groups.h>
namespace cg = cooperative_groups;
__device__ __forceinline__ float shx(float v, int lane, int m) { return __builtin_bit_cast(float, __builtin_amdgcn_ds_bpermute((lane ^ m) << 2, __builtin_bit_cast(int, v))); }
__device__ __forceinline__ int lane_now() { int l; asm volatile("v_mbcnt_lo_u32_b32 %0, -1, 0\n\tv_mbcnt_hi_u32_b32 %0, -1, %0" : "=v"(l)); return l; }
#include <hip/hip_runtime.h>
#include <cstdio>
#include <cstdint>
namespace pg8 {
#define PG8_LAS __attribute__((address_space(3)))
typedef unsigned short bf16_t;
typedef short bf16x8 __attribute__((ext_vector_type(8)));
typedef float f32x4 __attribute__((ext_vector_type(4)));
typedef unsigned u32x4 __attribute__((ext_vector_type(4)));
constexpr int BM = 256, BK = 64, HALF = 128, HTB = HALF * BK * 2  , STAGE_BYTES = 8 * HTB, NXCD = 8, WGM = 8;

__host__ __device__ __forceinline__ int lds_byte(int r, int c) { const int st = (r >> 4) * 2 + (c >> 5), rr = r & 15, cc = c & 31, ob = rr * 64 + cc * 2; return st * 1024 + (ob ^ (((ob >> 9) & 1) << 5)); }
__host__ __device__ __forceinline__ void stage_rc(int b, int& R, int& C) { const int st = b / 1024, sb = b % 1024, swz = sb ^ (((sb >> 9) & 1) << 5); R = (st >> 1) * 16 + swz / 64; C = (st & 1) * 32 + (swz % 64) / 2; }
__host__ __device__ __forceinline__ int perm32(int rho) { const int n = rho >> 4, i = rho & 15; return 8 * (i >> 2) + 4 * n + (i & 3); }

struct Unit { int pm, pn; };
struct Gemm { const bf16_t* A; const bf16_t* Bt; int M, N, K, lda; };

struct StaticOrder {
    int nM, nN, nwg, G, c;
    __host__ __device__ void init(int M, int N, int G_, int c_) { nM = M / BM; nN = N / BM; nwg = nM * nN; G = G_; c = c_; }
    __host__ __device__ bool next(int i, Unit& u) const {
        const long L = (long)i * G + c; if (L >= nwg) return false;
        int wgid = (int)L; { const int q = nwg / NXCD, r = nwg % NXCD, xcd = wgid % NXCD, off = wgid / NXCD; wgid = (xcd < r ? xcd * (q + 1) : r * (q + 1) + (xcd - r) * q) + off; }
        const int nig = WGM * nN, gid = wgid / nig, fm = gid * WGM, gsz = (nM - fm) < WGM ? (nM - fm) : WGM;
        u.pm = fm + ((wgid % nig) % gsz); u.pn = (wgid % nig) / gsz; return true;
    }
    __device__ __forceinline__ void a_ready(const Unit&) const {}
    __device__ __forceinline__ void done(const Unit&) const {}
};

template <class Epi, class Sched, bool ALIGN_EPI = false, bool SP2 = false>
__device__ __forceinline__ void gemm_phase(PG8_LAS unsigned char* lds, const Gemm g, const Sched& S, const Epi& E, const int wave_id) {
    const int tid = wave_id * 64 + lane_now(), wid = wave_id, lane = tid & 63, wr = wid >> 2, wc = wid & 3, fr = lane & 15, fq = lane >> 4;
    const int K = g.K, nt = K / BK;
    unsigned voffA[2], voffB[2];
#pragma unroll
    for (int i = 0; i < 2; ++i) { int R, C; stage_rc(tid * 16 + i * 8192, R, C); const int Rb = Epi::PERM ? ((R & ~31) + perm32(R & 31)) : R;
        voffA[i] = (unsigned)(R * g.lda + C) * 2u; voffB[i] = (unsigned)(Rb * K + C) * 2u; }
    const size_t kstep = (size_t)(BK * 2);
    const size_t hstep = (size_t)HALF * K * 2;
    const size_t tstep = 2 * hstep; const size_t hstepA = (size_t)HALF * g.lda * 2, tstepA = 2 * hstepA;
    const unsigned ldsw = (unsigned)wid * 1024u;
    const int aoff = lds_byte(wr * 64 + fr, fq * 8), boff = lds_byte(wc * 32 + fr, fq * 8);
#define PG8_SA(b, h) (((b) * 2 + (h)) * HTB)
#define PG8_SB(b, h) ((4 + (b) * 2 + (h)) * HTB)
#define PG8_STAGE(bufoff, gbase, voff) do { _Pragma("unroll") for (int _i = 0; _i < 2; ++_i) \
        __builtin_amdgcn_global_load_lds((const unsigned*)((const char*)(gbase) + (voff)[_i]), (PG8_LAS unsigned*)(lds + (bufoff) + ldsw + _i * 8192), 16, 0, 0); } while (0)
#define PG8_LDA(dst, b, h) do { _Pragma("unroll") for (int m = 0; m < 4; ++m) _Pragma("unroll") for (int k = 0; k < 2; ++k) dst[m][k] = *(const PG8_LAS bf16x8*)(lds + PG8_SA(b, h) + aoff + m * 2048 + k * 1024); } while (0)
#define PG8_LDB(dst, b, h) do { _Pragma("unroll") for (int n = 0; n < 2; ++n) _Pragma("unroll") for (int k = 0; k < 2; ++k) dst[n][k] = *(const PG8_LAS bf16x8*)(lds + PG8_SB(b, h) + boff + n * 2048 + k * 1024); } while (0)
#define PG8_MMA(ai, bj, At, Bt) do { __builtin_amdgcn_s_setprio(1); _Pragma("unroll") for (int m = 0; m < 4; ++m) _Pragma("unroll") for (int n = 0; n < 2; ++n) _Pragma("unroll") for (int k = 0; k < 2; ++k) \
        acc[ai][bj][m][n] = __builtin_amdgcn_mfma_f32_16x16x32_bf16(Bt[n][k], At[m][k], acc[ai][bj][m][n], 0, 0, 0); __builtin_amdgcn_s_setprio(0); } while (0)
#define PG8_WAIT_V(n) asm volatile("s_waitcnt vmcnt(" #n ")" ::: "memory")
#define PG8_WAIT_L(n) asm volatile("s_waitcnt lgkmcnt(" #n ")" ::: "memory")
#define PG8_BAR __builtin_amdgcn_s_barrier()
#define PG8_SCHED __builtin_amdgcn_sched_barrier(0)
    Unit cur, nxt; int ui = 0;
    if (!S.next(0, cur)) return;
    f32x4 acc[2][2][4][2];
#pragma unroll
    for (int a = 0; a < 2; ++a)
#pragma unroll
        for (int b = 0; b < 2; ++b)
#pragma unroll
            for (int m = 0; m < 4; ++m)
#pragma unroll
                for (int n = 0; n < 2; ++n) acc[a][b][m][n] = (f32x4){0.f, 0.f, 0.f, 0.f};
    bf16x8 At[4][2], B0[2][2], B1[2][2];
    const char* cA = (const char*)g.A + (size_t)cur.pm * tstepA; const char* cB = (const char*)g.Bt + (size_t)cur.pn * tstep;
    S.a_ready(cur);
    if constexpr (SP2) {
        PG8_STAGE(PG8_SB(0, 0), cB, voffB); PG8_STAGE(PG8_SB(0, 1), cB + hstep, voffB); PG8_STAGE(PG8_SA(0, 0), cA, voffA); PG8_STAGE(PG8_SA(0, 1), cA + hstepA, voffA);
        if (wr == 1) PG8_BAR;
        PG8_WAIT_V(2); PG8_BAR;
        PG8_STAGE(PG8_SB(1, 0), cB + kstep, voffB); PG8_STAGE(PG8_SA(1, 0), cA + kstep, voffA); PG8_STAGE(PG8_SB(1, 1), cB + hstep + kstep, voffB);
        PG8_WAIT_V(6); PG8_BAR;
    } else {
        PG8_STAGE(PG8_SB(0, 0), cB, voffB); PG8_STAGE(PG8_SA(0, 0), cA, voffA); PG8_STAGE(PG8_SB(0, 1), cB + hstep, voffB); PG8_STAGE(PG8_SA(0, 1), cA + hstepA, voffA);
        if (wr == 1) PG8_BAR;
        PG8_WAIT_V(4); PG8_BAR;
        PG8_STAGE(PG8_SB(1, 0), cB + kstep, voffB); PG8_STAGE(PG8_SA(1, 0), cA + kstep, voffA); PG8_STAGE(PG8_SB(1, 1), cB + hstep + kstep, voffB);
        PG8_WAIT_V(6); PG8_BAR;
    }
    for (;;) {
        const bool has_next = S.next(ui + 1, nxt);
        const char* nA = has_next ? (const char*)g.A + (size_t)nxt.pm * tstepA : cA; const char* nB = has_next ? (const char*)g.Bt + (size_t)nxt.pn * tstep : cB;
        for (int t = 0; t < nt; t += 2) {
            const bool last = (t == nt - 2);
            const char* a1 = cA + (size_t)(t + 1) * kstep;
            const char* a2 = last ? nA : cA + (size_t)(t + 2) * kstep; const char* b2 = last ? nB : cB + (size_t)(t + 2) * kstep;
            const char* a3 = a2 + kstep; const char* b3 = b2 + kstep;
            if (last && has_next) S.a_ready(nxt);
            if constexpr (SP2) {
            PG8_LDB(B0, 0, 0); PG8_LDB(B1, 0, 1); PG8_SCHED; PG8_LDA(At, 0, 0); PG8_STAGE(PG8_SA(1, 1), a1 + hstepA, voffA);
            PG8_WAIT_V(8); PG8_WAIT_L(0); PG8_BAR; PG8_MMA(0, 0, At, B0); PG8_MMA(0, 1, At, B1); PG8_BAR; PG8_SCHED;
            PG8_LDA(At, 0, 1); PG8_STAGE(PG8_SB(0, 0), b2, voffB); PG8_STAGE(PG8_SB(0, 1), b2 + hstep, voffB); PG8_STAGE(PG8_SA(0, 0), a2, voffA);
            PG8_WAIT_V(8); PG8_WAIT_L(0); PG8_BAR; PG8_MMA(1, 0, At, B0); PG8_MMA(1, 1, At, B1); PG8_BAR; PG8_SCHED;
            PG8_LDB(B0, 1, 0); PG8_LDB(B1, 1, 1); PG8_SCHED; PG8_LDA(At, 1, 0); PG8_STAGE(PG8_SA(0, 1), a2 + hstepA, voffA);
            PG8_WAIT_V(8); PG8_WAIT_L(0); PG8_BAR; PG8_MMA(0, 0, At, B0); PG8_MMA(0, 1, At, B1); PG8_BAR; PG8_SCHED;
            PG8_LDA(At, 1, 1); PG8_STAGE(PG8_SB(1, 0), b3, voffB); PG8_STAGE(PG8_SB(1, 1), b3 + hstep, voffB); PG8_STAGE(PG8_SA(1, 0), a3, voffA);
            PG8_WAIT_V(8); PG8_WAIT_L(0); PG8_BAR; PG8_MMA(1, 0, At, B0); PG8_MMA(1, 1, At, B1); PG8_BAR; PG8_SCHED;
            } else {
            PG8_LDB(B0, 0, 0); PG8_SCHED; PG8_LDA(At, 0, 0); PG8_STAGE(PG8_SA(1, 1), a1 + hstepA, voffA);
            PG8_WAIT_L(8); PG8_BAR; PG8_WAIT_L(0); PG8_MMA(0, 0, At, B0); PG8_BAR; PG8_SCHED;
            PG8_LDB(B1, 0, 1); PG8_STAGE(PG8_SB(0, 0), b2, voffB);
            PG8_BAR; PG8_WAIT_L(0); PG8_MMA(0, 1, At, B1); PG8_BAR;
            PG8_LDA(At, 0, 1); PG8_STAGE(PG8_SA(0, 0), a2, voffA);
            PG8_BAR; PG8_WAIT_L(0); PG8_MMA(1, 0, At, B0); PG8_BAR; PG8_SCHED;
            PG8_STAGE(PG8_SB(0, 1), b2 + hstep, voffB);
            PG8_WAIT_V(6); PG8_BAR; PG8_MMA(1, 1, At, B1); PG8_BAR;
            PG8_LDB(B0, 1, 0); PG8_SCHED; PG8_LDA(At, 1, 0); PG8_STAGE(PG8_SA(0, 1), a2 + hstepA, voffA);
            PG8_WAIT_L(8); PG8_BAR; PG8_WAIT_L(0); PG8_MMA(0, 0, At, B0); PG8_BAR; PG8_SCHED;
            PG8_LDB(B1, 1, 1); PG8_STAGE(PG8_SB(1, 0), b3, voffB);
            PG8_BAR; PG8_WAIT_L(0); PG8_MMA(0, 1, At, B1); PG8_BAR;
            PG8_LDA(At, 1, 1); PG8_STAGE(PG8_SA(1, 0), a3, voffA);
            PG8_BAR; PG8_WAIT_L(0); PG8_MMA(1, 0, At, B0); PG8_BAR; PG8_SCHED;
            PG8_STAGE(PG8_SB(1, 1), b3 + hstep, voffB);
            PG8_WAIT_V(6); PG8_BAR; PG8_MMA(1, 1, At, B1); PG8_BAR;
            }
        }
        if constexpr (ALIGN_EPI) { if (wr == 0) PG8_BAR; }
        if constexpr (!Epi::AFTER_DRAIN) { E(acc, cur, wr, wc, fr, fq); S.done(cur); }
        if (!has_next) break;
#pragma unroll
        for (int a = 0; a < 2; ++a)
#pragma unroll
            for (int b = 0; b < 2; ++b)
#pragma unroll
                for (int m = 0; m < 4; ++m)
#pragma unroll
                    for (int n = 0; n < 2; ++n) acc[a][b][m][n] = (f32x4){0.f, 0.f, 0.f, 0.f};
        cur = nxt; cA = nA; cB = nB; ++ui;
        if constexpr (ALIGN_EPI) { if (wr == 1) PG8_BAR; }
    }
    PG8_WAIT_V(0);
    if constexpr (!ALIGN_EPI) { if (wr == 0) PG8_BAR; }
    PG8_BAR;
    if constexpr (Epi::AFTER_DRAIN) { E.fused(acc, cur, wr, wc, fr, fq, lds, wid, lane); S.done(cur); }
#undef PG8_SA
#undef PG8_SB
#undef PG8_STAGE
#undef PG8_LDA
#undef PG8_LDB
#undef PG8_MMA
#undef PG8_WAIT_V
#undef PG8_WAIT_L
#undef PG8_BAR
#undef PG8_SCHED
}
}
namespace pg8 {
__device__ __forceinline__ unsigned cvt_pk_bf16(float lo, float hi) { unsigned r; asm volatile("v_cvt_pk_bf16_f32 %0, %1, %2" : "=v"(r) : "v"(lo), "v"(hi)); return r; }
__device__ __forceinline__ float bf_lo(unsigned w) { return __uint_as_float(w << 16); }
__device__ __forceinline__ float bf_hi(unsigned w) { return __uint_as_float(w & 0xffff0000u); }
__device__ __forceinline__ float sigm(float x) { return __builtin_amdgcn_rcpf(1.f + __expf(-x)); }
#define EPI_ROWS_BEGIN \
    const int row0 = u.pm * BM + wr * 64 + fr; const int col0 = u.pn * BM + wc * 32 + 8 * fq; \
    _Pragma("unroll") for (int ai = 0; ai < 2; ++ai) _Pragma("unroll") for (int m = 0; m < 4; ++m) { const int lr = row0 + ai * HALF + m * 16;
#define EPI_ROWS_END }
typedef float f32x2e __attribute__((ext_vector_type(2)));
struct EpiProj {
    static constexpr bool PERM = true, AFTER_DRAIN = false;
    bf16_t* O; int ldc; const float* ss; int grow0; const float* gq; const float* gk; const f32x2e* tax; const f32x2e* t1d;
    __device__ __forceinline__ void operator()(const f32x4 (&acc)[2][2][4][2], const Unit& u, int wr, int wc, int fr_, int fq_) const {
        const int l_ = lane_now(), fr = l_ & 15, fq = l_ >> 4;
        const int pn = u.pn;
        const int kind = pn < 2 ? 1 : (pn == 2 ? (wc < 2 ? 2 : 0) : (pn < 5 ? 0 : (pn < 8 ? 3 : (pn < 11 ? 4 : 0))));
        const int row0 = u.pm * BM + wr * 64 + fr; const int ocol = pn * BM + wc * 64 + 8 * fq;
        const float C2v = 0.125f * 1.4426950408889634f;
        if (kind == 0) {
#pragma unroll
            for (int ai = 0; ai < 2; ++ai)
#pragma unroll
                for (int m = 0; m < 4; ++m) { const int lr = row0 + ai * HALF + m * 16;
                    const float rs = __builtin_amdgcn_rsqf(ss[grow0 + lr] * (1.f / 1024.f) + 1e-6f);
                    bf16_t* rowp = O + (size_t)lr * ldc + ocol;
#pragma unroll
                    for (int bj = 0; bj < 2; ++bj) { const f32x4 v0 = acc[ai][bj][m][0] * rs, v1 = acc[ai][bj][m][1] * rs;
                        u32x4 w; w.x = cvt_pk_bf16(v0[0], v0[1]); w.y = cvt_pk_bf16(v0[2], v0[3]); w.z = cvt_pk_bf16(v1[0], v1[1]); w.w = cvt_pk_bf16(v1[2], v1[3]);
                        *(u32x4*)(rowp + bj * 32) = w; } }
        } else if (kind <= 2) {
            const float* gp = (kind == 1 ? gq : gk) + 8 * fq; const float osc = kind == 1 ? C2v : 1.f;
            float gv[2][8];
#pragma unroll
            for (int bj = 0; bj < 2; ++bj)
#pragma unroll
                for (int i = 0; i < 8; ++i) gv[bj][i] = gp[bj * 32 + i] * osc;
            const float sgn = fq < 2 ? -1.f : 1.f;
#pragma unroll
            for (int ai = 0; ai < 2; ++ai)
#pragma unroll
                for (int m = 0; m < 4; ++m) { const int lr = row0 + ai * HALF + m * 16; const int t = lr & 4095;
                    const float rs = __builtin_amdgcn_rsqf(ss[grow0 + lr] * (1.f / 1024.f) + 1e-6f);
                    float x[2][8]; float sq = 0.f;
#pragma unroll
                    for (int bj = 0; bj < 2; ++bj)
#pragma unroll
                        for (int i = 0; i < 8; ++i) { x[bj][i] = acc[ai][bj][m][i >> 2][i & 3] * rs; sq += x[bj][i] * x[bj][i]; }
                    sq += shx(sq, l_, 16); sq += shx(sq, l_, 32);
                    const float rn = __builtin_amdgcn_rsqf(sq * (1.f / 64.f) + 1e-6f);
                    bf16_t* rowp = O + (size_t)lr * ldc + ocol;
#pragma unroll
                    for (int bj = 0; bj < 2; ++bj) { const f32x2e* tb = tax + (bj == 0 ? (t >> 6) : (t & 63)) * 16 + 8 * (fq & 1);
                        float y[8];
#pragma unroll
                        for (int i = 0; i < 8; ++i) { const float xv = x[bj][i] * rn * gv[bj][i]; const float xp = shx(xv, l_, 32); const f32x2e cs = tb[i]; y[i] = xv * cs.x + sgn * xp * cs.y; }
                        u32x4 w; w.x = cvt_pk_bf16(y[0], y[1]); w.y = cvt_pk_bf16(y[2], y[3]); w.z = cvt_pk_bf16(y[4], y[5]); w.w = cvt_pk_bf16(y[6], y[7]);
                        *(u32x4*)(rowp + bj * 32) = w; } }
        } else {
            const float osc = kind == 3 ? C2v : 1.f;
#pragma unroll
            for (int ai = 0; ai < 2; ++ai)
#pragma unroll
                for (int m = 0; m < 4; ++m) { const int lr = row0 + ai * HALF + m * 16; const int t = lr & 4095;
                    const float rs = __builtin_amdgcn_rsqf(ss[grow0 + lr] * (1.f / 1024.f) + 1e-6f) * osc;
                    const f32x2e* tb = t1d + t * 32 + 8 * fq;
                    float y0[8], y1[8];
#pragma unroll
                    for (int i = 0; i < 8; ++i) { const float x0 = acc[ai][0][m][i >> 2][i & 3] * rs, x1 = acc[ai][1][m][i >> 2][i & 3] * rs; const f32x2e cs = tb[i];
                        y0[i] = x0 * cs.x - x1 * cs.y; y1[i] = x1 * cs.x + x0 * cs.y; }
                    bf16_t* rowp = O + (size_t)lr * ldc + ocol;
                    u32x4 w; w.x = cvt_pk_bf16(y0[0], y0[1]); w.y = cvt_pk_bf16(y0[2], y0[3]); w.z = cvt_pk_bf16(y0[4], y0[5]); w.w = cvt_pk_bf16(y0[6], y0[7]);
                    *(u32x4*)(rowp) = w;
                    w.x = cvt_pk_bf16(y1[0], y1[1]); w.y = cvt_pk_bf16(y1[2], y1[3]); w.z = cvt_pk_bf16(y1[4], y1[5]); w.w = cvt_pk_bf16(y1[6], y1[7]);
                    *(u32x4*)(rowp + 32) = w; }
        }
    }
};
template <bool ADD> struct EpiGate {
    static constexpr bool PERM = true, AFTER_DRAIN = false;
    bf16_t* O; int ldc; const bf16_t* G; int ldg;
    __device__ __forceinline__ void operator()(const f32x4 (&acc)[2][2][4][2], const Unit& u, int wr, int wc, int fr_, int fq_) const { const int l_ = lane_now(), fr = l_ & 15, fq = l_ >> 4;
        EPI_ROWS_BEGIN
            bf16_t* rowp = O + (size_t)lr * ldc + col0; const bf16_t* gp = G + (size_t)lr * ldg + col0;
#pragma unroll
            for (int bj = 0; bj < 2; ++bj) { const u32x4 gw = *(const u32x4*)(gp + bj * HALF); u32x4 pv = (u32x4){0u, 0u, 0u, 0u}; if (ADD) pv = *(const u32x4*)(rowp + bj * HALF);
                const f32x4 a0 = acc[ai][bj][m][0], a1 = acc[ai][bj][m][1]; u32x4 w;
                w.x = cvt_pk_bf16(bf_lo(pv.x) + sigm(bf_lo(gw.x)) * a0[0], bf_hi(pv.x) + sigm(bf_hi(gw.x)) * a0[1]);
                w.y = cvt_pk_bf16(bf_lo(pv.y) + sigm(bf_lo(gw.y)) * a0[2], bf_hi(pv.y) + sigm(bf_hi(gw.y)) * a0[3]);
                w.z = cvt_pk_bf16(bf_lo(pv.z) + sigm(bf_lo(gw.z)) * a1[0], bf_hi(pv.z) + sigm(bf_hi(gw.z)) * a1[1]);
                w.w = cvt_pk_bf16(bf_lo(pv.w) + sigm(bf_lo(gw.w)) * a1[2], bf_hi(pv.w) + sigm(bf_hi(gw.w)) * a1[3]);
                *(u32x4*)(rowp + bj * HALF) = w; }
        EPI_ROWS_END
    }
};
struct EpiPlain {
    static constexpr bool PERM = true, AFTER_DRAIN = false;
    bf16_t* O; int ldc;
    __device__ __forceinline__ void operator()(const f32x4 (&acc)[2][2][4][2], const Unit& u, int wr, int wc, int fr_, int fq_) const { const int l_ = lane_now(), fr = l_ & 15, fq = l_ >> 4;
        EPI_ROWS_BEGIN
            bf16_t* rowp = O + (size_t)lr * ldc + col0;
#pragma unroll
            for (int bj = 0; bj < 2; ++bj) { const f32x4 v0 = acc[ai][bj][m][0], v1 = acc[ai][bj][m][1];
                u32x4 w; w.x = cvt_pk_bf16(v0[0], v0[1]); w.y = cvt_pk_bf16(v0[2], v0[3]); w.z = cvt_pk_bf16(v1[0], v1[1]); w.w = cvt_pk_bf16(v1[2], v1[3]);
                *(u32x4*)(rowp + bj * HALF) = w; }
        EPI_ROWS_END
    }
};
template <bool GATED> struct EpiResid {
    static constexpr bool PERM = true, AFTER_DRAIN = false;
    float* H; const float* ss_in; float* ss_out; const bf16_t* E; bf16_t* XO; const float* gvec; int grow0; bool st;
    __device__ __forceinline__ void operator()(const f32x4 (&acc)[2][2][4][2], const Unit& u, int wr, int wc, int fr_, int fq_) const { const int l_ = lane_now(), fr = l_ & 15, fq = l_ >> 4;
        f32x4 gv[2][2];
#pragma unroll
        for (int bj = 0; bj < 2; ++bj)
#pragma unroll
            for (int n = 0; n < 2; ++n) gv[bj][n] = XO ? *(const f32x4*)(gvec + u.pn * BM + wc * 32 + 8 * fq + bj * HALF + 4 * n) : (f32x4){0.f, 0.f, 0.f, 0.f};
        EPI_ROWS_BEGIN
            const int gr = grow0 + lr; float* hp = H + (size_t)gr * 1024 + col0;
            float rs = 1.f; if (GATED) rs = __builtin_amdgcn_rsqf(ss_in[gr] * (1.f / 1024.f) + 1e-6f);
            float sq = 0.f;
#pragma unroll
            for (int bj = 0; bj < 2; ++bj) {
                f32x4 h0 = *(const f32x4*)(hp + bj * HALF), h1 = *(const f32x4*)(hp + bj * HALF + 4);
                f32x4 a0 = acc[ai][bj][m][0], a1 = acc[ai][bj][m][1];
                if (GATED) { const u32x4 ew = *(const u32x4*)(E + (size_t)lr * 1024 + col0 + bj * HALF);
                    a0[0] = sigm(a0[0] * rs) * bf_lo(ew.x); a0[1] = sigm(a0[1] * rs) * bf_hi(ew.x); a0[2] = sigm(a0[2] * rs) * bf_lo(ew.y); a0[3] = sigm(a0[3] * rs) * bf_hi(ew.y);
                    a1[0] = sigm(a1[0] * rs) * bf_lo(ew.z); a1[1] = sigm(a1[1] * rs) * bf_hi(ew.z); a1[2] = sigm(a1[2] * rs) * bf_lo(ew.w); a1[3] = sigm(a1[3] * rs) * bf_hi(ew.w); }
                h0 = h0 + a0; h1 = h1 + a1;
                if (st) { *(f32x4*)(hp + bj * HALF) = h0; *(f32x4*)(hp + bj * HALF + 4) = h1; }
                sq += (h0[0] * h0[0] + h0[1] * h0[1]) + (h0[2] * h0[2] + h0[3] * h0[3]) + (h1[0] * h1[0] + h1[1] * h1[1]) + (h1[2] * h1[2] + h1[3] * h1[3]);
                if (XO) { const f32x4 x0 = h0 * gv[bj][0], x1 = h1 * gv[bj][1];
                    u32x4 w; w.x = cvt_pk_bf16(x0[0], x0[1]); w.y = cvt_pk_bf16(x0[2], x0[3]); w.z = cvt_pk_bf16(x1[0], x1[1]); w.w = cvt_pk_bf16(x1[2], x1[3]);
                    if (st) *(u32x4*)(XO + (size_t)lr * 1024 + col0 + bj * HALF) = w; }
            }
            sq += shx(sq, fr + 16 * fq, 16); sq += shx(sq, fr + 16 * fq, 32);
            if (fq == 0 && st) unsafeAtomicAdd(ss_out + gr, sq);
        EPI_ROWS_END
    }
};
}
#include <hip/hip_bf16.h>
#include <cmath>
namespace attn_body {
using bf16=__hip_bfloat16;
using bf16x8=__attribute__((ext_vector_type(8)))short;
using s16x4=__attribute__((ext_vector_type(4)))short;
using f32x16=__attribute__((ext_vector_type(16)))float;
using u32x4=__attribute__((ext_vector_type(4)))unsigned;
constexpr int NHEAD=8,SEQ=4096,D=64,DM=5888;
constexpr int NW=8,QBLK=32,QB=QBLK*NW,KVBLK=64,NQB=SEQ/QB;
constexpr int ATTN_PITCH=DM, ATTN_UNIT_ROWS=QB;
__device__ __forceinline__ int crow(int r,int hi){return (r&3)+8*(r>>2)+4*hi;}
#define SBAR() __builtin_amdgcn_sched_barrier(0)
__device__ __forceinline__ void cmask(f32x16&p0,f32x16&p1,int jb,int qrel,int hi){
  const float NEG=-INFINITY; int kb=64*jb+4*hi;
  #pragma unroll
  for(int r=0;r<16;++r){int kv=kb+(r&3)+8*(r>>2); if(kv>qrel)p0[r]=NEG; if(kv+32>qrel)p1[r]=NEG;}
}

constexpr int NSLOT=3, SLOTB=8192;
constexpr int LDS_K=0, LDS_V=NSLOT*SLOTB, LDS_WS=2*NSLOT*SLOTB, LDS_OST=LDS_WS+NW*64*4, LDS_BYTES=LDS_OST+NW*4096;
constexpr float C2=0.125f*1.4426950408889634f;
__device__ __forceinline__ void glds16(const void*gsrc,unsigned lds_dst){unsigned keep;
  asm volatile("s_mov_b32 %0, m0\n\ts_mov_b32 m0, %2\n\ts_nop 0\n\tglobal_load_lds_dwordx4 %1, off\n\ts_mov_b32 m0, %0":"=&s"(keep):"v"(gsrc),"s"(lds_dst):"memory");}
__device__ __forceinline__ float max3f(float a,float b,float c){float r;asm("v_max3_f32 %0, %1, %2, %3":"=v"(r):"v"(a),"v"(b),"v"(c));return r;}
__device__ __forceinline__ float max2f(float a,float b){float r;asm("v_max_f32_e32 %0, %1, %2":"=v"(r):"v"(a),"v"(b));return r;}
__device__ __forceinline__ float fadd_s(float a,float b){float r;asm("v_add_f32_e32 %0, %1, %2":"=v"(r):"v"(a),"v"(b));return r;}
__device__ __forceinline__ float fsub_s(float a,float b){float r;asm("v_sub_f32_e32 %0, %1, %2":"=v"(r):"v"(a),"v"(b));return r;}
typedef float f32x2_t __attribute__((ext_vector_type(2))); typedef __bf16 bf16x2_t __attribute__((ext_vector_type(2)));
__device__ __forceinline__ unsigned cvtpk_s(float lo,float hi){f32x2_t v={lo,hi};bf16x2_t b=__builtin_convertvector(v,bf16x2_t);return __builtin_bit_cast(unsigned,b);}
#define WAIT_BAR(N) asm volatile("s_waitcnt vmcnt(" #N ") lgkmcnt(0)\n\ts_barrier":::"memory")

__device__ __forceinline__ void qkt(f32x16&p0,f32x16&p1,const char*Kslot,const bf16x8*qr,const f32x16&negm,int r32,int hi){
  const char*kb=Kslot+hi*1024+r32*16;
  #pragma unroll
  for(int d0=0;d0<4;++d0){
    const bf16x8 b0=*reinterpret_cast<const bf16x8*>(kb+d0*2048);
    const bf16x8 b1=*reinterpret_cast<const bf16x8*>(kb+d0*2048+512);
    if(d0==0){p0=__builtin_amdgcn_mfma_f32_32x32x16_bf16(b0,qr[0],negm,0,0,0);p1=__builtin_amdgcn_mfma_f32_32x32x16_bf16(b1,qr[0],negm,0,0,0);}
    else{p0=__builtin_amdgcn_mfma_f32_32x32x16_bf16(b0,qr[d0],p0,0,0,0);p1=__builtin_amdgcn_mfma_f32_32x32x16_bf16(b1,qr[d0],p1,0,0,0);}}
}
typedef __attribute__((address_space(3))) const char* lds_cptr;
typedef short v4i16_t __attribute__((ext_vector_type(4)));
__device__ __forceinline__ void kload8(bf16x8*kf,lds_cptr kp){
  kf[0]=*(const __attribute__((address_space(3))) bf16x8*)(kp);      kf[1]=*(const __attribute__((address_space(3))) bf16x8*)(kp+512);
  kf[2]=*(const __attribute__((address_space(3))) bf16x8*)(kp+2048); kf[3]=*(const __attribute__((address_space(3))) bf16x8*)(kp+2560);
  kf[4]=*(const __attribute__((address_space(3))) bf16x8*)(kp+4096); kf[5]=*(const __attribute__((address_space(3))) bf16x8*)(kp+4608);
  kf[6]=*(const __attribute__((address_space(3))) bf16x8*)(kp+6144); kf[7]=*(const __attribute__((address_space(3))) bf16x8*)(kp+6656);
}
__device__ __forceinline__ void kload2(bf16x8*kf,lds_cptr kp,int j){ kf[2*j]=*(const __attribute__((address_space(3))) bf16x8*)(kp+j*2048); kf[2*j+1]=*(const __attribute__((address_space(3))) bf16x8*)(kp+j*2048+512); }
__device__ __forceinline__ s16x4 vtr(lds_cptr p){ return __builtin_bit_cast(s16x4,__builtin_amdgcn_ds_read_tr16_b64_v4i16((__attribute__((address_space(3))) v4i16_t*)p)); }
__device__ __forceinline__ float rowmax(const f32x16&p0,const f32x16&p1){
  float a=max3f(p0[0],p0[1],p1[0]),b=max3f(p0[2],p0[3],p1[1]);a=max3f(a,p1[2],p1[3]);
  #pragma unroll
  for(int r=4;r<16;r+=4){a=max3f(a,p0[r],p0[r+1]);b=max3f(b,p0[r+2],p0[r+3]);a=max3f(a,p1[r],p1[r+1]);b=max3f(b,p1[r+2],p1[r+3]);}
  const float m=max2f(a,b);
  auto rr=__builtin_amdgcn_permlane32_swap(__float_as_uint(m),__float_as_uint(m),false,false);
  return max2f(__uint_as_float(rr[0]),__uint_as_float(rr[1]));
}
__device__ __forceinline__ void pv(f32x16*o,int vb,bf16x8 pa0,bf16x8 pa1,bf16x8 pa2,bf16x8 pa3){
  #pragma unroll
  for(int d0=0;d0<2;++d0){s16x4 lo[4],hi[4];
    #pragma unroll
    for(int ks=0;ks<4;++ks){
      asm volatile("ds_read_b64_tr_b16 %0,%1 offset:%c2":"=&v"(lo[ks]):"v"(vb),"i"(d0*4096+ks*1024):"memory");
      asm volatile("ds_read_b64_tr_b16 %0,%1 offset:%c2":"=&v"(hi[ks]):"v"(vb),"i"(d0*4096+ks*1024+512):"memory");}
    asm volatile("s_waitcnt lgkmcnt(0)":::"memory");SBAR();
    #define PK(k) (bf16x8){lo[k][0],lo[k][1],lo[k][2],lo[k][3],hi[k][0],hi[k][1],hi[k][2],hi[k][3]}
    o[d0]=__builtin_amdgcn_mfma_f32_32x32x16_bf16(pa0,PK(0),o[d0],0,0,0);
    o[d0]=__builtin_amdgcn_mfma_f32_32x32x16_bf16(pa1,PK(1),o[d0],0,0,0);
    o[d0]=__builtin_amdgcn_mfma_f32_32x32x16_bf16(pa2,PK(2),o[d0],0,0,0);
    o[d0]=__builtin_amdgcn_mfma_f32_32x32x16_bf16(pa3,PK(3),o[d0],0,0,0);
    #undef PK
  }
}

#ifndef ATTN_STORE16
#define ATTN_STORE16(p,v) (*(u32x4*)(p)=(v))
#endif
template<int THRL> __device__ __forceinline__ void attn_unit(int b,int h,int qb,const bf16*Q,const bf16*__restrict__ K,const bf16*__restrict__ V,bf16*O,const bf16*__restrict__ Z,char*shm,const int wave_id,const bool st_){
  const int lane=lane_now(),tid=wave_id*64+lane,r32=lane&31,hi=lane>>5; const int wid=wave_id;
  const long rowbase=(long)b*SEQ; const int q0=qb*QB;
  const bf16*Qw=Q+(rowbase+q0+wid*QBLK)*DM+h*D;
  const bf16*Kh=K+rowbase*DM+(h>>2)*D,*Vh=V+rowbase*DM+(h>>2)*D;
  const unsigned lds0=(unsigned)(uintptr_t)shm;
  float*wsf=(float*)(shm+LDS_WS)+wid*64;
  const bf16*ksrc=Kh+(long)lane*DM+wid*8;
  const bf16*vsrc=Vh+(long)(16*(wid&3)+(lane>>2))*DM+(wid>>2)*32+(lane&3)*8;
  const unsigned kdst=lds0+LDS_K+wid*1024, vdst=lds0+LDS_V+wid*1024;
  #define DMA_K(t,slot) glds16(ksrc+(long)(t)*KVBLK*DM,(unsigned)__builtin_amdgcn_readfirstlane(kdst+(slot)))
  #define DMA_V(t,slot) glds16(vsrc+(long)(t)*KVBLK*DM,(unsigned)__builtin_amdgcn_readfirstlane(vdst+(slot)))
  const int vb0=(int)(lds0+LDS_V)+((lane>>4)&1)*32+(lane&3)*8+(4*hi+((lane&15)>>2))*64;
  const char*Kbase=shm+LDS_K; bf16x8 kf[8];
  const lds_cptr shm3=(lds_cptr)shm; const lds_cptr kp0=shm3+LDS_K+hi*1024+r32*16; const lds_cptr vp0=shm3+LDS_V+((lane>>4)&1)*32+(lane&3)*8+(4*hi+((lane&15)>>2))*64;
  constexpr int NT=SEQ/KVBLK;
  DMA_K(0,0);DMA_V(0,0);DMA_K(1,SLOTB);
  bf16x8 qr[4];
  #pragma unroll
  for(int d0=0;d0<4;++d0)qr[d0]=*reinterpret_cast<const bf16x8*>(&Qw[(long)r32*DM+d0*16+hi*8]);
  float mhat=0.f,l_reg=0.f;f32x16 o[2];{float zz=0.f;asm volatile("":"+v"(zz));_Pragma("unroll") for(int r=0;r<16;++r){o[0][r]=zz;o[1][r]=zz;}}f32x16 negm;{float zz=0.f;asm volatile("":"+v"(zz));_Pragma("unroll") for(int r=0;r<16;++r)negm[r]=zz;}asm volatile("":"+v"(negm));
  const int qrel=wid*QBLK+r32;
  #define CMASK(P0,P1,t) do{}while(0)
  bool resc=false;
  #define START(P0,P1) do{ const float rm=rowmax(P0,P1); resc=false; \
    { const float dl=rm; mhat=fadd_s(mhat,dl); \
      _Pragma("unroll") for(int r=0;r<16;++r){P0[r]=fsub_s(P0[r],dl);P1[r]=fsub_s(P1[r],dl);} \
      _Pragma("unroll") for(int r=0;r<16;++r)negm[r]=-mhat; asm volatile("":"+v"(negm)); } \
    _Pragma("unroll") for(int r=0;r<16;++r)P0[r]=__builtin_amdgcn_exp2f(P0[r]); }while(0)
  #define RESC() do{ if(resc){ asm volatile("s_waitcnt lgkmcnt(0)":::"memory"); \
      _Pragma("unroll") for(int d_=0;d_<2;++d_) _Pragma("unroll") for(int r=0;r<16;++r)o[d_][r]*=wsf[crow(r,hi)]; } }while(0)
  f32x16 pA0,pA1,pB0,pB1;
  int sl_prev=0,sl_cur=0,sl_next=SLOTB;
  #define ROT() do{sl_prev=sl_cur;sl_cur=sl_next;sl_next=(sl_next==(NSLOT-1)*SLOTB)?0:sl_next+SLOTB;}while(0)
  DMA_K(2,2*SLOTB);
  WAIT_BAR(3);
  qkt(pA0,pA1,Kbase,qr,negm,r32,hi);asm volatile("s_nop 15\n\ts_nop 7":"+v"(pA0),"+v"(pA1));CMASK(pA0,pA1,0);
  START(pA0,pA1);
  _Pragma("unroll") for(int r=0;r<16;++r)pA1[r]=__builtin_amdgcn_exp2f(pA1[r]);
  WAIT_BAR(0);
  DMA_K(3,0);DMA_V(1,SLOTB);
  ROT();
  kload8(kf,kp0+sl_cur);
  WAIT_BAR(2);
  s16x4 vlo[8],vhi[8]; u32x4 pw0,pw1,pw2,pw3;
  #define PKW(P,B) cvtpk_s(P[B],P[B+1])
  #define PAF(k) __builtin_bit_cast(bf16x8,pw##k)
  #define VFR(i) (bf16x8){vlo[i][0],vlo[i][1],vlo[i][2],vlo[i][3],vhi[i][0],vhi[i][1],vhi[i][2],vhi[i][3]}
  #define PIN(x) asm volatile("":"+v"(x))
  #define MX3(a,b,c) __builtin_fmaxf(__builtin_fmaxf((a),(b)),(c))
  #define GAPA(MF,A0,A1,A2,A3,W0,W1,PW) do{ MF; sacc+=A0; sacc+=A1; sacc+=A2; sacc+=A3; PIN(sacc); W0; W1; PIN(PW); SBAR(); }while(0)
  #define EX(v) __builtin_amdgcn_exp2f(v)
  #define GAPB(MF,X,B) do{ MF; X[B]=EX(X[B]); X[B+1]=EX(X[B+1]); X[B+2]=EX(X[B+2]); X[B+3]=EX(X[B+3]); PIN(X); SBAR(); }while(0)
  #define VRD(i) do{ vlo[i]=vtr(vp_+(((i)>>2)*4096+((i)&3)*1024)); vhi[i]=vtr(vp_+(((i)>>2)*4096+((i)&3)*1024+512)); }while(0)
  #define KRD(G,j) do{ if(G){ kload2(kf,kp0+sl_next,j); SBAR(); } }while(0)
  #define STEP(C0,C1,P0,P1,t,GK,GV,GL) do{ SBAR(); \
    const lds_cptr vp_=vp0+sl_prev; \
    VRD(0); SBAR(); float sacc=(P0[0]+P0[1]); \
    GAPA(C0=__builtin_amdgcn_mfma_f32_32x32x16_bf16(kf[0],qr[0],negm,0,0,0), P0[2],P0[3],P0[4],P0[5],     pw0[0]=PKW(P0,0), pw0[1]=PKW(P0,2), pw0); \
    VRD(4); SBAR(); GAPA(C1=__builtin_amdgcn_mfma_f32_32x32x16_bf16(kf[1],qr[0],negm,0,0,0), P0[6],P0[7],P0[8],P0[9],     pw0[2]=PKW(P0,4), pw0[3]=PKW(P0,6), pw0); \
    VRD(1); SBAR(); GAPA(C0=__builtin_amdgcn_mfma_f32_32x32x16_bf16(kf[2],qr[1],C0,0,0,0),   P0[10],P0[11],P0[12],P0[13], pw1[0]=PKW(P0,8), pw1[1]=PKW(P0,10), pw1); \
    VRD(5); SBAR(); GAPA(C1=__builtin_amdgcn_mfma_f32_32x32x16_bf16(kf[3],qr[1],C1,0,0,0),   P0[14],P0[15],P1[0],P1[1],   pw1[2]=PKW(P0,12),pw1[3]=PKW(P0,14), pw1); \
    VRD(2); SBAR(); GAPA(C0=__builtin_amdgcn_mfma_f32_32x32x16_bf16(kf[4],qr[2],C0,0,0,0),   P1[2],P1[3],P1[4],P1[5],     pw2[0]=PKW(P1,0), pw2[1]=PKW(P1,2), pw2); \
    VRD(6); SBAR(); GAPA(C1=__builtin_amdgcn_mfma_f32_32x32x16_bf16(kf[5],qr[2],C1,0,0,0),   P1[6],P1[7],P1[8],P1[9],     pw2[2]=PKW(P1,4), pw2[3]=PKW(P1,6), pw2); \
    VRD(3); SBAR(); GAPA(C0=__builtin_amdgcn_mfma_f32_32x32x16_bf16(kf[6],qr[3],C0,0,0,0),   P1[10],P1[11],P1[12],P1[13], pw3[0]=PKW(P1,8), pw3[1]=PKW(P1,10), pw3); \
    VRD(7); SBAR(); GAPA(C1=__builtin_amdgcn_mfma_f32_32x32x16_bf16(kf[7],qr[3],C1,0,0,0),   P1[14],P1[15],0.f,0.f,       pw3[2]=PKW(P1,12),pw3[3]=PKW(P1,14), pw3); \
    l_reg+=sacc; \
    if(GK){DMA_K((t)+3,sl_cur);} if(GV){DMA_V((t)+1,sl_next);} \
    CMASK(C0,C1,t); \
    { float a=MX3(C0[0],C0[1],C1[0]),b=MX3(C0[2],C0[3],C1[1]); a=MX3(a,C1[2],C1[3]); \
      _Pragma("unroll") for(int r=4;r<16;r+=4){a=MX3(a,C0[r],C0[r+1]);b=MX3(b,C0[r+2],C0[r+3]);a=MX3(a,C1[r],C1[r+1]);b=MX3(b,C1[r+2],C1[r+3]);} \
      float rm=__builtin_fmaxf(a,b); { auto rr=__builtin_amdgcn_permlane32_swap(__float_as_uint(rm),__float_as_uint(rm),false,false); rm=__builtin_fmaxf(__uint_as_float(rr[0]),__uint_as_float(rr[1])); } \
      resc=false; \
      if(__builtin_expect(__any(rm>(float)THRL),0)){ const float dl=__builtin_fmaxf(rm,0.f); mhat+=dl; \
        _Pragma("unroll") for(int r=0;r<16;++r){C0[r]-=dl;C1[r]-=dl;} \
        _Pragma("unroll") for(int r=0;r<16;++r)negm[r]=-mhat; asm volatile("":"+v"(negm)); \
        const float f=__builtin_amdgcn_exp2f(-dl); l_reg*=f; if(hi==0)wsf[r32]=f; resc=true; } } \
    SBAR(); \
    GAPB(o[0]=__builtin_amdgcn_mfma_f32_32x32x16_bf16(PAF(0),VFR(0),o[0],0,0,0), C0,0); \
    GAPB(o[1]=__builtin_amdgcn_mfma_f32_32x32x16_bf16(PAF(0),VFR(4),o[1],0,0,0), C0,4); \
    KRD(GL,0); GAPB(o[0]=__builtin_amdgcn_mfma_f32_32x32x16_bf16(PAF(1),VFR(1),o[0],0,0,0), C0,8); \
    KRD(GL,1); GAPB(o[1]=__builtin_amdgcn_mfma_f32_32x32x16_bf16(PAF(1),VFR(5),o[1],0,0,0), C0,12); \
    KRD(GL,2); GAPB(o[0]=__builtin_amdgcn_mfma_f32_32x32x16_bf16(PAF(2),VFR(2),o[0],0,0,0), C1,0); \
    KRD(GL,3); GAPB(o[1]=__builtin_amdgcn_mfma_f32_32x32x16_bf16(PAF(2),VFR(6),o[1],0,0,0), C1,4); \
    GAPB(o[0]=__builtin_amdgcn_mfma_f32_32x32x16_bf16(PAF(3),VFR(3),o[0],0,0,0), C1,8); \
    GAPB(o[1]=__builtin_amdgcn_mfma_f32_32x32x16_bf16(PAF(3),VFR(7),o[1],0,0,0), C1,12); \
    }while(0)
  int t=1;
  #undef CMASK
  #define CMASK(P0,P1,t) do{}while(0)
  for(;t+5<NT;t+=2){
    STEP(pB0,pB1,pA0,pA1,t,true,true,true);     WAIT_BAR(2); RESC(); ROT();
    STEP(pA0,pA1,pB0,pB1,t+1,true,true,true);   WAIT_BAR(2); RESC(); ROT();
  }
  #undef CMASK
  #define CMASK(P0,P1,t) do{}while(0)
  #define ENDW(tt) do{ if((tt)+3<NT){WAIT_BAR(2);} else if((tt)+2<NT){WAIT_BAR(1);} else {WAIT_BAR(0);} }while(0)
  for(;t+1<NT;t+=2){
    STEP(pB0,pB1,pA0,pA1,t,(t+3<NT),(t+1<NT),(t+1<NT));       ENDW(t);   RESC(); ROT();
    STEP(pA0,pA1,pB0,pB1,t+1,(t+4<NT),(t+2<NT),(t+2<NT));     ENDW(t+1); RESC(); ROT();
  }
  STEP(pB0,pB1,pA0,pA1,NT-1,false,false,false); RESC();
  { float sacc=pB0[0]+pB0[1]; _Pragma("unroll") for(int r=2;r<16;++r)sacc+=pB0[r]; _Pragma("unroll") for(int r=0;r<16;++r)sacc+=pB1[r]; l_reg+=sacc;
    pw0=(u32x4){PKW(pB0,0),PKW(pB0,2),PKW(pB0,4),PKW(pB0,6)};pw1=(u32x4){PKW(pB0,8),PKW(pB0,10),PKW(pB0,12),PKW(pB0,14)};pw2=(u32x4){PKW(pB1,0),PKW(pB1,2),PKW(pB1,4),PKW(pB1,6)};pw3=(u32x4){PKW(pB1,8),PKW(pB1,10),PKW(pB1,12),PKW(pB1,14)};
    SBAR(); pv(o,vb0+sl_cur,PAF(0),PAF(1),PAF(2),PAF(3)); }
  #undef PKW
  #undef PAF
  #undef VFR
  #undef PIN
  #undef MX3
  #undef GAPA
  #undef GAPB
  #undef EX
  #undef VRD
  #undef KRD
  #undef STEP
  #undef ENDW
  {auto rr=__builtin_amdgcn_permlane32_swap(__float_as_uint(l_reg),__float_as_uint(l_reg),false,false);l_reg=__uint_as_float(rr[0])+__uint_as_float(rr[1]);}
  if(hi==0)wsf[32+r32]=l_reg;asm volatile("s_waitcnt lgkmcnt(0)":::"memory");
  float rli[16];
  #pragma unroll
  for(int r=0;r<16;++r)rli[r]=__builtin_amdgcn_rcpf(wsf[32+crow(r,hi)]);
  bf16*Ow=O+(rowbase+q0+wid*QBLK)*DM+h*D;
  { bf16*stg=(bf16*)(shm+LDS_OST)+wid*2048;
    #pragma unroll
    for(int r=0;r<16;++r){const int orow=crow(r,hi);
      #pragma unroll
      for(int d0=0;d0<2;++d0)stg[orow*64+d0*32+r32]=__float2bfloat16(o[d0][r]*rli[r]);}
    asm volatile("s_waitcnt lgkmcnt(0)":::"memory");
    const bf16*Zw=Z+(rowbase+q0+wid*QBLK)*DM+h*D;
    #pragma unroll
    for(int i=0;i<4;++i){const int row=i*8+(lane>>3),ch=lane&7; u32x4 v=*(const u32x4*)(stg+row*64+ch*8); const u32x4 z=*(const u32x4*)(Zw+(long)row*DM+ch*8);
      _Pragma("unroll") for(int e=0;e<4;++e){ const float z0=__uint_as_float(z[e]<<16), z1=__uint_as_float(z[e]&0xffff0000u); const float v0=__uint_as_float(v[e]<<16), v1=__uint_as_float(v[e]&0xffff0000u);
        const float g0=z0*__builtin_amdgcn_rcpf(1.f+__expf(-z0)), g1=z1*__builtin_amdgcn_rcpf(1.f+__expf(-z1)); v[e]=cvtpk_s(v0*g0,v1*g1); }
      if(st_)ATTN_STORE16(Ow+(long)row*DM+ch*8,v);} }
  asm volatile("s_waitcnt lgkmcnt(0)\n\ts_barrier":::"memory");
  #undef DMA_K
  #undef DMA_V
  #undef CMASK
  #undef START
  #undef RESC
  #undef ROT
}
constexpr int ATTN_LDS_BYTES=LDS_BYTES;
struct AttnTensors { const bf16* Q; const bf16* K; const bf16* V; bf16* O; const bf16* Z; };
struct AttnUnit { int b; int h; int qb; };
template<int THRL=8> __device__ __forceinline__ void attn_phase(char*lds,const AttnTensors&T,int vcu,int G,const int wave_id,const bool st_){
  const int x=vcu>>5,c=vcu&31;
  #pragma unroll 1
  for(int i=0;i<6;++i){ const int pair=x*3+(i>>1),u=(i&1)*32+c; attn_unit<THRL>(pair>>1,(pair&1)*4+(u>>4),u&15,T.Q,T.K,T.V,T.O,T.Z,lds,wave_id,st_); }
}
#undef SBAR
#undef WAIT_BAR
}
constexpr int NWAVES = 8;
constexpr int DM_ = 1024, DEPTH = 4, SEQ_ = 4096, MTOT = 98304, MH = 49152, NPROMPT = 65536, PITCH = 5888, PLE = 256;
constexpr int C_QA = 0, C_KA = 512, C_VA = 640, C_ZA = 768, C_QB = 1280, C_KB = 2048, C_VB = 2816, C_ZB = 3584, C_GA = 3840, C_GB = 4864;
constexpr size_t MiB = 1u << 20;
constexpr size_t WS_SS = 0;
constexpr size_t WS_TAX = 4 * MiB;
constexpr size_t WS_T1D = 4 * MiB + 65536;
constexpr size_t WS_BAR = 6 * MiB, BAR_BYTES = 16384;
constexpr size_t WS_W = 8 * MiB;
constexpr size_t WL_IN = 0, WL_A = (size_t)5888 * 1024 * 2, WL_B = WL_A + 1 * MiB, WL_O = WL_B + MiB / 2, WL_PLE = WL_O + 2 * MiB, WL_PG = WL_PLE + MiB / 2, WL_STRIDE = WL_PG + 2 * MiB;
constexpr size_t WS_LSE = 80 * MiB;
constexpr size_t WS_OBG = 84 * MiB;
constexpr size_t WS_PB = 108 * MiB;
constexpr size_t WS_BUFA = 132 * MiB;
constexpr size_t WS_PROJ = 228 * MiB;
constexpr size_t WS_HG = 780 * MiB;
constexpr size_t WS_EB = 876 * MiB;
constexpr size_t WS_END = 972 * MiB;
static_assert(WS_W + 4 * WL_STRIDE <= WS_LSE, "weights");
constexpr int LDS_BYTES = 147456;
#define LAS __attribute__((address_space(3)))
typedef unsigned short bf16;
typedef unsigned v4u __attribute__((ext_vector_type(4)));
typedef float f32x4 __attribute__((ext_vector_type(4)));
typedef float f32x16 __attribute__((ext_vector_type(16)));
typedef short bf16x8 __attribute__((ext_vector_type(8)));
typedef short s16x4 __attribute__((ext_vector_type(4)));
typedef float f32x2 __attribute__((ext_vector_type(2)));
__device__ __forceinline__ unsigned f2bf(float f) { unsigned u = __builtin_bit_cast(unsigned, f); return (u + 0x7fffu + ((u >> 16) & 1u)) >> 16; }
__device__ __forceinline__ unsigned pk2(float lo, float hi) { return f2bf(lo) | (f2bf(hi) << 16); }
__device__ __forceinline__ float blo(unsigned w) { return __uint_as_float(w << 16); }
__device__ __forceinline__ float bhi(unsigned w) { return __uint_as_float(w & 0xffff0000u); }
__device__ __forceinline__ float wave_sum(float v, int lane) {
#pragma unroll
    for (int o = 1; o < 64; o <<= 1) v += shx(v, lane, o);
    return v;
}
constexpr float C2F = 0.125f * 1.4426950408889634f;

#ifndef PROBE_P1
#define PROBE_P1 0
#endif
#ifndef PROBE_AA
#define PROBE_AA 0
#endif
#ifndef PROBE_AB
#define PROBE_AB 0
#endif
#ifndef PROBE_P2
#define PROBE_P2 0
#endif
#ifndef PROBE_P4
#define PROBE_P4 0
#endif
#ifndef PROBE_P5
#define PROBE_P5 0
#endif
#ifndef PROBE_P6
#define PROBE_P6 0
#endif
#ifndef PROBE_P7
#define PROBE_P7 0
#endif
#ifndef PROBE_SYNC
#define PROBE_SYNC 0
#endif
#define GSYNC() do { xcd_barrier(xbar); if (PROBE_SYNC) xcd_barrier(xbar); } while (0)
struct Args { const float* in[15]; float* out; unsigned char* ws; };

template <bool HEADPERM> __device__ __forceinline__ void transpose_item(const float* W, int K, int N, bf16* WT, LAS float* scr, int item, int lane) {
    const int nblk = N / 32, kb = item / nblk, nb = item % nblk, k0 = 64 * kb, n0 = 32 * nb;
#pragma unroll 8
    for (int i = 0; i < 32; ++i) { const int kk = 2 * i + (lane >> 5); scr[kk * 33 + (lane & 31)] = W[(size_t)(k0 + kk) * N + n0 + (lane & 31)]; }
    asm volatile("s_waitcnt lgkmcnt(0)" ::: "memory");
    const int c = lane & 7;
#pragma unroll
    for (int j = 0; j < 4; ++j) { const int n = (lane >> 3) + 8 * j; const LAS float* s = scr + (8 * c) * 33 + n;
        v4u o; o.x = pk2(s[0 * 33], s[1 * 33]); o.y = pk2(s[2 * 33], s[3 * 33]); o.z = pk2(s[4 * 33], s[5 * 33]); o.w = pk2(s[6 * 33], s[7 * 33]);
        int nr = n0 + n; if (HEADPERM) { const int w_ = nr & 255; nr = (nr & ~255) + ((w_ >> 5) & 1) * 128 + (w_ >> 6) * 32 + (w_ & 31); }
        *(v4u*)(WT + (size_t)nr * K + k0 + 8 * c) = o; }
    asm volatile("s_waitcnt lgkmcnt(0)" ::: "memory");
}

__device__ __forceinline__ int crow(int r, int hi) { return (r & 3) + 8 * (r >> 2) + 4 * hi; }
__device__ __forceinline__ s16x4 vtr(const LAS char* p) { typedef short v4i16_t __attribute__((ext_vector_type(4))); return __builtin_bit_cast(s16x4, __builtin_amdgcn_ds_read_tr16_b64_v4i16((LAS v4i16_t*)p)); }
__device__ __forceinline__ unsigned cvtpk(float lo, float hi) { typedef __bf16 bf16x2_t __attribute__((ext_vector_type(2))); f32x2 v = {lo, hi}; bf16x2_t b = __builtin_convertvector(v, bf16x2_t); return __builtin_bit_cast(unsigned, b); }
__device__ __forceinline__ void attnb_unit(bf16* P, float* LSE, int b, int hb, int tau, LAS char* wl, int lane, const bool st_) {
    const int g = hb >> 2, sh = 2 * g, L = 4096 >> sh, tprs = 7 - sh;
    const int r = tau >> tprs, m0 = 32 * (tau & ((1 << tprs) - 1));
    const int r32 = lane & 31, hi = lane >> 5;
    const size_t rowbase = (size_t)b * 4096;
    const int tq = r + ((m0 + r32) << sh);
    bf16x8 qf[4];
    { const bf16* qp = P + (rowbase + tq) * PITCH + C_QB + hb * 64 + hi * 8;
#pragma unroll
      for (int d0 = 0; d0 < 4; ++d0) qf[d0] = *(const bf16x8*)(qp + d0 * 16); }
    f32x16 S[5];
#pragma unroll
    for (int kb = 0; kb < 5; ++kb) {
        int mk = m0 - 64 + 32 * kb + r32; mk = mk < 0 ? 0 : (mk > L - 1 ? L - 1 : mk);
        const bf16* kp = P + (rowbase + r + (mk << sh)) * PITCH + C_KB + hb * 64 + hi * 8;
        bf16x8 kf[4];
#pragma unroll
        for (int d0 = 0; d0 < 4; ++d0) kf[d0] = *(const bf16x8*)(kp + d0 * 16);
        f32x16 s = {};
#pragma unroll
        for (int d0 = 0; d0 < 4; ++d0) s = __builtin_amdgcn_mfma_f32_32x32x16_bf16(kf[d0], qf[d0], s, 0, 0, 0);
        S[kb] = s;
    }
    const int mq = m0 + r32; float mx = -INFINITY;
#pragma unroll
    for (int kb = 0; kb < 5; ++kb)
#pragma unroll
        for (int q = 0; q < 16; ++q) { const int mk = m0 - 64 + 32 * kb + crow(q, hi); const int dd = mk - mq; const bool ok = (mk >= 0) && (mk < L) && (dd <= 64) && (dd >= -64);
            const float v = ok ? S[kb][q] : -INFINITY; S[kb][q] = v; mx = fmaxf(mx, v); }
    mx = fmaxf(mx, shx(mx, lane, 32));
    float l = 0.f;
#pragma unroll
    for (int kb = 0; kb < 5; ++kb)
#pragma unroll
        for (int q = 0; q < 16; ++q) { const float p = __builtin_amdgcn_exp2f(S[kb][q] - mx); S[kb][q] = p; l += p; }
    l += shx(l, lane, 32);
    f32x16 o0 = {}, o1 = {};
    const LAS char* vrd = wl + ((lane >> 4) & 1) * 32 + (lane & 3) * 8 + (4 * hi + ((lane & 15) >> 2)) * 64;
#pragma unroll
    for (int kb = 0; kb < 5; ++kb) {
        asm volatile("" ::: "memory");
#pragma unroll
        for (int j = 0; j < 4; ++j) { const int idx = lane + 64 * j, key = idx >> 3, c = idx & 7;
            int mk = m0 - 64 + 32 * kb + key; mk = mk < 0 ? 0 : (mk > L - 1 ? L - 1 : mk);
            const v4u vv = *(const v4u*)(P + (rowbase + r + (mk << sh)) * PITCH + C_VB + hb * 64 + c * 8);
            *(LAS v4u*)(wl + (c >> 2) * 2048 + (key >> 3) * 512 + (key & 7) * 64 + (c & 3) * 16) = vv; }
        asm volatile("s_waitcnt lgkmcnt(0)" ::: "memory");
#pragma unroll
        for (int s = 0; s < 2; ++s) {
            v4u pw; pw.x = cvtpk(S[kb][8 * s + 0], S[kb][8 * s + 1]); pw.y = cvtpk(S[kb][8 * s + 2], S[kb][8 * s + 3]); pw.z = cvtpk(S[kb][8 * s + 4], S[kb][8 * s + 5]); pw.w = cvtpk(S[kb][8 * s + 6], S[kb][8 * s + 7]);
            const bf16x8 pa = __builtin_bit_cast(bf16x8, pw);
            { const s16x4 lo = vtr(vrd + (2 * s) * 512), hh = vtr(vrd + (2 * s + 1) * 512);
              const bf16x8 vf = (bf16x8){lo[0], lo[1], lo[2], lo[3], hh[0], hh[1], hh[2], hh[3]};
              o0 = __builtin_amdgcn_mfma_f32_32x32x16_bf16(pa, vf, o0, 0, 0, 0); }
            { const s16x4 lo = vtr(vrd + 2048 + (2 * s) * 512), hh = vtr(vrd + 2048 + (2 * s + 1) * 512);
              const bf16x8 vf = (bf16x8){lo[0], lo[1], lo[2], lo[3], hh[0], hh[1], hh[2], hh[3]};
              o1 = __builtin_amdgcn_mfma_f32_32x32x16_bf16(pa, vf, o1, 0, 0, 0); }
        }
        asm volatile("s_waitcnt lgkmcnt(0)" ::: "memory");
    }
    LAS float* wsf = (LAS float*)(wl + 4096);
    if (hi == 0) { wsf[r32] = l; if (st_) LSE[(rowbase + tq) * 12 + hb] = mx + __builtin_amdgcn_logf(l); }
    asm volatile("s_waitcnt lgkmcnt(0)" ::: "memory");
    LAS bf16* stg = (LAS bf16*)wl;
#pragma unroll
    for (int q = 0; q < 16; ++q) { const int orow = crow(q, hi); const float rl = __builtin_amdgcn_rcpf(wsf[orow]);
        stg[orow * 64 + r32] = (bf16)f2bf(o0[q] * rl); stg[orow * 64 + 32 + r32] = (bf16)f2bf(o1[q] * rl); }
    asm volatile("s_waitcnt lgkmcnt(0)" ::: "memory");
#pragma unroll
    for (int i = 0; i < 4; ++i) { const int row = i * 8 + (lane >> 3), ch = lane & 7; const v4u v = *(const LAS v4u*)(wl + row * 128 + ch * 16);
        if (st_) *(v4u*)(P + (rowbase + r + ((m0 + row) << sh)) * PITCH + C_QB + hb * 64 + ch * 8) = v; }
    asm volatile("s_waitcnt lgkmcnt(0)" ::: "memory");
}

#define XB_TMO      128
#define XB_XCNT(j)  (256  + 64 * (j))
#define XB_XSUB(j)  (1280 + 64 * (j))
#define XB_XGEN(j)  (2304 + 64 * (j))
#define XB_TOP      3328
#define XB_TOPGEN   3392
#define XCD_BAR_WORDS 3456
#define XB_SPIN_CAP (1u << 18)

__device__ __forceinline__ unsigned xb_ld(unsigned* p)              { return __hip_atomic_load(p, __ATOMIC_RELAXED, __HIP_MEMORY_SCOPE_AGENT); }
__device__ __forceinline__ unsigned xb_add(unsigned* p, unsigned v) { return __hip_atomic_fetch_add(p, v, __ATOMIC_RELAXED, __HIP_MEMORY_SCOPE_AGENT); }
__device__ __forceinline__ unsigned xb_xcc_id() { return (unsigned)__builtin_amdgcn_s_getreg((3 << 11) | 20) & 0xFu; }
#define XB_SPIN(cond, bar) do { unsigned _sp = 0; while (cond) { __builtin_amdgcn_s_sleep(1); \
    if ((++_sp & 255u) == 0u) { if (xb_ld(&(bar)[XB_TMO])) break; if (_sp > XB_SPIN_CAP) { atomicAdd(&(bar)[XB_TMO], 1u); break; } } } } while (0)

struct XcdBarrier {
    unsigned* bar; unsigned x;
    volatile LAS unsigned* st;
};

__device__ __forceinline__ XcdBarrier xcd_barrier_post(unsigned* bar, volatile LAS unsigned* st) {
    XcdBarrier b; b.bar = bar; b.x = xb_xcc_id(); b.st = st;
    if (threadIdx.x == 0) (void)xb_add(&bar[XB_XCNT(b.x)], 1u);
    return b;
}
__device__ __forceinline__ void xcd_barrier_complete(unsigned* bar, unsigned x, unsigned& nloc, unsigned& nx) {
    const unsigned G = gridDim.x * gridDim.y * gridDim.z;
    unsigned sum, cnt, mine, sp = 0u;
    for (;;) {
        sum = 0u; cnt = 0u; mine = 0u;
#pragma unroll
        for (unsigned j = 0; j < 16; ++j) { const unsigned c = xb_ld(&bar[XB_XCNT(j)]); sum += c; cnt += (c > 0u) ? 1u : 0u; mine = (j == x) ? c : mine; }
        if (sum == G) break;
        __builtin_amdgcn_s_sleep(1);
        if ((++sp & 255u) == 0u) { if (xb_ld(&bar[XB_TMO])) break; if (sp > XB_SPIN_CAP) { atomicAdd(&bar[XB_TMO], 1u); break; } }
    }
    nloc = mine > 0u ? mine : 1u; nx = cnt > 0u ? cnt : 1u;
}

__device__ __forceinline__ void xcd_barrier(const XcdBarrier& b) {
    asm volatile("s_waitcnt vmcnt(0)" ::: "memory");
    __syncthreads();
    if (threadIdx.x == 0) {
        unsigned* bar = b.bar;
        __builtin_amdgcn_s_waitcnt(0);
        unsigned nloc = b.st[0], nx = b.st[1];
        if (nloc == 0u) { xcd_barrier_complete(bar, b.x, nloc, nx); b.st[0] = nloc; b.st[1] = nx; }
        const unsigned old = xb_add(&bar[XB_XSUB(b.x)], 1u);
        const unsigned gen = old / nloc;
        if (old + 1u == (gen + 1u) * nloc) {
            __builtin_amdgcn_fence(__ATOMIC_RELEASE, "agent");
            asm volatile("s_waitcnt vmcnt(0)" ::: "memory");
            const unsigned og = xb_add(&bar[XB_TOP], 1u);
            const unsigned tg = og / nx;
            if (og + 1u == (tg + 1u) * nx) xb_add(&bar[XB_TOPGEN], 1u);
            else XB_SPIN(xb_ld(&bar[XB_TOPGEN]) == tg, bar);
            __builtin_amdgcn_fence(__ATOMIC_ACQUIRE, "agent");
            xb_add(&bar[XB_XGEN(b.x)], 1u);
            asm volatile("s_waitcnt vmcnt(0)" ::: "memory");
        } else {
            XB_SPIN(xb_ld(&bar[XB_XGEN(b.x)]) == gen, bar);
            __builtin_amdgcn_fence(__ATOMIC_ACQUIRE, "agent");
            asm volatile("s_waitcnt vmcnt(0)" ::: "memory");
        }
    }
    __syncthreads();
}

__global__ void __launch_bounds__(NWAVES * 64, 2) fwd_mega(Args args) {
    extern __shared__ __attribute__((aligned(16))) unsigned char lds[];
    cg::grid_group grid = cg::this_grid();
    LAS unsigned char* ldsl = (LAS unsigned char*)lds;
    const int wave = __builtin_amdgcn_readfirstlane(threadIdx.x >> 6); int tidv = wave * 64 + lane_now();
#define LAUNDER() do { tidv = wave * 64 + lane_now(); asm volatile("" : "+s"(bxv)); } while (0)
#define lane (tidv & 63)
#define gt (bx * (NWAVES * 64) + tidv)
    const int G = gridDim.x; int bxv = blockIdx.x; asm volatile("" : "+s"(bxv));
#define bx bxv
#define vcu ((bxv % 8) * (G / 8) + bxv / 8)
#define gw (vcu * NWAVES + wave)
    const int NGW = G * NWAVES;
    const int NGT = G * NWAVES * 64;
    unsigned char* ws = args.ws;
    const float* x_prompt = args.in[0]; const float* x_sample = args.in[1]; const float* p_prompt = args.in[2]; const float* p_sample = args.in[3];
    const float* g_norm = args.in[4]; const float* w_in = args.in[5]; const float* g_q = args.in[6]; const float* g_k = args.in[7];
    const float* w_a = args.in[8]; const float* w_b = args.in[9]; const float* w_o = args.in[10]; const float* w_ple = args.in[11];
    const float* g_ple = args.in[12]; const float* w_pg = args.in[13]; const float* g_final = args.in[14];
    float* H = args.out;
    const bool never = (args.ws == nullptr);
    float* SS = (float*)(ws + WS_SS);
    f32x2* TAX = (f32x2*)(ws + WS_TAX); f32x2* T1D = (f32x2*)(ws + WS_T1D);
    float* LSE = (float*)(ws + WS_LSE);
    bf16* OBG = (bf16*)(ws + WS_OBG); bf16* PB = (bf16*)(ws + WS_PB); bf16* BUFA = (bf16*)(ws + WS_BUFA); bf16* PROJ = (bf16*)(ws + WS_PROJ);
    bf16* HG = (bf16*)(ws + WS_HG); bf16* EB = (bf16*)(ws + WS_EB);

    volatile LAS unsigned* bst = (volatile LAS unsigned*)(ldsl + 143360);
    if (threadIdx.x < 2) bst[threadIdx.x] = 0u;
    __syncthreads();
    XcdBarrier xbar = xcd_barrier_post((unsigned*)(ws + WS_BAR), bst);
    for (int i = gt + MTOT / 4; i < 9 * MTOT / 4; i += NGT) ((f32x4*)SS)[i] = (f32x4){0.f, 0.f, 0.f, 0.f};
    for (int i = gt; i < 64 * 16 + 4096 * 32; i += NGT) {
        int pos, k; float ex; f32x2* dst;
        if (i < 1024) { pos = i >> 4; k = i & 15; ex = (float)(2 * k) / 32.f; dst = TAX + i; }
        else { const int j = i - 1024; pos = j >> 5; k = j & 31; ex = (float)(2 * k) / 64.f; dst = T1D + j; }
        const float freq = exp2f(-ex * 13.287712379549449f);
        double rev = (double)pos * (double)freq * 0.15915494309189535; rev -= floor(rev);
        const float rf = (float)rev;
        *dst = (f32x2){__builtin_amdgcn_cosf(rf), __builtin_amdgcn_sinf(rf)};
    }
    {
        LAS float* scr = (LAS float*)(ldsl + wave * 16384);
        constexpr int I_IN = 16 * 184, I_A = 8 * 32, I_B = 4 * 32, I_O = 16 * 32, I_PLE = 4 * 32, I_PG = 16 * 32, I_L = I_IN + I_A + I_B + I_O + I_PLE + I_PG;
        for (int it = gw; it < DEPTH * I_L; it += NGW) {
            const int layer = it / I_L; int r = it % I_L; unsigned char* wl = ws + WS_W + (size_t)layer * WL_STRIDE;
            if (r < I_IN) { transpose_item<true>(w_in + (size_t)layer * 1024 * 5888, 1024, 5888, (bf16*)(wl + WL_IN), scr, r, lane); continue; } r -= I_IN;
            if (r < I_A) { transpose_item<false>(w_a + (size_t)layer * 512 * 1024, 512, 1024, (bf16*)(wl + WL_A), scr, r, lane); continue; } r -= I_A;
            if (r < I_B) { transpose_item<false>(w_b + (size_t)layer * 256 * 1024, 256, 1024, (bf16*)(wl + WL_B), scr, r, lane); continue; } r -= I_B;
            if (r < I_O) { transpose_item<false>(w_o + (size_t)layer * 1024 * 1024, 1024, 1024, (bf16*)(wl + WL_O), scr, r, lane); continue; } r -= I_O;
            if (r < I_PLE) { transpose_item<false>(w_ple + (size_t)layer * 256 * 1024, 256, 1024, (bf16*)(wl + WL_PLE), scr, r, lane); continue; } r -= I_PLE;
            transpose_item<false>(w_pg + (size_t)layer * 1024 * 1024, 1024, 1024, (bf16*)(wl + WL_PG), scr, r, lane);
        }
    }

#pragma unroll 1
    for (int half = 0; half < 2; ++half) {
        const int grow0 = half * MH;
            LAUNDER();
        for (int lr0 = gw; lr0 < MH; lr0 += 2 * NGW) {
            f32x4 v[2][4]; const f32x4* xr[2];
#pragma unroll
            for (int k = 0; k < 2; ++k) { const int lr = lr0 + k * NGW < MH ? lr0 + k * NGW : lr0; const int gr = grow0 + lr;
                xr[k] = (const f32x4*)(gr < NPROMPT ? x_prompt + (size_t)gr * 1024 : x_sample + (size_t)(gr - NPROMPT) * 1024); }
#pragma unroll
            for (int k = 0; k < 2; ++k)
#pragma unroll
                for (int j = 0; j < 4; ++j) v[k][j] = __builtin_nontemporal_load(xr[k] + lane + 64 * j);
#pragma unroll
            for (int k = 0; k < 2; ++k) { const int lr = lr0 + k * NGW; if (lr < MH) { const int gr = grow0 + lr; float s = 0.f;
#pragma unroll
                for (int j = 0; j < 4; ++j) s += (v[k][j].x * v[k][j].x + v[k][j].y * v[k][j].y) + (v[k][j].z * v[k][j].z + v[k][j].w * v[k][j].w);
                s = wave_sum(s, lane); if (lane == 0) SS[gr] = s;
#pragma unroll
                for (int j = 0; j < 4; ++j) { ((f32x4*)(H + (size_t)gr * 1024))[lane + 64 * j] = v[k][j]; const f32x4 gg = ((const f32x4*)g_norm)[lane + 64 * j];
                    ((unsigned long long*)(BUFA + (size_t)lr * 1024))[lane + 64 * j] = (unsigned long long)pk2(v[k][j].x * gg.x, v[k][j].y * gg.y) | ((unsigned long long)pk2(v[k][j].z * gg.z, v[k][j].w * gg.w) << 32); } } }
        }
        if (half == 0) grid.sync(); else GSYNC();
#pragma unroll 1
        for (int layer = 0; layer < DEPTH; ++layer) {
            unsigned char* wl = ws + WS_W + (size_t)layer * WL_STRIDE;
            LAUNDER();
            { pg8::Gemm g{BUFA, (const bf16*)(wl + WL_IN), MH, PITCH, 1024, 1024}; pg8::StaticOrder S; S.init(MH, PITCH, G, bx);
              pg8::EpiProj E{PROJ, PITCH, SS + (size_t)layer * MTOT, grow0, g_q + layer * 64, g_k + layer * 64, (const pg8::f32x2e*)TAX, (const pg8::f32x2e*)T1D};
              for (int rep_ = 0; rep_ < 1 + PROBE_P1; ++rep_) { LAUNDER(); pg8::gemm_phase<pg8::EpiProj, pg8::StaticOrder, true, true>(ldsl, g, S, E, wave); } }
            GSYNC();
            LAUNDER();
            { const attn_body::AttnTensors AT{(const attn_body::bf16*)(PROJ + C_QA), (const attn_body::bf16*)(PROJ + C_KA), (const attn_body::bf16*)(PROJ + C_VA), (attn_body::bf16*)(PROJ + C_QA), (const attn_body::bf16*)(PROJ + C_ZA)};
              for (int rep_ = PROBE_AA ? 0 : 1; rep_ < 2; ++rep_) { LAUNDER(); attn_body::attn_phase<8>((char*)lds, AT, vcu, G, wave, rep_ == 1 || never); } }
            __syncthreads();
            LAUNDER();
            { LAS char* wlds = (LAS char*)(ldsl + wave * 8448);
              for (int rep_ = PROBE_AB ? 0 : 1; rep_ < 2; ++rep_) { LAUNDER();
              for (int u = gw; u < 12 * 12 * 128; u += NGW) { const int b = u / 1536, rem = u - b * 1536; attnb_unit(PROJ, LSE, b, rem >> 7, rem & 127, wlds, lane, rep_ == 1 || never); } } }
            GSYNC();
            LAUNDER();
            for (int rep_ = 0; rep_ < 1 + PROBE_P4; ++rep_) { LAUNDER();
            for (int it0 = gt; it0 < MH * 32; it0 += 4 * NGT) {
                v4u a[4], bq[4], cq[4], z[4]; float l0[4], l1[4], l2[4];
#pragma unroll
                for (int k = 0; k < 4; ++k) { const int it = it0 + k * NGT < MH * 32 ? it0 + k * NGT : it0; const int lr = it >> 5, cc = it & 31, hh = cc >> 3, c = cc & 7;
                    const bf16* rp = PROJ + (size_t)lr * PITCH;
                    a[k] = *(const v4u*)(rp + C_QB + hh * 64 + c * 8); bq[k] = *(const v4u*)(rp + C_QB + (4 + hh) * 64 + c * 8); cq[k] = *(const v4u*)(rp + C_QB + (8 + hh) * 64 + c * 8); z[k] = *(const v4u*)(rp + C_ZB + hh * 64 + c * 8);
                    l0[k] = LSE[(size_t)lr * 12 + hh]; l1[k] = LSE[(size_t)lr * 12 + 4 + hh]; l2[k] = LSE[(size_t)lr * 12 + 8 + hh]; }
#pragma unroll
                for (int k = 0; k < 4; ++k) { const int it = it0 + k * NGT; if (it < MH * 32) { const int lr = it >> 5, cc = it & 31;
                    const float mx = fmaxf(l0[k], fmaxf(l1[k], l2[k])); float w0 = __builtin_amdgcn_exp2f(l0[k] - mx), w1 = __builtin_amdgcn_exp2f(l1[k] - mx), w2 = __builtin_amdgcn_exp2f(l2[k] - mx);
                    const float inv = __builtin_amdgcn_rcpf(w0 + w1 + w2); w0 *= inv; w1 *= inv; w2 *= inv;
                    v4u o;
#pragma unroll
                    for (int e = 0; e < 4; ++e) { const float z0 = blo(z[k][e]), z1 = bhi(z[k][e]);
                        const float s0 = z0 * __builtin_amdgcn_rcpf(1.f + __expf(-z0)), s1 = z1 * __builtin_amdgcn_rcpf(1.f + __expf(-z1));
                        o[e] = pk2((w0 * blo(a[k][e]) + w1 * blo(bq[k][e]) + w2 * blo(cq[k][e])) * s0, (w0 * bhi(a[k][e]) + w1 * bhi(bq[k][e]) + w2 * bhi(cq[k][e])) * s1); }
                    *(v4u*)(OBG + (size_t)lr * 256 + cc * 8) = o; } }
            } }
            LAUNDER();
            for (int it0 = gt; it0 < MH * 32; it0 += 4 * NGT) {
                f32x4 a[4], bq[4];
#pragma unroll
                for (int k = 0; k < 4; ++k) { const int it = it0 + k * NGT < MH * 32 ? it0 + k * NGT : it0; const int lr = it >> 5, c = it & 31, gr = grow0 + lr;
                    const float* pr = gr < NPROMPT ? p_prompt + ((size_t)layer * NPROMPT + gr) * PLE : p_sample + ((size_t)layer * (MTOT - NPROMPT) + (gr - NPROMPT)) * PLE;
                    a[k] = __builtin_nontemporal_load((const f32x4*)pr + 2 * c); bq[k] = __builtin_nontemporal_load((const f32x4*)pr + 2 * c + 1); }
#pragma unroll
                for (int k = 0; k < 4; ++k) { const int it = it0 + k * NGT; if (it < MH * 32) { const int lr = it >> 5, c = it & 31;
                    v4u o; o.x = pk2(a[k].x, a[k].y); o.y = pk2(a[k].z, a[k].w); o.z = pk2(bq[k].x, bq[k].y); o.w = pk2(bq[k].z, bq[k].w); *(v4u*)(PB + (size_t)lr * PLE + c * 8) = o; } }
            }
            GSYNC();
            LAUNDER();
            for (int rep_ = 0; rep_ < 1 + PROBE_P5; ++rep_) {
            LAUNDER();
            { pg8::Gemm g{PROJ + C_QA, (const bf16*)(wl + WL_A), MH, 1024, 512, PITCH}; pg8::StaticOrder S; S.init(MH, 1024, G, bx);
              pg8::EpiGate<false> E{BUFA, 1024, PROJ + C_GA, PITCH};
              pg8::gemm_phase<pg8::EpiGate<false>, pg8::StaticOrder, true, true>(ldsl, g, S, E, wave); }
            LAUNDER();
            { pg8::Gemm g{OBG, (const bf16*)(wl + WL_B), MH, 1024, 256, 256}; pg8::StaticOrder S; S.init(MH, 1024, G, bx);
              pg8::EpiGate<true> E{BUFA, 1024, PROJ + C_GB, PITCH};
              pg8::gemm_phase<pg8::EpiGate<true>, pg8::StaticOrder, true, true>(ldsl, g, S, E, wave); } }
            GSYNC();
            LAUNDER();
            for (int rep_ = PROBE_P6 ? 0 : 1; rep_ < 2; ++rep_) {
            LAUNDER();
            { pg8::Gemm g{BUFA, (const bf16*)(wl + WL_O), MH, 1024, 1024, 1024}; pg8::StaticOrder S; S.init(MH, 1024, G, bx);
              pg8::EpiResid<false> E{H, nullptr, SS + (size_t)(5 + layer) * MTOT, nullptr, HG, g_ple + layer * 1024, grow0, rep_ == 1 || never};
              pg8::gemm_phase<pg8::EpiResid<false>, pg8::StaticOrder, true, true>(ldsl, g, S, E, wave); }
            LAUNDER();
            { pg8::Gemm g{PB, (const bf16*)(wl + WL_PLE), MH, 1024, 256, 256}; pg8::StaticOrder S; S.init(MH, 1024, G, bx);
              pg8::EpiPlain E{EB, 1024};
              pg8::gemm_phase<pg8::EpiPlain, pg8::StaticOrder, true, true>(ldsl, g, S, E, wave); } }
            GSYNC();
            LAUNDER();
            for (int rep_ = PROBE_P7 ? 0 : 1; rep_ < 2; ++rep_) {
            LAUNDER();
            { pg8::Gemm g{HG, (const bf16*)(wl + WL_PG), MH, 1024, 1024, 1024}; pg8::StaticOrder S; S.init(MH, 1024, G, bx);
              pg8::EpiResid<true> E{H, SS + (size_t)(5 + layer) * MTOT, SS + (size_t)(layer + 1) * MTOT, EB, layer < DEPTH - 1 ? BUFA : nullptr, g_norm + (layer < DEPTH - 1 ? layer + 1 : 0) * 1024, grow0, rep_ == 1 || never};
              pg8::gemm_phase<pg8::EpiResid<true>, pg8::StaticOrder, true, true>(ldsl, g, S, E, wave); } }
            GSYNC();
        }
    }
            LAUNDER();
    for (int gr0 = gw; gr0 < MTOT; gr0 += 4 * NGW) {
        f32x4 v[4][4]; float rs[4];
#pragma unroll
        for (int k = 0; k < 4; ++k) { const int gr = gr0 + k * NGW < MTOT ? gr0 + k * NGW : gr0; rs[k] = SS[(size_t)4 * MTOT + gr];
#pragma unroll
            for (int j = 0; j < 4; ++j) v[k][j] = ((const f32x4*)(H + (size_t)gr * 1024))[lane + 64 * j]; }
#pragma unroll
        for (int k = 0; k < 4; ++k) { const int gr = gr0 + k * NGW; if (gr < MTOT) { const float r_ = __builtin_amdgcn_rsqf(rs[k] * (1.f / 1024.f) + 1e-6f);
#pragma unroll
            for (int j = 0; j < 4; ++j) { const f32x4 gg = ((const f32x4*)g_final)[lane + 64 * j]; __builtin_nontemporal_store(v[k][j] * gg * r_, (f32x4*)(H + (size_t)gr * 1024) + lane + 64 * j); } } }
    }
}

#undef lane
#undef gt
#undef bx
#undef vcu
#undef gw
extern "C" void kernel_launch(void* const* d_in, const int* in_sizes, int n_in, void* d_out, int out_size, void* d_ws, size_t ws_size, hipStream_t stream) {
    static int grid = 0;
    if (grid == 0) {
        if (n_in != 15 || out_size != MTOT * DM_ || ws_size < WS_END) { fprintf(stderr, "kernel_launch: unexpected shapes (n_in %d out %d ws %zu)\n", n_in, out_size, ws_size); grid = -1; return; }
        int dev = 0, cus = 0, per_cu = 0;
        (void)hipGetDevice(&dev); (void)hipDeviceGetAttribute(&cus, hipDeviceAttributeMultiprocessorCount, dev);
        (void)hipFuncSetAttribute((const void*)fwd_mega, hipFuncAttributeMaxDynamicSharedMemorySize, LDS_BYTES);
        (void)hipOccupancyMaxActiveBlocksPerMultiprocessor(&per_cu, (const void*)fwd_mega, NWAVES * 64, LDS_BYTES);
        if (per_cu < 1) per_cu = 1;
        grid = cus * per_cu;
        (void)hipGetLastError();
    }
    if (grid < 0) return;
    (void)hipMemsetAsync((char*)d_ws + WS_BAR, 0, BAR_BYTES, stream);
    Args a{};
    for (int i = 0; i < 15; ++i) a.in[i] = (const float*)d_in[i];
    a.out = (float*)d_out; a.ws = (unsigned char*)d_ws;
    void* kargs[] = {&a};
    hipError_t e = hipLaunchCooperativeKernel((const void*)fwd_mega, dim3(grid), dim3(NWAVES * 64), kargs, LDS_BYTES, stream);
    if (e != hipSuccess) fprintf(stderr, "cooperative launch failed: %s (grid %d)\n", hipGetErrorString(e), grid);
}
```

```cpp
#include <hip/hip_runtime.h>
#include <hip/hip_cooperative_groups.h>
namespace cg = cooperative_groups;
__device__ __forceinline__ float shx(float v, int lane, int m) { return __builtin_bit_cast(float, __builtin_amdgcn_ds_bpermute((lane ^ m) << 2, __builtin_bit_cast(int, v))); }
__device__ __forceinline__ int lane_now() { int l; asm volatile("v_mbcnt_lo_u32_b32 %0, -1, 0\n\tv_mbcnt_hi_u32_b32 %0, -1, %0" : "=v"(l)); return l; }
#include <hip/hip_runtime.h>
#include <cstdio>
#include <cstdint>
namespace pg8 {
#define PG8_LAS __attribute__((address_space(3)))
typedef unsigned short bf16_t;
typedef short bf16x8 __attribute__((ext_vector_type(8)));
typedef float f32x4 __attribute__((ext_vector_type(4)));
typedef unsigned u32x4 __attribute__((ext_vector_type(4)));
constexpr int BM = 256, BK = 64, HALF = 128, HTB = HALF * BK * 2  , STAGE_BYTES = 8 * HTB, NXCD = 8, WGM = 8;

__host__ __device__ __forceinline__ int lds_byte(int r, int c) { const int st = (r >> 4) * 2 + (c >> 5), rr = r & 15, cc = c & 31, ob = rr * 64 + cc * 2; return st * 1024 + (ob ^ (((ob >> 9) & 1) << 5)); }
__host__ __device__ __forceinline__ void stage_rc(int b, int& R, int& C) { const int st = b / 1024, sb = b % 1024, swz = sb ^ (((sb >> 9) & 1) << 5); R = (st >> 1) * 16 + swz / 64; C = (st & 1) * 32 + (swz % 64) / 2; }
__host__ __device__ __forceinline__ int perm32(int rho) { const int n = rho >> 4, i = rho & 15; return 8 * (i >> 2) + 4 * n + (i & 3); }

struct Unit { int pm, pn; };
struct Gemm { const bf16_t* A; const bf16_t* Bt; int M, N, K, lda; };

struct StaticOrder {
    int nM, nN, nwg, G, c;
    __host__ __device__ void init(int M, int N, int G_, int c_) { nM = M / BM; nN = N / BM; nwg = nM * nN; G = G_; c = c_; }
    __host__ __device__ bool next(int i, Unit& u) const {
        const long L = (long)i * G + c; if (L >= nwg) return false;
        int wgid = (int)L; { const int q = nwg / NXCD, r = nwg % NXCD, xcd = wgid % NXCD, off = wgid / NXCD; wgid = (xcd < r ? xcd * (q + 1) : r * (q + 1) + (xcd - r) * q) + off; }
        const int nig = WGM * nN, gid = wgid / nig, fm = gid * WGM, gsz = (nM - fm) < WGM ? (nM - fm) : WGM;
        u.pm = fm + ((wgid % nig) % gsz); u.pn = (wgid % nig) / gsz; return true;
    }
    __device__ __forceinline__ void a_ready(const Unit&) const {}
    __device__ __forceinline__ void done(const Unit&) const {}
};

template <class Epi, class Sched, bool ALIGN_EPI = false, bool SP2 = false>
__device__ __forceinline__ void gemm_phase(PG8_LAS unsigned char* lds, const Gemm g, const Sched& S, const Epi& E, const int wave_id) {
    const int tid = wave_id * 64 + lane_now(), wid = wave_id, lane = tid & 63, wr = wid >> 2, wc = wid & 3, fr = lane & 15, fq = lane >> 4;
    const int K = g.K, nt = K / BK;
    unsigned voffA[2], voffB[2];
#pragma unroll
    for (int i = 0; i < 2; ++i) { int R, C; stage_rc(tid * 16 + i * 8192, R, C); const int Rb = Epi::PERM ? ((R & ~31) + perm32(R & 31)) : R;
        voffA[i] = (unsigned)(R * g.lda + C) * 2u; voffB[i] = (unsigned)(Rb * K + C) * 2u; }
    const size_t kstep = (size_t)(BK * 2);
    const size_t hstep = (size_t)HALF * K * 2;
    const size_t tstep = 2 * hstep; const size_t hstepA = (size_t)HALF * g.lda * 2, tstepA = 2 * hstepA;
    const unsigned ldsw = (unsigned)wid * 1024u;
    const int aoff = lds_byte(wr * 64 + fr, fq * 8), boff = lds_byte(wc * 32 + fr, fq * 8);
#define PG8_SA(b, h) (((b) * 2 + (h)) * HTB)
#define PG8_SB(b, h) ((4 + (b) * 2 + (h)) * HTB)
#define PG8_STAGE(bufoff, gbase, voff) do { _Pragma("unroll") for (int _i = 0; _i < 2; ++_i) \
        __builtin_amdgcn_global_load_lds((const unsigned*)((const char*)(gbase) + (voff)[_i]), (PG8_LAS unsigned*)(lds + (bufoff) + ldsw + _i * 8192), 16, 0, 0); } while (0)
#define PG8_LDA(dst, b, h) do { _Pragma("unroll") for (int m = 0; m < 4; ++m) _Pragma("unroll") for (int k = 0; k < 2; ++k) dst[m][k] = *(const PG8_LAS bf16x8*)(lds + PG8_SA(b, h) + aoff + m * 2048 + k * 1024); } while (0)
#define PG8_LDB(dst, b, h) do { _Pragma("unroll") for (int n = 0; n < 2; ++n) _Pragma("unroll") for (int k = 0; k < 2; ++k) dst[n][k] = *(const PG8_LAS bf16x8*)(lds + PG8_SB(b, h) + boff + n * 2048 + k * 1024); } while (0)
#define PG8_MMA(ai, bj, At, Bt) do { __builtin_amdgcn_s_setprio(1); _Pragma("unroll") for (int m = 0; m < 4; ++m) _Pragma("unroll") for (int n = 0; n < 2; ++n) _Pragma("unroll") for (int k = 0; k < 2; ++k) \
        acc[ai][bj][m][n] = __builtin_amdgcn_mfma_f32_16x16x32_bf16(Bt[n][k], At[m][k], acc[ai][bj][m][n], 0, 0, 0); __builtin_amdgcn_s_setprio(0); } while (0)
#define PG8_WAIT_V(n) asm volatile("s_waitcnt vmcnt(" #n ")" ::: "memory")
#define PG8_WAIT_L(n) asm volatile("s_waitcnt lgkmcnt(" #n ")" ::: "memory")
#define PG8_BAR __builtin_amdgcn_s_barrier()
#define PG8_SCHED __builtin_amdgcn_sched_barrier(0)
    Unit cur, nxt; int ui = 0;
    if (!S.next(0, cur)) return;
    f32x4 acc[2][2][4][2];
#pragma unroll
    for (int a = 0; a < 2; ++a)
#pragma unroll
        for (int b = 0; b < 2; ++b)
#pragma unroll
            for (int m = 0; m < 4; ++m)
#pragma unroll
                for (int n = 0; n < 2; ++n) acc[a][b][m][n] = (f32x4){0.f, 0.f, 0.f, 0.f};
    bf16x8 At[4][2], B0[2][2], B1[2][2];
    const char* cA = (const char*)g.A + (size_t)cur.pm * tstepA; const char* cB = (const char*)g.Bt + (size_t)cur.pn * tstep;
    S.a_ready(cur);
    if constexpr (SP2) {
        PG8_STAGE(PG8_SB(0, 0), cB, voffB); PG8_STAGE(PG8_SB(0, 1), cB + hstep, voffB); PG8_STAGE(PG8_SA(0, 0), cA, voffA); PG8_STAGE(PG8_SA(0, 1), cA + hstepA, voffA);
        if (wr == 1) PG8_BAR;
        PG8_WAIT_V(2); PG8_BAR;
        PG8_STAGE(PG8_SB(1, 0), cB + kstep, voffB); PG8_STAGE(PG8_SA(1, 0), cA + kstep, voffA); PG8_STAGE(PG8_SB(1, 1), cB + hstep + kstep, voffB);
        PG8_WAIT_V(6); PG8_BAR;
    } else {
        PG8_STAGE(PG8_SB(0, 0), cB, voffB); PG8_STAGE(PG8_SA(0, 0), cA, voffA); PG8_STAGE(PG8_SB(0, 1), cB + hstep, voffB); PG8_STAGE(PG8_SA(0, 1), cA + hstepA, voffA);
        if (wr == 1) PG8_BAR;
        PG8_WAIT_V(4); PG8_BAR;
        PG8_STAGE(PG8_SB(1, 0), cB + kstep, voffB); PG8_STAGE(PG8_SA(1, 0), cA + kstep, voffA); PG8_STAGE(PG8_SB(1, 1), cB + hstep + kstep, voffB);
        PG8_WAIT_V(6); PG8_BAR;
    }
    for (;;) {
        const bool has_next = S.next(ui + 1, nxt);
        const char* nA = has_next ? (const char*)g.A + (size_t)nxt.pm * tstepA : cA; const char* nB = has_next ? (const char*)g.Bt + (size_t)nxt.pn * tstep : cB;
        for (int t = 0; t < nt; t += 2) {
            const bool last = (t == nt - 2);
            const char* a1 = cA + (size_t)(t + 1) * kstep;
            const char* a2 = last ? nA : cA + (size_t)(t + 2) * kstep; const char* b2 = last ? nB : cB + (size_t)(t + 2) * kstep;
            const char* a3 = a2 + kstep; const char* b3 = b2 + kstep;
            if (last && has_next) S.a_ready(nxt);
            if constexpr (SP2) {
            PG8_LDB(B0, 0, 0); PG8_LDB(B1, 0, 1); PG8_SCHED; PG8_LDA(At, 0, 0); PG8_STAGE(PG8_SA(1, 1), a1 + hstepA, voffA);
            PG8_WAIT_V(8); PG8_WAIT_L(0); PG8_BAR; PG8_MMA(0, 0, At, B0); PG8_MMA(0, 1, At, B1); PG8_BAR; PG8_SCHED;
            PG8_LDA(At, 0, 1); PG8_STAGE(PG8_SB(0, 0), b2, voffB); PG8_STAGE(PG8_SB(0, 1), b2 + hstep, voffB); PG8_STAGE(PG8_SA(0, 0), a2, voffA);
            PG8_WAIT_V(8); PG8_WAIT_L(0); PG8_BAR; PG8_MMA(1, 0, At, B0); PG8_MMA(1, 1, At, B1); PG8_BAR; PG8_SCHED;
            PG8_LDB(B0, 1, 0); PG8_LDB(B1, 1, 1); PG8_SCHED; PG8_LDA(At, 1, 0); PG8_STAGE(PG8_SA(0, 1), a2 + hstepA, voffA);
            PG8_WAIT_V(8); PG8_WAIT_L(0); PG8_BAR; PG8_MMA(0, 0, At, B0); PG8_MMA(0, 1, At, B1); PG8_BAR; PG8_SCHED;
            PG8_LDA(At, 1, 1); PG8_STAGE(PG8_SB(1, 0), b3, voffB); PG8_STAGE(PG8_SB(1, 1), b3 + hstep, voffB); PG8_STAGE(PG8_SA(1, 0), a3, voffA);
            PG8_WAIT_V(8); PG8_WAIT_L(0); PG8_BAR; PG8_MMA(1, 0, At, B0); PG8_MMA(1, 1, At, B1); PG8_BAR; PG8_SCHED;
            } else {
            PG8_LDB(B0, 0, 0); PG8_SCHED; PG8_LDA(At, 0, 0); PG8_STAGE(PG8_SA(1, 1), a1 + hstepA, voffA);
            PG8_WAIT_L(8); PG8_BAR; PG8_WAIT_L(0); PG8_MMA(0, 0, At, B0); PG8_BAR; PG8_SCHED;
            PG8_LDB(B1, 0, 1); PG8_STAGE(PG8_SB(0, 0), b2, voffB);
            PG8_BAR; PG8_WAIT_L(0); PG8_MMA(0, 1, At, B1); PG8_BAR;
            PG8_LDA(At, 0, 1); PG8_STAGE(PG8_SA(0, 0), a2, voffA);
            PG8_BAR; PG8_WAIT_L(0); PG8_MMA(1, 0, At, B0); PG8_BAR; PG8_SCHED;
            PG8_STAGE(PG8_SB(0, 1), b2 + hstep, voffB);
            PG8_WAIT_V(6); PG8_BAR; PG8_MMA(1, 1, At, B1); PG8_BAR;
            PG8_LDB(B0, 1, 0); PG8_SCHED; PG8_LDA(At, 1, 0); PG8_STAGE(PG8_SA(0, 1), a2 + hstepA, voffA);
            PG8_WAIT_L(8); PG8_BAR; PG8_WAIT_L(0); PG8_MMA(0, 0, At, B0); PG8_BAR; PG8_SCHED;
            PG8_LDB(B1, 1, 1); PG8_STAGE(PG8_SB(1, 0), b3, voffB);
            PG8_BAR; PG8_WAIT_L(0); PG8_MMA(0, 1, At, B1); PG8_BAR;
            PG8_LDA(At, 1, 1); PG8_STAGE(PG8_SA(1, 0), a3, voffA);
            PG8_BAR; PG8_WAIT_L(0); PG8_MMA(1, 0, At, B0); PG8_BAR; PG8_SCHED;
            PG8_STAGE(PG8_SB(1, 1), b3 + hstep, voffB);
            PG8_WAIT_V(6); PG8_BAR; PG8_MMA(1, 1, At, B1); PG8_BAR;
            }
        }
        if constexpr (ALIGN_EPI) { if (wr == 0) PG8_BAR; }
        if constexpr (!Epi::AFTER_DRAIN) { E(acc, cur, wr, wc, fr, fq); S.done(cur); }
        if (!has_next) break;
#pragma unroll
        for (int a = 0; a < 2; ++a)
#pragma unroll
            for (int b = 0; b < 2; ++b)
#pragma unroll
                for (int m = 0; m < 4; ++m)
#pragma unroll
                    for (int n = 0; n < 2; ++n) acc[a][b][m][n] = (f32x4){0.f, 0.f, 0.f, 0.f};
        cur = nxt; cA = nA; cB = nB; ++ui;
        if constexpr (ALIGN_EPI) { if (wr == 1) PG8_BAR; }
    }
    PG8_WAIT_V(0);
    if constexpr (!ALIGN_EPI) { if (wr == 0) PG8_BAR; }
    PG8_BAR;
    if constexpr (Epi::AFTER_DRAIN) { E.fused(acc, cur, wr, wc, fr, fq, lds, wid, lane); S.done(cur); }
#undef PG8_SA
#undef PG8_SB
#undef PG8_STAGE
#undef PG8_LDA
#undef PG8_LDB
#undef PG8_MMA
#undef PG8_WAIT_V
#undef PG8_WAIT_L
#undef PG8_BAR
#undef PG8_SCHED
}
}
namespace pg8 {
__device__ __forceinline__ unsigned cvt_pk_bf16(float lo, float hi) { unsigned r; asm volatile("v_cvt_pk_bf16_f32 %0, %1, %2" : "=v"(r) : "v"(lo), "v"(hi)); return r; }
__device__ __forceinline__ float bf_lo(unsigned w) { return __uint_as_float(w << 16); }
__device__ __forceinline__ float bf_hi(unsigned w) { return __uint_as_float(w & 0xffff0000u); }
__device__ __forceinline__ float sigm(float x) { return __builtin_amdgcn_rcpf(1.f + __expf(-x)); }
#define EPI_ROWS_BEGIN \
    const int row0 = u.pm * BM + wr * 64 + fr; const int col0 = u.pn * BM + wc * 32 + 8 * fq; \
    _Pragma("unroll") for (int ai = 0; ai < 2; ++ai) _Pragma("unroll") for (int m = 0; m < 4; ++m) { const int lr = row0 + ai * HALF + m * 16;
#define EPI_ROWS_END }
typedef float f32x2e __attribute__((ext_vector_type(2)));
struct EpiProj {
    static constexpr bool PERM = true, AFTER_DRAIN = false;
    bf16_t* O; int ldc; const float* ss; int grow0; const float* gq; const float* gk; const f32x2e* tax; const f32x2e* t1d;
    __device__ __forceinline__ void operator()(const f32x4 (&acc)[2][2][4][2], const Unit& u, int wr, int wc, int fr_, int fq_) const {
        const int l_ = lane_now(), fr = l_ & 15, fq = l_ >> 4;
        const int pn = u.pn;
        const int kind = pn < 2 ? 1 : (pn == 2 ? (wc < 2 ? 2 : 0) : (pn < 5 ? 0 : (pn < 8 ? 3 : (pn < 11 ? 4 : 0))));
        const int row0 = u.pm * BM + wr * 64 + fr; const int ocol = pn * BM + wc * 64 + 8 * fq;
        const float C2v = 0.125f * 1.4426950408889634f;
        if (kind == 0) {
#pragma unroll
            for (int ai = 0; ai < 2; ++ai)
#pragma unroll
                for (int m = 0; m < 4; ++m) { const int lr = row0 + ai * HALF + m * 16;
                    const float rs = __builtin_amdgcn_rsqf(ss[grow0 + lr] * (1.f / 1024.f) + 1e-6f);
                    bf16_t* rowp = O + (size_t)lr * ldc + ocol;
#pragma unroll
                    for (int bj = 0; bj < 2; ++bj) { const f32x4 v0 = acc[ai][bj][m][0] * rs, v1 = acc[ai][bj][m][1] * rs;
                        u32x4 w; w.x = cvt_pk_bf16(v0[0], v0[1]); w.y = cvt_pk_bf16(v0[2], v0[3]); w.z = cvt_pk_bf16(v1[0], v1[1]); w.w = cvt_pk_bf16(v1[2], v1[3]);
                        *(u32x4*)(rowp + bj * 32) = w; } }
        } else if (kind <= 2) {
            const float* gp = (kind == 1 ? gq : gk) + 8 * fq; const float osc = kind == 1 ? C2v : 1.f;
            float gv[2][8];
#pragma unroll
            for (int bj = 0; bj < 2; ++bj)
#pragma unroll
                for (int i = 0; i < 8; ++i) gv[bj][i] = gp[bj * 32 + i] * osc;
            const float sgn = fq < 2 ? -1.f : 1.f;
#pragma unroll
            for (int ai = 0; ai < 2; ++ai)
#pragma unroll
                for (int m = 0; m < 4; ++m) { const int lr = row0 + ai * HALF + m * 16; const int t = lr & 4095;
                    const float rs = __builtin_amdgcn_rsqf(ss[grow0 + lr] * (1.f / 1024.f) + 1e-6f);
                    float x[2][8]; float sq = 0.f;
#pragma unroll
                    for (int bj = 0; bj < 2; ++bj)
#pragma unroll
                        for (int i = 0; i < 8; ++i) { x[bj][i] = acc[ai][bj][m][i >> 2][i & 3] * rs; sq += x[bj][i] * x[bj][i]; }
                    sq += shx(sq, l_, 16); sq += shx(sq, l_, 32);
                    const float rn = __builtin_amdgcn_rsqf(sq * (1.f / 64.f) + 1e-6f);
                    bf16_t* rowp = O + (size_t)lr * ldc + ocol;
#pragma unroll
                    for (int bj = 0; bj < 2; ++bj) { const f32x2e* tb = tax + (bj == 0 ? (t >> 6) : (t & 63)) * 16 + 8 * (fq & 1);
                        float y[8];
#pragma unroll
                        for (int i = 0; i < 8; ++i) { const float xv = x[bj][i] * rn * gv[bj][i]; const float xp = shx(xv, l_, 32); const f32x2e cs = tb[i]; y[i] = xv * cs.x + sgn * xp * cs.y; }
                        u32x4 w; w.x = cvt_pk_bf16(y[0], y[1]); w.y = cvt_pk_bf16(y[2], y[3]); w.z = cvt_pk_bf16(y[4], y[5]); w.w = cvt_pk_bf16(y[6], y[7]);
                        *(u32x4*)(rowp + bj * 32) = w; } }
        } else {
            const float osc = kind == 3 ? C2v : 1.f;
#pragma unroll
            for (int ai = 0; ai < 2; ++ai)
#pragma unroll
                for (int m = 0; m < 4; ++m) { const int lr = row0 + ai * HALF + m * 16; const int t = lr & 4095;
                    const float rs = __builtin_amdgcn_rsqf(ss[grow0 + lr] * (1.f / 1024.f) + 1e-6f) * osc;
                    const f32x2e* tb = t1d + t * 32 + 8 * fq;
                    float y0[8], y1[8];
#pragma unroll
                    for (int i = 0; i < 8; ++i) { const float x0 = acc[ai][0][m][i >> 2][i & 3] * rs, x1 = acc[ai][1][m][i >> 2][i & 3] * rs; const f32x2e cs = tb[i];
                        y0[i] = x0 * cs.x - x1 * cs.y; y1[i] = x1 * cs.x + x0 * cs.y; }
                    bf16_t* rowp = O + (size_t)lr * ldc + ocol;
                    u32x4 w; w.x = cvt_pk_bf16(y0[0], y0[1]); w.y = cvt_pk_bf16(y0[2], y0[3]); w.z = cvt_pk_bf16(y0[4], y0[5]); w.w = cvt_pk_bf16(y0[6], y0[7]);
                    *(u32x4*)(rowp) = w;
                    w.x = cvt_pk_bf16(y1[0], y1[1]); w.y = cvt_pk_bf16(y1[2], y1[3]); w.z = cvt_pk_bf16(y1[4], y1[5]); w.w = cvt_pk_bf16(y1[6], y1[7]);
                    *(u32x4*)(rowp + 32) = w; }
        }
    }
};
template <bool ADD> struct EpiGate {
    static constexpr bool PERM = true, AFTER_DRAIN = false;
    bf16_t* O; int ldc; const bf16_t* G; int ldg;
    __device__ __forceinline__ void operator()(const f32x4 (&acc)[2][2][4][2], const Unit& u, int wr, int wc, int fr_, int fq_) const { const int l_ = lane_now(), fr = l_ & 15, fq = l_ >> 4;
        const int row0 = u.pm * BM + wr * 64 + fr; const int col0 = u.pn * BM + wc * 32 + 8 * fq;
#pragma unroll
        for (int ai = 0; ai < 2; ++ai)
#pragma unroll
        for (int mh = 0; mh < 4; mh += 2) {
            u32x4 gw[4][2], pv[4][2];
#pragma unroll
            for (int m = mh; m < mh + 2; ++m) { const int lr = row0 + ai * HALF + m * 16;
#pragma unroll
                for (int bj = 0; bj < 2; ++bj) { gw[m][bj] = *(const u32x4*)(G + (size_t)lr * ldg + col0 + bj * HALF); pv[m][bj] = (u32x4){0u, 0u, 0u, 0u}; if (ADD) pv[m][bj] = *(const u32x4*)(O + (size_t)lr * ldc + col0 + bj * HALF); } }
#pragma unroll
            for (int m = mh; m < mh + 2; ++m) { const int lr = row0 + ai * HALF + m * 16; bf16_t* rowp = O + (size_t)lr * ldc + col0;
#pragma unroll
                for (int bj = 0; bj < 2; ++bj) { const u32x4 g_ = gw[m][bj], p_ = pv[m][bj]; const f32x4 a0 = acc[ai][bj][m][0], a1 = acc[ai][bj][m][1]; u32x4 w;
                    w.x = cvt_pk_bf16(bf_lo(p_.x) + sigm(bf_lo(g_.x)) * a0[0], bf_hi(p_.x) + sigm(bf_hi(g_.x)) * a0[1]);
                    w.y = cvt_pk_bf16(bf_lo(p_.y) + sigm(bf_lo(g_.y)) * a0[2], bf_hi(p_.y) + sigm(bf_hi(g_.y)) * a0[3]);
                    w.z = cvt_pk_bf16(bf_lo(p_.z) + sigm(bf_lo(g_.z)) * a1[0], bf_hi(p_.z) + sigm(bf_hi(g_.z)) * a1[1]);
                    w.w = cvt_pk_bf16(bf_lo(p_.w) + sigm(bf_lo(g_.w)) * a1[2], bf_hi(p_.w) + sigm(bf_hi(g_.w)) * a1[3]);
                    *(u32x4*)(rowp + bj * HALF) = w; } }
        }
    }
};
struct EpiPlain {
    static constexpr bool PERM = true, AFTER_DRAIN = false;
    bf16_t* O; int ldc;
    __device__ __forceinline__ void operator()(const f32x4 (&acc)[2][2][4][2], const Unit& u, int wr, int wc, int fr_, int fq_) const { const int l_ = lane_now(), fr = l_ & 15, fq = l_ >> 4;
        EPI_ROWS_BEGIN
            bf16_t* rowp = O + (size_t)lr * ldc + col0;
#pragma unroll
            for (int bj = 0; bj < 2; ++bj) { const f32x4 v0 = acc[ai][bj][m][0], v1 = acc[ai][bj][m][1];
                u32x4 w; w.x = cvt_pk_bf16(v0[0], v0[1]); w.y = cvt_pk_bf16(v0[2], v0[3]); w.z = cvt_pk_bf16(v1[0], v1[1]); w.w = cvt_pk_bf16(v1[2], v1[3]);
                *(u32x4*)(rowp + bj * HALF) = w; }
        EPI_ROWS_END
    }
};
template <bool GATED> struct EpiResid {
    static constexpr bool PERM = true, AFTER_DRAIN = false;
    float* H; const float* ss_in; float* ss_out; const bf16_t* E; bf16_t* XO; const float* gvec; int grow0; bool st;
    __device__ __forceinline__ void operator()(const f32x4 (&acc)[2][2][4][2], const Unit& u, int wr, int wc, int fr_, int fq_) const { const int l_ = lane_now(), fr = l_ & 15, fq = l_ >> 4;
        const int row0 = u.pm * BM + wr * 64 + fr; const int col0 = u.pn * BM + wc * 32 + 8 * fq;
        f32x4 gv[2][2];
#pragma unroll
        for (int bj = 0; bj < 2; ++bj)
#pragma unroll
            for (int n = 0; n < 2; ++n) gv[bj][n] = XO ? *(const f32x4*)(gvec + col0 + bj * HALF + 4 * n) : (f32x4){0.f, 0.f, 0.f, 0.f};
#pragma unroll
        for (int ai = 0; ai < 2; ++ai)
#pragma unroll
        for (int mh = 0; mh < 4; mh += 2) {
            f32x4 hv[4][2][2]; u32x4 ev[4][2]; float sv[4];
#pragma unroll
            for (int m = mh; m < mh + 2; ++m) { const int lr = row0 + ai * HALF + m * 16, gr = grow0 + lr; const float* hp = H + (size_t)gr * 1024 + col0;
                sv[m] = GATED ? ss_in[gr] : 0.f;
#pragma unroll
                for (int bj = 0; bj < 2; ++bj) { hv[m][bj][0] = *(const f32x4*)(hp + bj * HALF); hv[m][bj][1] = *(const f32x4*)(hp + bj * HALF + 4);
                    ev[m][bj] = (u32x4){0u, 0u, 0u, 0u}; if (GATED) ev[m][bj] = *(const u32x4*)(E + (size_t)lr * 1024 + col0 + bj * HALF); } }
#pragma unroll
            for (int m = mh; m < mh + 2; ++m) { const int lr = row0 + ai * HALF + m * 16, gr = grow0 + lr; float* hp = H + (size_t)gr * 1024 + col0;
                float rs = 1.f; if (GATED) rs = __builtin_amdgcn_rsqf(sv[m] * (1.f / 1024.f) + 1e-6f);
                float sq = 0.f;
#pragma unroll
                for (int bj = 0; bj < 2; ++bj) {
                    f32x4 h0 = hv[m][bj][0], h1 = hv[m][bj][1];
                    f32x4 a0 = acc[ai][bj][m][0], a1 = acc[ai][bj][m][1];
                    if (GATED) { const u32x4 ew = ev[m][bj];
                        a0[0] = sigm(a0[0] * rs) * bf_lo(ew.x); a0[1] = sigm(a0[1] * rs) * bf_hi(ew.x); a0[2] = sigm(a0[2] * rs) * bf_lo(ew.y); a0[3] = sigm(a0[3] * rs) * bf_hi(ew.y);
                        a1[0] = sigm(a1[0] * rs) * bf_lo(ew.z); a1[1] = sigm(a1[1] * rs) * bf_hi(ew.z); a1[2] = sigm(a1[2] * rs) * bf_lo(ew.w); a1[3] = sigm(a1[3] * rs) * bf_hi(ew.w); }
                    h0 = h0 + a0; h1 = h1 + a1;
                    if (st) { *(f32x4*)(hp + bj * HALF) = h0; *(f32x4*)(hp + bj * HALF + 4) = h1; }
                    sq += (h0[0] * h0[0] + h0[1] * h0[1]) + (h0[2] * h0[2] + h0[3] * h0[3]) + (h1[0] * h1[0] + h1[1] * h1[1]) + (h1[2] * h1[2] + h1[3] * h1[3]);
                    if (XO) { const f32x4 x0 = h0 * gv[bj][0], x1 = h1 * gv[bj][1];
                        u32x4 w; w.x = cvt_pk_bf16(x0[0], x0[1]); w.y = cvt_pk_bf16(x0[2], x0[3]); w.z = cvt_pk_bf16(x1[0], x1[1]); w.w = cvt_pk_bf16(x1[2], x1[3]);
                        if (st) *(u32x4*)(XO + (size_t)lr * 1024 + col0 + bj * HALF) = w; }
                }
                sq += shx(sq, l_, 16); sq += shx(sq, l_, 32);
                if (fq == 0 && st) unsafeAtomicAdd(ss_out + gr, sq);
            }
        }
    }
};
}
#include <hip/hip_bf16.h>
#include <cmath>
namespace attn_body {
using bf16=__hip_bfloat16;
using bf16x8=__attribute__((ext_vector_type(8)))short;
using s16x4=__attribute__((ext_vector_type(4)))short;
using f32x16=__attribute__((ext_vector_type(16)))float;
using u32x4=__attribute__((ext_vector_type(4)))unsigned;
constexpr int NHEAD=8,SEQ=4096,D=64,DM=5888;
constexpr int NW=8,QBLK=32,QB=QBLK*NW,KVBLK=64,NQB=SEQ/QB;
constexpr int ATTN_PITCH=DM, ATTN_UNIT_ROWS=QB;
__device__ __forceinline__ int crow(int r,int hi){return (r&3)+8*(r>>2)+4*hi;}
#define SBAR() __builtin_amdgcn_sched_barrier(0)
__device__ __forceinline__ void cmask(f32x16&p0,f32x16&p1,int jb,int qrel,int hi){
  const float NEG=-INFINITY; int kb=64*jb+4*hi;
  #pragma unroll
  for(int r=0;r<16;++r){int kv=kb+(r&3)+8*(r>>2); if(kv>qrel)p0[r]=NEG; if(kv+32>qrel)p1[r]=NEG;}
}

constexpr int NSLOT=3, SLOTB=8192;
constexpr int LDS_K=0, LDS_V=NSLOT*SLOTB, LDS_WS=2*NSLOT*SLOTB, LDS_OST=LDS_WS+NW*64*4, LDS_BYTES=LDS_OST+NW*4096;
constexpr float C2=0.125f*1.4426950408889634f;
__device__ __forceinline__ void glds16(const void*gsrc,unsigned lds_dst){unsigned keep;
  asm volatile("s_mov_b32 %0, m0\n\ts_mov_b32 m0, %2\n\ts_nop 0\n\tglobal_load_lds_dwordx4 %1, off\n\ts_mov_b32 m0, %0":"=&s"(keep):"v"(gsrc),"s"(lds_dst):"memory");}
__device__ __forceinline__ float max3f(float a,float b,float c){float r;asm("v_max3_f32 %0, %1, %2, %3":"=v"(r):"v"(a),"v"(b),"v"(c));return r;}
__device__ __forceinline__ float max2f(float a,float b){float r;asm("v_max_f32_e32 %0, %1, %2":"=v"(r):"v"(a),"v"(b));return r;}
__device__ __forceinline__ float fadd_s(float a,float b){float r;asm("v_add_f32_e32 %0, %1, %2":"=v"(r):"v"(a),"v"(b));return r;}
__device__ __forceinline__ float fsub_s(float a,float b){float r;asm("v_sub_f32_e32 %0, %1, %2":"=v"(r):"v"(a),"v"(b));return r;}
typedef float f32x2_t __attribute__((ext_vector_type(2))); typedef __bf16 bf16x2_t __attribute__((ext_vector_type(2)));
__device__ __forceinline__ unsigned cvtpk_s(float lo,float hi){f32x2_t v={lo,hi};bf16x2_t b=__builtin_convertvector(v,bf16x2_t);return __builtin_bit_cast(unsigned,b);}
#define WAIT_BAR(N) asm volatile("s_waitcnt vmcnt(" #N ") lgkmcnt(0)\n\ts_barrier":::"memory")

__device__ __forceinline__ void qkt(f32x16&p0,f32x16&p1,const char*Kslot,const bf16x8*qr,const f32x16&negm,int r32,int hi){
  const char*kb=Kslot+hi*1024+r32*16;
  #pragma unroll
  for(int d0=0;d0<4;++d0){
    const bf16x8 b0=*reinterpret_cast<const bf16x8*>(kb+d0*2048);
    const bf16x8 b1=*reinterpret_cast<const bf16x8*>(kb+d0*2048+512);
    if(d0==0){p0=__builtin_amdgcn_mfma_f32_32x32x16_bf16(b0,qr[0],negm,0,0,0);p1=__builtin_amdgcn_mfma_f32_32x32x16_bf16(b1,qr[0],negm,0,0,0);}
    else{p0=__builtin_amdgcn_mfma_f32_32x32x16_bf16(b0,qr[d0],p0,0,0,0);p1=__builtin_amdgcn_mfma_f32_32x32x16_bf16(b1,qr[d0],p1,0,0,0);}}
}
typedef __attribute__((address_space(3))) const char* lds_cptr;
typedef short v4i16_t __attribute__((ext_vector_type(4)));
__device__ __forceinline__ void kload8(bf16x8*kf,lds_cptr kp){
  kf[0]=*(const __attribute__((address_space(3))) bf16x8*)(kp);      kf[1]=*(const __attribute__((address_space(3))) bf16x8*)(kp+512);
  kf[2]=*(const __attribute__((address_space(3))) bf16x8*)(kp+2048); kf[3]=*(const __attribute__((address_space(3))) bf16x8*)(kp+2560);
  kf[4]=*(const __attribute__((address_space(3))) bf16x8*)(kp+4096); kf[5]=*(const __attribute__((address_space(3))) bf16x8*)(kp+4608);
  kf[6]=*(const __attribute__((address_space(3))) bf16x8*)(kp+6144); kf[7]=*(const __attribute__((address_space(3))) bf16x8*)(kp+6656);
}
__device__ __forceinline__ void kload2(bf16x8*kf,lds_cptr kp,int j){ kf[2*j]=*(const __attribute__((address_space(3))) bf16x8*)(kp+j*2048); kf[2*j+1]=*(const __attribute__((address_space(3))) bf16x8*)(kp+j*2048+512); }
__device__ __forceinline__ s16x4 vtr(lds_cptr p){ return __builtin_bit_cast(s16x4,__builtin_amdgcn_ds_read_tr16_b64_v4i16((__attribute__((address_space(3))) v4i16_t*)p)); }
__device__ __forceinline__ float rowmax(const f32x16&p0,const f32x16&p1){
  float a=max3f(p0[0],p0[1],p1[0]),b=max3f(p0[2],p0[3],p1[1]);a=max3f(a,p1[2],p1[3]);
  #pragma unroll
  for(int r=4;r<16;r+=4){a=max3f(a,p0[r],p0[r+1]);b=max3f(b,p0[r+2],p0[r+3]);a=max3f(a,p1[r],p1[r+1]);b=max3f(b,p1[r+2],p1[r+3]);}
  const float m=max2f(a,b);
  auto rr=__builtin_amdgcn_permlane32_swap(__float_as_uint(m),__float_as_uint(m),false,false);
  return max2f(__uint_as_float(rr[0]),__uint_as_float(rr[1]));
}
__device__ __forceinline__ void pv(f32x16*o,int vb,bf16x8 pa0,bf16x8 pa1,bf16x8 pa2,bf16x8 pa3){
  #pragma unroll
  for(int d0=0;d0<2;++d0){s16x4 lo[4],hi[4];
    #pragma unroll
    for(int ks=0;ks<4;++ks){
      asm volatile("ds_read_b64_tr_b16 %0,%1 offset:%c2":"=&v"(lo[ks]):"v"(vb),"i"(d0*4096+ks*1024):"memory");
      asm volatile("ds_read_b64_tr_b16 %0,%1 offset:%c2":"=&v"(hi[ks]):"v"(vb),"i"(d0*4096+ks*1024+512):"memory");}
    asm volatile("s_waitcnt lgkmcnt(0)":::"memory");SBAR();
    #define PK(k) (bf16x8){lo[k][0],lo[k][1],lo[k][2],lo[k][3],hi[k][0],hi[k][1],hi[k][2],hi[k][3]}
    o[d0]=__builtin_amdgcn_mfma_f32_32x32x16_bf16(pa0,PK(0),o[d0],0,0,0);
    o[d0]=__builtin_amdgcn_mfma_f32_32x32x16_bf16(pa1,PK(1),o[d0],0,0,0);
    o[d0]=__builtin_amdgcn_mfma_f32_32x32x16_bf16(pa2,PK(2),o[d0],0,0,0);
    o[d0]=__builtin_amdgcn_mfma_f32_32x32x16_bf16(pa3,PK(3),o[d0],0,0,0);
    #undef PK
  }
}

#ifndef ATTN_STORE16
#define ATTN_STORE16(p,v) (*(u32x4*)(p)=(v))
#endif
template<int THRL> __device__ __forceinline__ void attn_unit(int b,int h,int qb,const bf16*Q,const bf16*__restrict__ K,const bf16*__restrict__ V,bf16*O,const bf16*__restrict__ Z,char*shm,const int wave_id,const bool st_){
  const int lane=lane_now(),tid=wave_id*64+lane,r32=lane&31,hi=lane>>5; const int wid=wave_id;
  const long rowbase=(long)b*SEQ; const int q0=qb*QB;
  const bf16*Qw=Q+(rowbase+q0+wid*QBLK)*DM+h*D;
  const bf16*Kh=K+rowbase*DM+(h>>2)*D,*Vh=V+rowbase*DM+(h>>2)*D;
  const unsigned lds0=(unsigned)(uintptr_t)shm;
  float*wsf=(float*)(shm+LDS_WS)+wid*64;
  const bf16*ksrc=Kh+(long)lane*DM+wid*8;
  const bf16*vsrc=Vh+(long)(16*(wid&3)+(lane>>2))*DM+(wid>>2)*32+(lane&3)*8;
  const unsigned kdst=lds0+LDS_K+wid*1024, vdst=lds0+LDS_V+wid*1024;
  #define DMA_K(t,slot) glds16(ksrc+(long)(t)*KVBLK*DM,(unsigned)__builtin_amdgcn_readfirstlane(kdst+(slot)))
  #define DMA_V(t,slot) glds16(vsrc+(long)(t)*KVBLK*DM,(unsigned)__builtin_amdgcn_readfirstlane(vdst+(slot)))
  const int vb0=(int)(lds0+LDS_V)+((lane>>4)&1)*32+(lane&3)*8+(4*hi+((lane&15)>>2))*64;
  const char*Kbase=shm+LDS_K; bf16x8 kf[8];
  const lds_cptr shm3=(lds_cptr)shm; const lds_cptr kp0=shm3+LDS_K+hi*1024+r32*16; const lds_cptr vp0=shm3+LDS_V+((lane>>4)&1)*32+(lane&3)*8+(4*hi+((lane&15)>>2))*64;
  constexpr int NT=SEQ/KVBLK;
  DMA_K(0,0);DMA_V(0,0);DMA_K(1,SLOTB);
  bf16x8 qr[4];
  #pragma unroll
  for(int d0=0;d0<4;++d0)qr[d0]=*reinterpret_cast<const bf16x8*>(&Qw[(long)r32*DM+d0*16+hi*8]);
  float mhat=0.f,l_reg=0.f;f32x16 o[2];{float zz=0.f;asm volatile("":"+v"(zz));_Pragma("unroll") for(int r=0;r<16;++r){o[0][r]=zz;o[1][r]=zz;}}f32x16 negm;{float zz=0.f;asm volatile("":"+v"(zz));_Pragma("unroll") for(int r=0;r<16;++r)negm[r]=zz;}asm volatile("":"+v"(negm));
  const int qrel=wid*QBLK+r32;
  #define CMASK(P0,P1,t) do{}while(0)
  bool resc=false;
  #define START(P0,P1) do{ const float rm=rowmax(P0,P1); resc=false; \
    { const float dl=rm; mhat=fadd_s(mhat,dl); \
      _Pragma("unroll") for(int r=0;r<16;++r){P0[r]=fsub_s(P0[r],dl);P1[r]=fsub_s(P1[r],dl);} \
      _Pragma("unroll") for(int r=0;r<16;++r)negm[r]=-mhat; asm volatile("":"+v"(negm)); } \
    _Pragma("unroll") for(int r=0;r<16;++r)P0[r]=__builtin_amdgcn_exp2f(P0[r]); }while(0)
  #define RESC() do{ if(resc){ asm volatile("s_waitcnt lgkmcnt(0)":::"memory"); \
      _Pragma("unroll") for(int d_=0;d_<2;++d_) _Pragma("unroll") for(int r=0;r<16;++r)o[d_][r]*=wsf[crow(r,hi)]; } }while(0)
  f32x16 pA0,pA1,pB0,pB1;
  int sl_prev=0,sl_cur=0,sl_next=SLOTB;
  #define ROT() do{sl_prev=sl_cur;sl_cur=sl_next;sl_next=(sl_next==(NSLOT-1)*SLOTB)?0:sl_next+SLOTB;}while(0)
  DMA_K(2,2*SLOTB);
  WAIT_BAR(3);
  qkt(pA0,pA1,Kbase,qr,negm,r32,hi);asm volatile("s_nop 15\n\ts_nop 7":"+v"(pA0),"+v"(pA1));CMASK(pA0,pA1,0);
  START(pA0,pA1);
  _Pragma("unroll") for(int r=0;r<16;++r)pA1[r]=__builtin_amdgcn_exp2f(pA1[r]);
  WAIT_BAR(0);
  DMA_K(3,0);DMA_V(1,SLOTB);
  ROT();
  kload8(kf,kp0+sl_cur);
  WAIT_BAR(2);
  s16x4 vlo[8],vhi[8]; u32x4 pw0,pw1,pw2,pw3;
  #define PKW(P,B) cvtpk_s(P[B],P[B+1])
  #define PAF(k) __builtin_bit_cast(bf16x8,pw##k)
  #define VFR(i) (bf16x8){vlo[i][0],vlo[i][1],vlo[i][2],vlo[i][3],vhi[i][0],vhi[i][1],vhi[i][2],vhi[i][3]}
  #define PIN(x) asm volatile("":"+v"(x))
  #define MX3(a,b,c) __builtin_fmaxf(__builtin_fmaxf((a),(b)),(c))
  #define GAPA(MF,A0,A1,A2,A3,W0,W1,PW) do{ MF; sacc+=A0; sacc+=A1; sacc+=A2; sacc+=A3; PIN(sacc); W0; W1; PIN(PW); SBAR(); }while(0)
  #define EX(v) __builtin_amdgcn_exp2f(v)
  #define GAPB(MF,X,B) do{ MF; X[B]=EX(X[B]); X[B+1]=EX(X[B+1]); X[B+2]=EX(X[B+2]); X[B+3]=EX(X[B+3]); PIN(X); SBAR(); }while(0)
  #define VRD(i) do{ vlo[i]=vtr(vp_+(((i)>>2)*4096+((i)&3)*1024)); vhi[i]=vtr(vp_+(((i)>>2)*4096+((i)&3)*1024+512)); }while(0)
  #define KRD(G,j) do{ if(G){ kload2(kf,kp0+sl_next,j); SBAR(); } }while(0)
  #define STEP(C0,C1,P0,P1,t,GK,GV,GL) do{ SBAR(); \
    const lds_cptr vp_=vp0+sl_prev; \
    VRD(0); SBAR(); float sacc=(P0[0]+P0[1]); \
    GAPA(C0=__builtin_amdgcn_mfma_f32_32x32x16_bf16(kf[0],qr[0],negm,0,0,0), P0[2],P0[3],P0[4],P0[5],     pw0[0]=PKW(P0,0), pw0[1]=PKW(P0,2), pw0); \
    VRD(4); SBAR(); GAPA(C1=__builtin_amdgcn_mfma_f32_32x32x16_bf16(kf[1],qr[0],negm,0,0,0), P0[6],P0[7],P0[8],P0[9],     pw0[2]=PKW(P0,4), pw0[3]=PKW(P0,6), pw0); \
    VRD(1); SBAR(); GAPA(C0=__builtin_amdgcn_mfma_f32_32x32x16_bf16(kf[2],qr[1],C0,0,0,0),   P0[10],P0[11],P0[12],P0[13], pw1[0]=PKW(P0,8), pw1[1]=PKW(P0,10), pw1); \
    VRD(5); SBAR(); GAPA(C1=__builtin_amdgcn_mfma_f32_32x32x16_bf16(kf[3],qr[1],C1,0,0,0),   P0[14],P0[15],P1[0],P1[1],   pw1[2]=PKW(P0,12),pw1[3]=PKW(P0,14), pw1); \
    VRD(2); SBAR(); GAPA(C0=__builtin_amdgcn_mfma_f32_32x32x16_bf16(kf[4],qr[2],C0,0,0,0),   P1[2],P1[3],P1[4],P1[5],     pw2[0]=PKW(P1,0), pw2[1]=PKW(P1,2), pw2); \
    VRD(6); SBAR(); GAPA(C1=__builtin_amdgcn_mfma_f32_32x32x16_bf16(kf[5],qr[2],C1,0,0,0),   P1[6],P1[7],P1[8],P1[9],     pw2[2]=PKW(P1,4), pw2[3]=PKW(P1,6), pw2); \
    VRD(3); SBAR(); GAPA(C0=__builtin_amdgcn_mfma_f32_32x32x16_bf16(kf[6],qr[3],C0,0,0,0),   P1[10],P1[11],P1[12],P1[13], pw3[0]=PKW(P1,8), pw3[1]=PKW(P1,10), pw3); \
    VRD(7); SBAR(); GAPA(C1=__builtin_amdgcn_mfma_f32_32x32x16_bf16(kf[7],qr[3],C1,0,0,0),   P1[14],P1[15],0.f,0.f,       pw3[2]=PKW(P1,12),pw3[3]=PKW(P1,14), pw3); \
    l_reg+=sacc; \
    if(GK){DMA_K((t)+3,sl_cur);} if(GV){DMA_V((t)+1,sl_next);} \
    CMASK(C0,C1,t); \
    { float a=MX3(C0[0],C0[1],C1[0]),b=MX3(C0[2],C0[3],C1[1]); a=MX3(a,C1[2],C1[3]); \
      _Pragma("unroll") for(int r=4;r<16;r+=4){a=MX3(a,C0[r],C0[r+1]);b=MX3(b,C0[r+2],C0[r+3]);a=MX3(a,C1[r],C1[r+1]);b=MX3(b,C1[r+2],C1[r+3]);} \
      float rm=__builtin_fmaxf(a,b); { auto rr=__builtin_amdgcn_permlane32_swap(__float_as_uint(rm),__float_as_uint(rm),false,false); rm=__builtin_fmaxf(__uint_as_float(rr[0]),__uint_as_float(rr[1])); } \
      resc=false; \
      if(__builtin_expect(__any(rm>(float)THRL),0)){ const float dl=__builtin_fmaxf(rm,0.f); mhat+=dl; \
        _Pragma("unroll") for(int r=0;r<16;++r){C0[r]-=dl;C1[r]-=dl;} \
        _Pragma("unroll") for(int r=0;r<16;++r)negm[r]=-mhat; asm volatile("":"+v"(negm)); \
        const float f=__builtin_amdgcn_exp2f(-dl); l_reg*=f; if(hi==0)wsf[r32]=f; resc=true; } } \
    SBAR(); \
    GAPB(o[0]=__builtin_amdgcn_mfma_f32_32x32x16_bf16(PAF(0),VFR(0),o[0],0,0,0), C0,0); \
    GAPB(o[1]=__builtin_amdgcn_mfma_f32_32x32x16_bf16(PAF(0),VFR(4),o[1],0,0,0), C0,4); \
    KRD(GL,0); GAPB(o[0]=__builtin_amdgcn_mfma_f32_32x32x16_bf16(PAF(1),VFR(1),o[0],0,0,0), C0,8); \
    KRD(GL,1); GAPB(o[1]=__builtin_amdgcn_mfma_f32_32x32x16_bf16(PAF(1),VFR(5),o[1],0,0,0), C0,12); \
    KRD(GL,2); GAPB(o[0]=__builtin_amdgcn_mfma_f32_32x32x16_bf16(PAF(2),VFR(2),o[0],0,0,0), C1,0); \
    KRD(GL,3); GAPB(o[1]=__builtin_amdgcn_mfma_f32_32x32x16_bf16(PAF(2),VFR(6),o[1],0,0,0), C1,4); \
    GAPB(o[0]=__builtin_amdgcn_mfma_f32_32x32x16_bf16(PAF(3),VFR(3),o[0],0,0,0), C1,8); \
    GAPB(o[1]=__builtin_amdgcn_mfma_f32_32x32x16_bf16(PAF(3),VFR(7),o[1],0,0,0), C1,12); \
    }while(0)
  int t=1;
  #undef CMASK
  #define CMASK(P0,P1,t) do{}while(0)
  for(;t+5<NT;t+=2){
    STEP(pB0,pB1,pA0,pA1,t,true,true,true);     WAIT_BAR(2); RESC(); ROT();
    STEP(pA0,pA1,pB0,pB1,t+1,true,true,true);   WAIT_BAR(2); RESC(); ROT();
  }
  #undef CMASK
  #define CMASK(P0,P1,t) do{}while(0)
  #define ENDW(tt) do{ if((tt)+3<NT){WAIT_BAR(2);} else if((tt)+2<NT){WAIT_BAR(1);} else {WAIT_BAR(0);} }while(0)
  for(;t+1<NT;t+=2){
    STEP(pB0,pB1,pA0,pA1,t,(t+3<NT),(t+1<NT),(t+1<NT));       ENDW(t);   RESC(); ROT();
    STEP(pA0,pA1,pB0,pB1,t+1,(t+4<NT),(t+2<NT),(t+2<NT));     ENDW(t+1); RESC(); ROT();
  }
  STEP(pB0,pB1,pA0,pA1,NT-1,false,false,false); RESC();
  { float sacc=pB0[0]+pB0[1]; _Pragma("unroll") for(int r=2;r<16;++r)sacc+=pB0[r]; _Pragma("unroll") for(int r=0;r<16;++r)sacc+=pB1[r]; l_reg+=sacc;
    pw0=(u32x4){PKW(pB0,0),PKW(pB0,2),PKW(pB0,4),PKW(pB0,6)};pw1=(u32x4){PKW(pB0,8),PKW(pB0,10),PKW(pB0,12),PKW(pB0,14)};pw2=(u32x4){PKW(pB1,0),PKW(pB1,2),PKW(pB1,4),PKW(pB1,6)};pw3=(u32x4){PKW(pB1,8),PKW(pB1,10),PKW(pB1,12),PKW(pB1,14)};
    SBAR(); pv(o,vb0+sl_cur,PAF(0),PAF(1),PAF(2),PAF(3)); }
  #undef PKW
  #undef PAF
  #undef VFR
  #undef PIN
  #undef MX3
  #undef GAPA
  #undef GAPB
  #undef EX
  #undef VRD
  #undef KRD
  #undef STEP
  #undef ENDW
  {auto rr=__builtin_amdgcn_permlane32_swap(__float_as_uint(l_reg),__float_as_uint(l_reg),false,false);l_reg=__uint_as_float(rr[0])+__uint_as_float(rr[1]);}
  if(hi==0)wsf[32+r32]=l_reg;asm volatile("s_waitcnt lgkmcnt(0)":::"memory");
  float rli[16];
  #pragma unroll
  for(int r=0;r<16;++r)rli[r]=__builtin_amdgcn_rcpf(wsf[32+crow(r,hi)]);
  bf16*Ow=O+(rowbase+q0+wid*QBLK)*DM+h*D;
  { bf16*stg=(bf16*)(shm+LDS_OST)+wid*2048;
    #pragma unroll
    for(int r=0;r<16;++r){const int orow=crow(r,hi);
      #pragma unroll
      for(int d0=0;d0<2;++d0)stg[orow*64+d0*32+r32]=__float2bfloat16(o[d0][r]*rli[r]);}
    asm volatile("s_waitcnt lgkmcnt(0)":::"memory");
    const bf16*Zw=Z+(rowbase+q0+wid*QBLK)*DM+h*D;
    #pragma unroll
    for(int i=0;i<4;++i){const int row=i*8+(lane>>3),ch=lane&7; u32x4 v=*(const u32x4*)(stg+row*64+ch*8); const u32x4 z=*(const u32x4*)(Zw+(long)row*DM+ch*8);
      _Pragma("unroll") for(int e=0;e<4;++e){ const float z0=__uint_as_float(z[e]<<16), z1=__uint_as_float(z[e]&0xffff0000u); const float v0=__uint_as_float(v[e]<<16), v1=__uint_as_float(v[e]&0xffff0000u);
        const float g0=z0*__builtin_amdgcn_rcpf(1.f+__expf(-z0)), g1=z1*__builtin_amdgcn_rcpf(1.f+__expf(-z1)); v[e]=cvtpk_s(v0*g0,v1*g1); }
      if(st_)ATTN_STORE16(Ow+(long)row*DM+ch*8,v);} }
  asm volatile("s_waitcnt lgkmcnt(0)\n\ts_barrier":::"memory");
  #undef DMA_K
  #undef DMA_V
  #undef CMASK
  #undef START
  #undef RESC
  #undef ROT
}
constexpr int ATTN_LDS_BYTES=LDS_BYTES;
struct AttnTensors { const bf16* Q; const bf16* K; const bf16* V; bf16* O; const bf16* Z; };
struct AttnUnit { int b; int h; int qb; };
template<int THRL=8> __device__ __forceinline__ void attn_phase(char*lds,const AttnTensors&T,int vcu,int G,const int wave_id,const bool st_){
  const int x=vcu>>5,c=vcu&31;
  #pragma unroll 1
  for(int i=0;i<6;++i){ const int pair=x*3+(i>>1),u=(i&1)*32+c; attn_unit<THRL>(pair>>1,(pair&1)*4+(u>>4),u&15,T.Q,T.K,T.V,T.O,T.Z,lds,wave_id,st_); }
}
#undef SBAR
#undef WAIT_BAR
}
constexpr int NWAVES = 8;
constexpr int DM_ = 1024, DEPTH = 4, SEQ_ = 4096, MTOT = 98304, MH = 49152, NPROMPT = 65536, PITCH = 5888, PLE = 256;
constexpr int C_QA = 0, C_KA = 512, C_VA = 640, C_ZA = 768, C_QB = 1280, C_KB = 2048, C_VB = 2816, C_ZB = 3584, C_GA = 3840, C_GB = 4864;
constexpr size_t MiB = 1u << 20;
constexpr size_t WS_SS = 0;
constexpr size_t WS_TAX = 4 * MiB;
constexpr size_t WS_T1D = 4 * MiB + 65536;
constexpr size_t WS_BAR = 6 * MiB, BAR_BYTES = 16384;
constexpr size_t WS_W = 8 * MiB;
constexpr size_t WL_IN = 0, WL_A = (size_t)5888 * 1024 * 2, WL_B = WL_A + 1 * MiB, WL_O = WL_B + MiB / 2, WL_PLE = WL_O + 2 * MiB, WL_PG = WL_PLE + MiB / 2, WL_STRIDE = WL_PG + 2 * MiB;
constexpr size_t WS_LSE = 80 * MiB;
constexpr size_t WS_OBG = 84 * MiB;
constexpr size_t WS_PB = 108 * MiB;
constexpr size_t WS_BUFA = 132 * MiB;
constexpr size_t WS_PROJ = 228 * MiB;
constexpr size_t WS_HG = 780 * MiB;
constexpr size_t WS_EB = 876 * MiB;
constexpr size_t WS_END = 972 * MiB;
static_assert(WS_W + 4 * WL_STRIDE <= WS_LSE, "weights");
constexpr int LDS_BYTES = 147456;
#define LAS __attribute__((address_space(3)))
typedef unsigned short bf16;
typedef unsigned v4u __attribute__((ext_vector_type(4)));
typedef float f32x4 __attribute__((ext_vector_type(4)));
typedef float f32x16 __attribute__((ext_vector_type(16)));
typedef short bf16x8 __attribute__((ext_vector_type(8)));
typedef short s16x4 __attribute__((ext_vector_type(4)));
typedef float f32x2 __attribute__((ext_vector_type(2)));
__device__ __forceinline__ unsigned f2bf(float f) { unsigned u = __builtin_bit_cast(unsigned, f); return (u + 0x7fffu + ((u >> 16) & 1u)) >> 16; }
__device__ __forceinline__ unsigned pk2(float lo, float hi) { return f2bf(lo) | (f2bf(hi) << 16); }
__device__ __forceinline__ float blo(unsigned w) { return __uint_as_float(w << 16); }
__device__ __forceinline__ float bhi(unsigned w) { return __uint_as_float(w & 0xffff0000u); }
__device__ __forceinline__ float wave_sum(float v, int lane) {
#pragma unroll
    for (int o = 1; o < 64; o <<= 1) v += shx(v, lane, o);
    return v;
}
constexpr float C2F = 0.125f * 1.4426950408889634f;

#ifndef PROBE_P1
#define PROBE_P1 0
#endif
#ifndef PROBE_AA
#define PROBE_AA 0
#endif
#ifndef PROBE_AB
#define PROBE_AB 0
#endif
#ifndef PROBE_P2
#define PROBE_P2 0
#endif
#ifndef PROBE_P4
#define PROBE_P4 0
#endif
#ifndef PROBE_P5
#define PROBE_P5 0
#endif
#ifndef PROBE_P6
#define PROBE_P6 0
#endif
#ifndef PROBE_P7
#define PROBE_P7 0
#endif
#ifndef PROBE_SYNC
#define PROBE_SYNC 0
#endif
#define GSYNC() do { xcd_barrier(xbar); if (PROBE_SYNC) xcd_barrier(xbar); } while (0)
struct Args { const float* in[15]; float* out; unsigned char* ws; };

template <bool HEADPERM> __device__ __forceinline__ void transpose_item(const float* W, int K, int N, bf16* WT, LAS float* scr, int item, int lane) {
    const int nblk = N / 32, kb = item / nblk, nb = item % nblk, k0 = 64 * kb, n0 = 32 * nb;
#pragma unroll 8
    for (int i = 0; i < 32; ++i) { const int kk = 2 * i + (lane >> 5); scr[kk * 33 + (lane & 31)] = W[(size_t)(k0 + kk) * N + n0 + (lane & 31)]; }
    asm volatile("s_waitcnt lgkmcnt(0)" ::: "memory");
    const int c = lane & 7;
#pragma unroll
    for (int j = 0; j < 4; ++j) { const int n = (lane >> 3) + 8 * j; const LAS float* s = scr + (8 * c) * 33 + n;
        v4u o; o.x = pk2(s[0 * 33], s[1 * 33]); o.y = pk2(s[2 * 33], s[3 * 33]); o.z = pk2(s[4 * 33], s[5 * 33]); o.w = pk2(s[6 * 33], s[7 * 33]);
        int nr = n0 + n; if (HEADPERM) { const int w_ = nr & 255; nr = (nr & ~255) + ((w_ >> 5) & 1) * 128 + (w_ >> 6) * 32 + (w_ & 31); }
        *(v4u*)(WT + (size_t)nr * K + k0 + 8 * c) = o; }
    asm volatile("s_waitcnt lgkmcnt(0)" ::: "memory");
}

__device__ __forceinline__ int crow(int r, int hi) { return (r & 3) + 8 * (r >> 2) + 4 * hi; }
__device__ __forceinline__ s16x4 vtr(const LAS char* p) { typedef short v4i16_t __attribute__((ext_vector_type(4))); return __builtin_bit_cast(s16x4, __builtin_amdgcn_ds_read_tr16_b64_v4i16((LAS v4i16_t*)p)); }
__device__ __forceinline__ unsigned cvtpk(float lo, float hi) { typedef __bf16 bf16x2_t __attribute__((ext_vector_type(2))); f32x2 v = {lo, hi}; bf16x2_t b = __builtin_convertvector(v, bf16x2_t); return __builtin_bit_cast(unsigned, b); }
__device__ __forceinline__ void attnb_unit(bf16* P, float* LSE, int b, int hb, int tau, LAS char* wl, int lane, const bool st_) {
    const int g = hb >> 2, sh = 2 * g, L = 4096 >> sh, tprs = 7 - sh;
    const int r = tau >> tprs, m0 = 32 * (tau & ((1 << tprs) - 1));
    const int r32 = lane & 31, hi = lane >> 5;
    const size_t rowbase = (size_t)b * 4096;
    const int tq = r + ((m0 + r32) << sh);
    bf16x8 qf[4];
    { const bf16* qp = P + (rowbase + tq) * PITCH + C_QB + hb * 64 + hi * 8;
#pragma unroll
      for (int d0 = 0; d0 < 4; ++d0) qf[d0] = *(const bf16x8*)(qp + d0 * 16); }
    f32x16 S[5];
#pragma unroll
    for (int kb = 0; kb < 5; ++kb) {
        int mk = m0 - 64 + 32 * kb + r32; mk = mk < 0 ? 0 : (mk > L - 1 ? L - 1 : mk);
        const bf16* kp = P + (rowbase + r + (mk << sh)) * PITCH + C_KB + hb * 64 + hi * 8;
        bf16x8 kf[4];
#pragma unroll
        for (int d0 = 0; d0 < 4; ++d0) kf[d0] = *(const bf16x8*)(kp + d0 * 16);
        f32x16 s = {};
#pragma unroll
        for (int d0 = 0; d0 < 4; ++d0) s = __builtin_amdgcn_mfma_f32_32x32x16_bf16(kf[d0], qf[d0], s, 0, 0, 0);
        S[kb] = s;
    }
    v4u vreg[5][4];
#pragma unroll
    for (int kb = 0; kb < 5; ++kb)
#pragma unroll
        for (int j = 0; j < 4; ++j) { const int idx = lane + 64 * j, key = idx >> 3, c = idx & 7;
            int mk = m0 - 64 + 32 * kb + key; mk = mk < 0 ? 0 : (mk > L - 1 ? L - 1 : mk);
            vreg[kb][j] = *(const v4u*)(P + (rowbase + r + (mk << sh)) * PITCH + C_VB + hb * 64 + c * 8); }
    const int mq = m0 + r32; float mx = -INFINITY;
#pragma unroll
    for (int kb = 0; kb < 5; ++kb)
#pragma unroll
        for (int q = 0; q < 16; ++q) { const int mk = m0 - 64 + 32 * kb + crow(q, hi); const int dd = mk - mq; const bool ok = (mk >= 0) && (mk < L) && (dd <= 64) && (dd >= -64);
            const float v = ok ? S[kb][q] : -INFINITY; S[kb][q] = v; mx = fmaxf(mx, v); }
    mx = fmaxf(mx, shx(mx, lane, 32));
    float l = 0.f;
#pragma unroll
    for (int kb = 0; kb < 5; ++kb)
#pragma unroll
        for (int q = 0; q < 16; ++q) { const float p = __builtin_amdgcn_exp2f(S[kb][q] - mx); S[kb][q] = p; l += p; }
    l += shx(l, lane, 32);
    f32x16 o0 = {}, o1 = {};
    const LAS char* vrd = wl + ((lane >> 4) & 1) * 32 + (lane & 3) * 8 + (4 * hi + ((lane & 15) >> 2)) * 64;
#pragma unroll
    for (int kb = 0; kb < 5; ++kb) {
        asm volatile("" ::: "memory");
#pragma unroll
        for (int j = 0; j < 4; ++j) { const int idx = lane + 64 * j, key = idx >> 3, c = idx & 7;
            *(LAS v4u*)(wl + (c >> 2) * 2048 + (key >> 3) * 512 + (key & 7) * 64 + (c & 3) * 16) = vreg[kb][j]; }
        asm volatile("s_waitcnt lgkmcnt(0)" ::: "memory");
#pragma unroll
        for (int s = 0; s < 2; ++s) {
            v4u pw; pw.x = cvtpk(S[kb][8 * s + 0], S[kb][8 * s + 1]); pw.y = cvtpk(S[kb][8 * s + 2], S[kb][8 * s + 3]); pw.z = cvtpk(S[kb][8 * s + 4], S[kb][8 * s + 5]); pw.w = cvtpk(S[kb][8 * s + 6], S[kb][8 * s + 7]);
            const bf16x8 pa = __builtin_bit_cast(bf16x8, pw);
            { const s16x4 lo = vtr(vrd + (2 * s) * 512), hh = vtr(vrd + (2 * s + 1) * 512);
              const bf16x8 vf = (bf16x8){lo[0], lo[1], lo[2], lo[3], hh[0], hh[1], hh[2], hh[3]};
              o0 = __builtin_amdgcn_mfma_f32_32x32x16_bf16(pa, vf, o0, 0, 0, 0); }
            { const s16x4 lo = vtr(vrd + 2048 + (2 * s) * 512), hh = vtr(vrd + 2048 + (2 * s + 1) * 512);
              const bf16x8 vf = (bf16x8){lo[0], lo[1], lo[2], lo[3], hh[0], hh[1], hh[2], hh[3]};
              o1 = __builtin_amdgcn_mfma_f32_32x32x16_bf16(pa, vf, o1, 0, 0, 0); }
        }
        asm volatile("s_waitcnt lgkmcnt(0)" ::: "memory");
    }
    LAS float* wsf = (LAS float*)(wl + 4096);
    if (hi == 0) { wsf[r32] = l; if (st_) LSE[(rowbase + tq) * 12 + hb] = mx + __builtin_amdgcn_logf(l); }
    asm volatile("s_waitcnt lgkmcnt(0)" ::: "memory");
    LAS bf16* stg = (LAS bf16*)wl;
#pragma unroll
    for (int q = 0; q < 16; ++q) { const int orow = crow(q, hi); const float rl = __builtin_amdgcn_rcpf(wsf[orow]);
        stg[orow * 64 + r32] = (bf16)f2bf(o0[q] * rl); stg[orow * 64 + 32 + r32] = (bf16)f2bf(o1[q] * rl); }
    asm volatile("s_waitcnt lgkmcnt(0)" ::: "memory");
#pragma unroll
    for (int i = 0; i < 4; ++i) { const int row = i * 8 + (lane >> 3), ch = lane & 7; const v4u v = *(const LAS v4u*)(wl + row * 128 + ch * 16);
        if (st_) *(v4u*)(P + (rowbase + r + ((m0 + row) << sh)) * PITCH + C_QB + hb * 64 + ch * 8) = v; }
    asm volatile("s_waitcnt lgkmcnt(0)" ::: "memory");
}

#define XB_TMO      128
#define XB_XCNT(j)  (256  + 64 * (j))
#define XB_XSUB(j)  (1280 + 64 * (j))
#define XB_XGEN(j)  (2304 + 64 * (j))
#define XB_TOP      3328
#define XB_TOPGEN   3392
#define XCD_BAR_WORDS 3456
#define XB_SPIN_CAP (1u << 18)

__device__ __forceinline__ unsigned xb_ld(unsigned* p)              { return __hip_atomic_load(p, __ATOMIC_RELAXED, __HIP_MEMORY_SCOPE_AGENT); }
__device__ __forceinline__ unsigned xb_add(unsigned* p, unsigned v) { return __hip_atomic_fetch_add(p, v, __ATOMIC_RELAXED, __HIP_MEMORY_SCOPE_AGENT); }
__device__ __forceinline__ unsigned xb_xcc_id() { return (unsigned)__builtin_amdgcn_s_getreg((3 << 11) | 20) & 0xFu; }
#define XB_SPIN(cond, bar) do { unsigned _sp = 0; while (cond) { __builtin_amdgcn_s_sleep(1); \
    if ((++_sp & 255u) == 0u) { if (xb_ld(&(bar)[XB_TMO])) break; if (_sp > XB_SPIN_CAP) { atomicAdd(&(bar)[XB_TMO], 1u); break; } } } } while (0)

struct XcdBarrier {
    unsigned* bar; unsigned x;
    volatile LAS unsigned* st;
};

__device__ __forceinline__ XcdBarrier xcd_barrier_post(unsigned* bar, volatile LAS unsigned* st) {
    XcdBarrier b; b.bar = bar; b.x = xb_xcc_id(); b.st = st;
    if (threadIdx.x == 0) (void)xb_add(&bar[XB_XCNT(b.x)], 1u);
    return b;
}
__device__ __forceinline__ void xcd_barrier_complete(unsigned* bar, unsigned x, unsigned& nloc, unsigned& nx) {
    const unsigned G = gridDim.x * gridDim.y * gridDim.z;
    unsigned sum, cnt, mine, sp = 0u;
    for (;;) {
        sum = 0u; cnt = 0u; mine = 0u;
#pragma unroll
        for (unsigned j = 0; j < 16; ++j) { const unsigned c = xb_ld(&bar[XB_XCNT(j)]); sum += c; cnt += (c > 0u) ? 1u : 0u; mine = (j == x) ? c : mine; }
        if (sum == G) break;
        __builtin_amdgcn_s_sleep(1);
        if ((++sp & 255u) == 0u) { if (xb_ld(&bar[XB_TMO])) break; if (sp > XB_SPIN_CAP) { atomicAdd(&bar[XB_TMO], 1u); break; } }
    }
    nloc = mine > 0u ? mine : 1u; nx = cnt > 0u ? cnt : 1u;
}

__device__ __forceinline__ void xcd_barrier(const XcdBarrier& b) {
    asm volatile("s_waitcnt vmcnt(0)" ::: "memory");
    __syncthreads();
    if (threadIdx.x == 0) {
        unsigned* bar = b.bar;
        __builtin_amdgcn_s_waitcnt(0);
        unsigned nloc = b.st[0], nx = b.st[1];
        if (nloc == 0u) { xcd_barrier_complete(bar, b.x, nloc, nx); b.st[0] = nloc; b.st[1] = nx; }
        const unsigned old = xb_add(&bar[XB_XSUB(b.x)], 1u);
        const unsigned gen = old / nloc;
        if (old + 1u == (gen + 1u) * nloc) {
            __builtin_amdgcn_fence(__ATOMIC_RELEASE, "agent");
            asm volatile("s_waitcnt vmcnt(0)" ::: "memory");
            const unsigned og = xb_add(&bar[XB_TOP], 1u);
            const unsigned tg = og / nx;
            if (og + 1u == (tg + 1u) * nx) xb_add(&bar[XB_TOPGEN], 1u);
            else XB_SPIN(xb_ld(&bar[XB_TOPGEN]) == tg, bar);
            __builtin_amdgcn_fence(__ATOMIC_ACQUIRE, "agent");
            xb_add(&bar[XB_XGEN(b.x)], 1u);
            asm volatile("s_waitcnt vmcnt(0)" ::: "memory");
        } else {
            XB_SPIN(xb_ld(&bar[XB_XGEN(b.x)]) == gen, bar);
            __builtin_amdgcn_fence(__ATOMIC_ACQUIRE, "agent");
            asm volatile("s_waitcnt vmcnt(0)" ::: "memory");
        }
    }
    __syncthreads();
}

__global__ void __launch_bounds__(NWAVES * 64, 2) fwd_mega(Args args) {
    extern __shared__ __attribute__((aligned(16))) unsigned char lds[];
    cg::grid_group grid = cg::this_grid();
    LAS unsigned char* ldsl = (LAS unsigned char*)lds;
    const int wave = __builtin_amdgcn_readfirstlane(threadIdx.x >> 6); int tidv = wave * 64 + lane_now();
#define LAUNDER() do { tidv = wave * 64 + lane_now(); asm volatile("" : "+s"(bxv)); } while (0)
#define lane (tidv & 63)
#define gt (bx * (NWAVES * 64) + tidv)
    const int G = gridDim.x; int bxv = blockIdx.x; asm volatile("" : "+s"(bxv));
#define bx bxv
#define vcu ((bxv % 8) * (G / 8) + bxv / 8)
#define gw (vcu * NWAVES + wave)
    const int NGW = G * NWAVES;
    const int NGT = G * NWAVES * 64;
    unsigned char* ws = args.ws;
    const float* x_prompt = args.in[0]; const float* x_sample = args.in[1]; const float* p_prompt = args.in[2]; const float* p_sample = args.in[3];
    const float* g_norm = args.in[4]; const float* w_in = args.in[5]; const float* g_q = args.in[6]; const float* g_k = args.in[7];
    const float* w_a = args.in[8]; const float* w_b = args.in[9]; const float* w_o = args.in[10]; const float* w_ple = args.in[11];
    const float* g_ple = args.in[12]; const float* w_pg = args.in[13]; const float* g_final = args.in[14];
    float* H = args.out;
    const bool never = (args.ws == nullptr);
    float* SS = (float*)(ws + WS_SS);
    f32x2* TAX = (f32x2*)(ws + WS_TAX); f32x2* T1D = (f32x2*)(ws + WS_T1D);
    float* LSE = (float*)(ws + WS_LSE);
    bf16* OBG = (bf16*)(ws + WS_OBG); bf16* PB = (bf16*)(ws + WS_PB); bf16* BUFA = (bf16*)(ws + WS_BUFA); bf16* PROJ = (bf16*)(ws + WS_PROJ);
    bf16* HG = (bf16*)(ws + WS_HG); bf16* EB = (bf16*)(ws + WS_EB);

    volatile LAS unsigned* bst = (volatile LAS unsigned*)(ldsl + 143360);
    if (threadIdx.x < 2) bst[threadIdx.x] = 0u;
    __syncthreads();
    XcdBarrier xbar = xcd_barrier_post((unsigned*)(ws + WS_BAR), bst);
    for (int i = gt + MTOT / 4; i < 9 * MTOT / 4; i += NGT) ((f32x4*)SS)[i] = (f32x4){0.f, 0.f, 0.f, 0.f};
    for (int i = gt; i < 64 * 16 + 4096 * 32; i += NGT) {
        int pos, k; float ex; f32x2* dst;
        if (i < 1024) { pos = i >> 4; k = i & 15; ex = (float)(2 * k) / 32.f; dst = TAX + i; }
        else { const int j = i - 1024; pos = j >> 5; k = j & 31; ex = (float)(2 * k) / 64.f; dst = T1D + j; }
        const float freq = exp2f(-ex * 13.287712379549449f);
        double rev = (double)pos * (double)freq * 0.15915494309189535; rev -= floor(rev);
        const float rf = (float)rev;
        *dst = (f32x2){__builtin_amdgcn_cosf(rf), __builtin_amdgcn_sinf(rf)};
    }
    {
        LAS float* scr = (LAS float*)(ldsl + wave * 16384);
        constexpr int I_IN = 16 * 184, I_A = 8 * 32, I_B = 4 * 32, I_O = 16 * 32, I_PLE = 4 * 32, I_PG = 16 * 32, I_L = I_IN + I_A + I_B + I_O + I_PLE + I_PG;
        for (int it = gw; it < DEPTH * I_L; it += NGW) {
            const int layer = it / I_L; int r = it % I_L; unsigned char* wl = ws + WS_W + (size_t)layer * WL_STRIDE;
            if (r < I_IN) { transpose_item<true>(w_in + (size_t)layer * 1024 * 5888, 1024, 5888, (bf16*)(wl + WL_IN), scr, r, lane); continue; } r -= I_IN;
            if (r < I_A) { transpose_item<false>(w_a + (size_t)layer * 512 * 1024, 512, 1024, (bf16*)(wl + WL_A), scr, r, lane); continue; } r -= I_A;
            if (r < I_B) { transpose_item<false>(w_b + (size_t)layer * 256 * 1024, 256, 1024, (bf16*)(wl + WL_B), scr, r, lane); continue; } r -= I_B;
            if (r < I_O) { transpose_item<false>(w_o + (size_t)layer * 1024 * 1024, 1024, 1024, (bf16*)(wl + WL_O), scr, r, lane); continue; } r -= I_O;
            if (r < I_PLE) { transpose_item<false>(w_ple + (size_t)layer * 256 * 1024, 256, 1024, (bf16*)(wl + WL_PLE), scr, r, lane); continue; } r -= I_PLE;
            transpose_item<false>(w_pg + (size_t)layer * 1024 * 1024, 1024, 1024, (bf16*)(wl + WL_PG), scr, r, lane);
        }
    }

#pragma unroll 1
    for (int half = 0; half < 2; ++half) {
        const int grow0 = half * MH;
            LAUNDER();
        for (int lr0 = gw; lr0 < MH; lr0 += 2 * NGW) {
            f32x4 v[2][4]; const f32x4* xr[2];
#pragma unroll
            for (int k = 0; k < 2; ++k) { const int lr = lr0 + k * NGW < MH ? lr0 + k * NGW : lr0; const int gr = grow0 + lr;
                xr[k] = (const f32x4*)(gr < NPROMPT ? x_prompt + (size_t)gr * 1024 : x_sample + (size_t)(gr - NPROMPT) * 1024); }
#pragma unroll
            for (int k = 0; k < 2; ++k)
#pragma unroll
                for (int j = 0; j < 4; ++j) v[k][j] = __builtin_nontemporal_load(xr[k] + lane + 64 * j);
#pragma unroll
            for (int k = 0; k < 2; ++k) { const int lr = lr0 + k * NGW; if (lr < MH) { const int gr = grow0 + lr; float s = 0.f;
#pragma unroll
                for (int j = 0; j < 4; ++j) s += (v[k][j].x * v[k][j].x + v[k][j].y * v[k][j].y) + (v[k][j].z * v[k][j].z + v[k][j].w * v[k][j].w);
                s = wave_sum(s, lane); if (lane == 0) SS[gr] = s;
#pragma unroll
                for (int j = 0; j < 4; ++j) { ((f32x4*)(H + (size_t)gr * 1024))[lane + 64 * j] = v[k][j]; const f32x4 gg = ((const f32x4*)g_norm)[lane + 64 * j];
                    ((unsigned long long*)(BUFA + (size_t)lr * 1024))[lane + 64 * j] = (unsigned long long)pk2(v[k][j].x * gg.x, v[k][j].y * gg.y) | ((unsigned long long)pk2(v[k][j].z * gg.z, v[k][j].w * gg.w) << 32); } } }
        }
        if (half == 0) grid.sync(); else GSYNC();
#pragma unroll 1
        for (int layer = 0; layer < DEPTH; ++layer) {
            unsigned char* wl = ws + WS_W + (size_t)layer * WL_STRIDE;
            LAUNDER();
            { pg8::Gemm g{BUFA, (const bf16*)(wl + WL_IN), MH, PITCH, 1024, 1024}; pg8::StaticOrder S; S.init(MH, PITCH, G, bx);
              pg8::EpiProj E{PROJ, PITCH, SS + (size_t)layer * MTOT, grow0, g_q + layer * 64, g_k + layer * 64, (const pg8::f32x2e*)TAX, (const pg8::f32x2e*)T1D};
              for (int rep_ = 0; rep_ < 1 + PROBE_P1; ++rep_) { LAUNDER(); pg8::gemm_phase<pg8::EpiProj, pg8::StaticOrder, true, true>(ldsl, g, S, E, wave); } }
            GSYNC();
            LAUNDER();
            { const attn_body::AttnTensors AT{(const attn_body::bf16*)(PROJ + C_QA), (const attn_body::bf16*)(PROJ + C_KA), (const attn_body::bf16*)(PROJ + C_VA), (attn_body::bf16*)(PROJ + C_QA), (const attn_body::bf16*)(PROJ + C_ZA)};
              for (int rep_ = PROBE_AA ? 0 : 1; rep_ < 2; ++rep_) { LAUNDER(); attn_body::attn_phase<8>((char*)lds, AT, vcu, G, wave, rep_ == 1 || never); } }
            __syncthreads();
            LAUNDER();
            { LAS char* wlds = (LAS char*)(ldsl + wave * 8448);
              for (int rep_ = PROBE_AB ? 0 : 1; rep_ < 2; ++rep_) { LAUNDER();
              const int xw = (vcu & 31) * 8 + wave, xq = vcu >> 5;
#pragma unroll 1
              for (int i = 0; i < 9; ++i) { const int pair = xq * 18 + i * 2 + (xw >> 7); const int b = pair / 12, hb = pair - b * 12; attnb_unit(PROJ, LSE, b, hb, xw & 127, wlds, lane, rep_ == 1 || never); } } }
            GSYNC();
            LAUNDER();
            for (int rep_ = 0; rep_ < 1 + PROBE_P4; ++rep_) { LAUNDER();
            for (int it0 = gt; it0 < MH * 32; it0 += 4 * NGT) {
                v4u a[4], bq[4], cq[4], z[4]; float l0[4], l1[4], l2[4];
#pragma unroll
                for (int k = 0; k < 4; ++k) { const int it = it0 + k * NGT < MH * 32 ? it0 + k * NGT : it0; const int lr = it >> 5, cc = it & 31, hh = cc >> 3, c = cc & 7;
                    const bf16* rp = PROJ + (size_t)lr * PITCH;
                    a[k] = *(const v4u*)(rp + C_QB + hh * 64 + c * 8); bq[k] = *(const v4u*)(rp + C_QB + (4 + hh) * 64 + c * 8); cq[k] = *(const v4u*)(rp + C_QB + (8 + hh) * 64 + c * 8); z[k] = *(const v4u*)(rp + C_ZB + hh * 64 + c * 8);
                    l0[k] = LSE[(size_t)lr * 12 + hh]; l1[k] = LSE[(size_t)lr * 12 + 4 + hh]; l2[k] = LSE[(size_t)lr * 12 + 8 + hh]; }
#pragma unroll
                for (int k = 0; k < 4; ++k) { const int it = it0 + k * NGT; if (it < MH * 32) { const int lr = it >> 5, cc = it & 31;
                    const float mx = fmaxf(l0[k], fmaxf(l1[k], l2[k])); float w0 = __builtin_amdgcn_exp2f(l0[k] - mx), w1 = __builtin_amdgcn_exp2f(l1[k] - mx), w2 = __builtin_amdgcn_exp2f(l2[k] - mx);
                    const float inv = __builtin_amdgcn_rcpf(w0 + w1 + w2); w0 *= inv; w1 *= inv; w2 *= inv;
                    v4u o;
#pragma unroll
                    for (int e = 0; e < 4; ++e) { const float z0 = blo(z[k][e]), z1 = bhi(z[k][e]);
                        const float s0 = z0 * __builtin_amdgcn_rcpf(1.f + __expf(-z0)), s1 = z1 * __builtin_amdgcn_rcpf(1.f + __expf(-z1));
                        o[e] = pk2((w0 * blo(a[k][e]) + w1 * blo(bq[k][e]) + w2 * blo(cq[k][e])) * s0, (w0 * bhi(a[k][e]) + w1 * bhi(bq[k][e]) + w2 * bhi(cq[k][e])) * s1); }
                    *(v4u*)(OBG + (size_t)lr * 256 + cc * 8) = o; } }
            } }
            LAUNDER();
            for (int it0 = gt; it0 < MH * 32; it0 += 4 * NGT) {
                f32x4 a[4], bq[4];
#pragma unroll
                for (int k = 0; k < 4; ++k) { const int it = it0 + k * NGT < MH * 32 ? it0 + k * NGT : it0; const int lr = it >> 5, c = it & 31, gr = grow0 + lr;
                    const float* pr = gr < NPROMPT ? p_prompt + ((size_t)layer * NPROMPT + gr) * PLE : p_sample + ((size_t)layer * (MTOT - NPROMPT) + (gr - NPROMPT)) * PLE;
                    a[k] = __builtin_nontemporal_load((const f32x4*)pr + 2 * c); bq[k] = __builtin_nontemporal_load((const f32x4*)pr + 2 * c + 1); }
#pragma unroll
                for (int k = 0; k < 4; ++k) { const int it = it0 + k * NGT; if (it < MH * 32) { const int lr = it >> 5, c = it & 31;
                    v4u o; o.x = pk2(a[k].x, a[k].y); o.y = pk2(a[k].z, a[k].w); o.z = pk2(bq[k].x, bq[k].y); o.w = pk2(bq[k].z, bq[k].w); *(v4u*)(PB + (size_t)lr * PLE + c * 8) = o; } }
            }
            GSYNC();
            LAUNDER();
            for (int rep_ = 0; rep_ < 1 + PROBE_P5; ++rep_) {
            LAUNDER();
            { pg8::Gemm g{PROJ + C_QA, (const bf16*)(wl + WL_A), MH, 1024, 512, PITCH}; pg8::StaticOrder S; S.init(MH, 1024, G, bx);
              pg8::EpiGate<false> E{BUFA, 1024, PROJ + C_GA, PITCH};
              pg8::gemm_phase<pg8::EpiGate<false>, pg8::StaticOrder, true, true>(ldsl, g, S, E, wave); }
            LAUNDER();
            { pg8::Gemm g{OBG, (const bf16*)(wl + WL_B), MH, 1024, 256, 256}; pg8::StaticOrder S; S.init(MH, 1024, G, bx);
              pg8::EpiGate<true> E{BUFA, 1024, PROJ + C_GB, PITCH};
              pg8::gemm_phase<pg8::EpiGate<true>, pg8::StaticOrder, true, true>(ldsl, g, S, E, wave); } }
            GSYNC();
            LAUNDER();
            for (int rep_ = PROBE_P6 ? 0 : 1; rep_ < 2; ++rep_) {
            LAUNDER();
            { pg8::Gemm g{BUFA, (const bf16*)(wl + WL_O), MH, 1024, 1024, 1024}; pg8::StaticOrder S; S.init(MH, 1024, G, bx);
              pg8::EpiResid<false> E{H, nullptr, SS + (size_t)(5 + layer) * MTOT, nullptr, HG, g_ple + layer * 1024, grow0, rep_ == 1 || never};
              pg8::gemm_phase<pg8::EpiResid<false>, pg8::StaticOrder, true, true>(ldsl, g, S, E, wave); }
            LAUNDER();
            { pg8::Gemm g{PB, (const bf16*)(wl + WL_PLE), MH, 1024, 256, 256}; pg8::StaticOrder S; S.init(MH, 1024, G, bx);
              pg8::EpiPlain E{EB, 1024};
              pg8::gemm_phase<pg8::EpiPlain, pg8::StaticOrder, true, true>(ldsl, g, S, E, wave); } }
            GSYNC();
            LAUNDER();
            for (int rep_ = PROBE_P7 ? 0 : 1; rep_ < 2; ++rep_) {
            LAUNDER();
            { pg8::Gemm g{HG, (const bf16*)(wl + WL_PG), MH, 1024, 1024, 1024}; pg8::StaticOrder S; S.init(MH, 1024, G, bx);
              pg8::EpiResid<true> E{H, SS + (size_t)(5 + layer) * MTOT, SS + (size_t)(layer + 1) * MTOT, EB, layer < DEPTH - 1 ? BUFA : nullptr, g_norm + (layer < DEPTH - 1 ? layer + 1 : 0) * 1024, grow0, rep_ == 1 || never};
              pg8::gemm_phase<pg8::EpiResid<true>, pg8::StaticOrder, true, true>(ldsl, g, S, E, wave); } }
            GSYNC();
        }
    }
            LAUNDER();
    for (int gr0 = gw; gr0 < MTOT; gr0 += 4 * NGW) {
        f32x4 v[4][4]; float rs[4];
#pragma unroll
        for (int k = 0; k < 4; ++k) { const int gr = gr0 + k * NGW < MTOT ? gr0 + k * NGW : gr0; rs[k] = SS[(size_t)4 * MTOT + gr];
#pragma unroll
            for (int j = 0; j < 4; ++j) v[k][j] = ((const f32x4*)(H + (size_t)gr * 1024))[lane + 64 * j]; }
#pragma unroll
        for (int k = 0; k < 4; ++k) { const int gr = gr0 + k * NGW; if (gr < MTOT) { const float r_ = __builtin_amdgcn_rsqf(rs[k] * (1.f / 1024.f) + 1e-6f);
#pragma unroll
            for (int j = 0; j < 4; ++j) { const f32x4 gg = ((const f32x4*)g_final)[lane + 64 * j]; __builtin_nontemporal_store(v[k][j] * gg * r_, (f32x4*)(H + (size_t)gr * 1024) + lane + 64 * j); } } }
    }
}

#undef lane
#undef gt
#undef bx
#undef vcu
#undef gw
extern "C" void kernel_launch(void* const* d_in, const int* in_sizes, int n_in, void* d_out, int out_size, void* d_ws, size_t ws_size, hipStream_t stream) {
    static int grid = 0;
    if (grid == 0) {
        if (n_in != 15 || out_size != MTOT * DM_ || ws_size < WS_END) { fprintf(stderr, "kernel_launch: unexpected shapes (n_in %d out %d ws %zu)\n", n_in, out_size, ws_size); grid = -1; return; }
        int dev = 0, cus = 0, per_cu = 0;
        (void)hipGetDevice(&dev); (void)hipDeviceGetAttribute(&cus, hipDeviceAttributeMultiprocessorCount, dev);
        (void)hipFuncSetAttribute((const void*)fwd_mega, hipFuncAttributeMaxDynamicSharedMemorySize, LDS_BYTES);
        (void)hipOccupancyMaxActiveBlocksPerMultiprocessor(&per_cu, (const void*)fwd_mega, NWAVES * 64, LDS_BYTES);
        if (per_cu < 1) per_cu = 1;
        grid = cus * per_cu;
        (void)hipGetLastError();
    }
    if (grid < 0) return;
    (void)hipMemsetAsync((char*)d_ws + WS_BAR, 0, BAR_BYTES, stream);
    Args a{};
    for (int i = 0; i < 15; ++i) a.in[i] = (const float*)d_in[i];
    a.out = (float*)d_out; a.ws = (unsigned char*)d_ws;
    void* kargs[] = {&a};
    hipError_t e = hipLaunchCooperativeKernel((const void*)fwd_mega, dim3(grid), dim3(NWAVES * 64), kargs, LDS_BYTES, stream);
    if (e != hipSuccess) fprintf(stderr, "cooperative launch failed: %s (grid %d)\n", hipGetErrorString(e), grid);
}
```

```cpp
#include <hip/hip_runtime.h>
#include <hip/hip_cooperative_groups.h>
namespace cg = cooperative_groups;
__device__ __forceinline__ float shx(float v, int lane, int m) { return __builtin_bit_cast(float, __builtin_amdgcn_ds_bpermute((lane ^ m) << 2, __builtin_bit_cast(int, v))); }
__device__ __forceinline__ int lane_now() { int l; asm volatile("v_mbcnt_lo_u32_b32 %0, -1, 0\n\tv_mbcnt_hi_u32_b32 %0, -1, %0" : "=v"(l)); return l; }
#include <hip/hip_runtime.h>
#include <cstdio>
#include <cstdint>
namespace pg8 {
#define PG8_LAS __attribute__((address_space(3)))
typedef unsigned short bf16_t;
typedef short bf16x8 __attribute__((ext_vector_type(8)));
typedef float f32x4 __attribute__((ext_vector_type(4)));
typedef unsigned u32x4 __attribute__((ext_vector_type(4)));
constexpr int BM = 256, BK = 64, HALF = 128, HTB = HALF * BK * 2  , STAGE_BYTES = 8 * HTB, NXCD = 8, WGM = 4;

__host__ __device__ __forceinline__ int lds_byte(int r, int c) { const int st = (r >> 4) * 2 + (c >> 5), rr = r & 15, cc = c & 31, ob = rr * 64 + cc * 2; return st * 1024 + (ob ^ (((ob >> 9) & 1) << 5)); }
__host__ __device__ __forceinline__ void stage_rc(int b, int& R, int& C) { const int st = b / 1024, sb = b % 1024, swz = sb ^ (((sb >> 9) & 1) << 5); R = (st >> 1) * 16 + swz / 64; C = (st & 1) * 32 + (swz % 64) / 2; }
__host__ __device__ __forceinline__ int perm32(int rho) { const int n = rho >> 4, i = rho & 15; return 8 * (i >> 2) + 4 * n + (i & 3); }

struct Unit { int pm, pn; };
struct Gemm { const bf16_t* A; const bf16_t* Bt; int M, N, K, lda; };

struct StaticOrder {
    int nM, nN, nwg, G, c, cnt; bool rev;
    __host__ __device__ void init(int M, int N, int G_, int c_, bool rev_ = false) { nM = M / BM; nN = N / BM; nwg = nM * nN; G = G_; c = c_; rev = rev_; cnt = c < nwg ? (nwg - c + G - 1) / G : 0; }
    __host__ __device__ bool next(int i, Unit& u) const {
        if (i >= cnt) return false; const long L = (long)(rev ? cnt - 1 - i : i) * G + c;
        int wgid = (int)L; { const int q = nwg / NXCD, r = nwg % NXCD, xcd = wgid % NXCD, off = wgid / NXCD; wgid = (xcd < r ? xcd * (q + 1) : r * (q + 1) + (xcd - r) * q) + off; }
        const int nig = WGM * nN, gid = wgid / nig, fm = gid * WGM, gsz = (nM - fm) < WGM ? (nM - fm) : WGM;
        u.pm = fm + ((wgid % nig) % gsz); u.pn = (wgid % nig) / gsz; return true;
    }
    __device__ __forceinline__ void a_ready(const Unit&) const {}
    __device__ __forceinline__ void done(const Unit&) const {}
};

template <class Epi, class Sched, bool ALIGN_EPI = false, bool SP2 = false>
__device__ __forceinline__ void gemm_phase(PG8_LAS unsigned char* lds, const Gemm g, const Sched& S, const Epi& E, const int wave_id) {
    const int tid = wave_id * 64 + lane_now(), wid = wave_id, lane = tid & 63, wr = wid >> 2, wc = wid & 3, fr = lane & 15, fq = lane >> 4;
    const int K = g.K, nt = K / BK;
    unsigned voffA[2], voffB[2];
#pragma unroll
    for (int i = 0; i < 2; ++i) { int R, C; stage_rc(tid * 16 + i * 8192, R, C); const int Rb = Epi::PERM ? ((R & ~31) + perm32(R & 31)) : R;
        voffA[i] = (unsigned)(R * g.lda + C) * 2u; voffB[i] = (unsigned)(Rb * K + C) * 2u; }
    const size_t kstep = (size_t)(BK * 2);
    const size_t hstep = (size_t)HALF * K * 2;
    const size_t tstep = 2 * hstep; const size_t hstepA = (size_t)HALF * g.lda * 2, tstepA = 2 * hstepA;
    const unsigned ldsw = (unsigned)wid * 1024u;
    const int aoff = lds_byte(wr * 64 + fr, fq * 8), boff = lds_byte(wc * 32 + fr, fq * 8);
#define PG8_SA(b, h) (((b) * 2 + (h)) * HTB)
#define PG8_SB(b, h) ((4 + (b) * 2 + (h)) * HTB)
#define PG8_STAGE(bufoff, gbase, voff) do { _Pragma("unroll") for (int _i = 0; _i < 2; ++_i) \
        __builtin_amdgcn_global_load_lds((const unsigned*)((const char*)(gbase) + (voff)[_i]), (PG8_LAS unsigned*)(lds + (bufoff) + ldsw + _i * 8192), 16, 0, 0); } while (0)
#define PG8_LDA(dst, b, h) do { _Pragma("unroll") for (int m = 0; m < 4; ++m) _Pragma("unroll") for (int k = 0; k < 2; ++k) dst[m][k] = *(const PG8_LAS bf16x8*)(lds + PG8_SA(b, h) + aoff + m * 2048 + k * 1024); } while (0)
#define PG8_LDB(dst, b, h) do { _Pragma("unroll") for (int n = 0; n < 2; ++n) _Pragma("unroll") for (int k = 0; k < 2; ++k) dst[n][k] = *(const PG8_LAS bf16x8*)(lds + PG8_SB(b, h) + boff + n * 2048 + k * 1024); } while (0)
#define PG8_MMA(ai, bj, At, Bt) do { __builtin_amdgcn_s_setprio(1); _Pragma("unroll") for (int m = 0; m < 4; ++m) _Pragma("unroll") for (int n = 0; n < 2; ++n) _Pragma("unroll") for (int k = 0; k < 2; ++k) \
        acc[ai][bj][m][n] = __builtin_amdgcn_mfma_f32_16x16x32_bf16(Bt[n][k], At[m][k], acc[ai][bj][m][n], 0, 0, 0); __builtin_amdgcn_s_setprio(0); } while (0)
#define PG8_WAIT_V(n) asm volatile("s_waitcnt vmcnt(" #n ")" ::: "memory")
#define PG8_WAIT_L(n) asm volatile("s_waitcnt lgkmcnt(" #n ")" ::: "memory")
#define PG8_BAR __builtin_amdgcn_s_barrier()
#define PG8_SCHED __builtin_amdgcn_sched_barrier(0)
    Unit cur, nxt; int ui = 0;
    if (!S.next(0, cur)) return;
    f32x4 acc[2][2][4][2];
#pragma unroll
    for (int a = 0; a < 2; ++a)
#pragma unroll
        for (int b = 0; b < 2; ++b)
#pragma unroll
            for (int m = 0; m < 4; ++m)
#pragma unroll
                for (int n = 0; n < 2; ++n) acc[a][b][m][n] = (f32x4){0.f, 0.f, 0.f, 0.f};
    bf16x8 At[4][2], B0[2][2], B1[2][2];
    const char* cA = (const char*)g.A + (size_t)cur.pm * tstepA; const char* cB = (const char*)g.Bt + (size_t)cur.pn * tstep;
    S.a_ready(cur);
    if constexpr (SP2) {
        PG8_STAGE(PG8_SB(0, 0), cB, voffB); PG8_STAGE(PG8_SB(0, 1), cB + hstep, voffB); PG8_STAGE(PG8_SA(0, 0), cA, voffA); PG8_STAGE(PG8_SA(0, 1), cA + hstepA, voffA);
        if (wr == 1) PG8_BAR;
        PG8_WAIT_V(2); PG8_BAR;
        PG8_STAGE(PG8_SB(1, 0), cB + kstep, voffB); PG8_STAGE(PG8_SA(1, 0), cA + kstep, voffA); PG8_STAGE(PG8_SB(1, 1), cB + hstep + kstep, voffB);
        PG8_WAIT_V(6); PG8_BAR;
    } else {
        PG8_STAGE(PG8_SB(0, 0), cB, voffB); PG8_STAGE(PG8_SA(0, 0), cA, voffA); PG8_STAGE(PG8_SB(0, 1), cB + hstep, voffB); PG8_STAGE(PG8_SA(0, 1), cA + hstepA, voffA);
        if (wr == 1) PG8_BAR;
        PG8_WAIT_V(4); PG8_BAR;
        PG8_STAGE(PG8_SB(1, 0), cB + kstep, voffB); PG8_STAGE(PG8_SA(1, 0), cA + kstep, voffA); PG8_STAGE(PG8_SB(1, 1), cB + hstep + kstep, voffB);
        PG8_WAIT_V(6); PG8_BAR;
    }
    for (;;) {
        const bool has_next = S.next(ui + 1, nxt);
        const char* nA = has_next ? (const char*)g.A + (size_t)nxt.pm * tstepA : cA; const char* nB = has_next ? (const char*)g.Bt + (size_t)nxt.pn * tstep : cB;
        for (int t = 0; t < nt; t += 2) {
            const bool last = (t == nt - 2);
            if constexpr (Epi::HAS_MID) { if (t == Epi::MID_T) E.mid(acc, cur, wr, wc); }
            const char* a1 = cA + (size_t)(t + 1) * kstep;
            const char* a2 = last ? nA : cA + (size_t)(t + 2) * kstep; const char* b2 = last ? nB : cB + (size_t)(t + 2) * kstep;
            const char* a3 = a2 + kstep; const char* b3 = b2 + kstep;
            if (last && has_next) S.a_ready(nxt);
            if constexpr (SP2) {
            PG8_LDB(B0, 0, 0); PG8_LDB(B1, 0, 1); PG8_SCHED; PG8_LDA(At, 0, 0); PG8_STAGE(PG8_SA(1, 1), a1 + hstepA, voffA);
            PG8_WAIT_V(8); PG8_WAIT_L(0); PG8_BAR; PG8_MMA(0, 0, At, B0); PG8_MMA(0, 1, At, B1); PG8_BAR; PG8_SCHED;
            PG8_LDA(At, 0, 1); PG8_STAGE(PG8_SB(0, 0), b2, voffB); PG8_STAGE(PG8_SB(0, 1), b2 + hstep, voffB); PG8_STAGE(PG8_SA(0, 0), a2, voffA);
            PG8_WAIT_V(8); PG8_WAIT_L(0); PG8_BAR; PG8_MMA(1, 0, At, B0); PG8_MMA(1, 1, At, B1); PG8_BAR; PG8_SCHED;
            PG8_LDB(B0, 1, 0); PG8_LDB(B1, 1, 1); PG8_SCHED; PG8_LDA(At, 1, 0); PG8_STAGE(PG8_SA(0, 1), a2 + hstepA, voffA);
            PG8_WAIT_V(8); PG8_WAIT_L(0); PG8_BAR; PG8_MMA(0, 0, At, B0); PG8_MMA(0, 1, At, B1); PG8_BAR; PG8_SCHED;
            PG8_LDA(At, 1, 1); PG8_STAGE(PG8_SB(1, 0), b3, voffB); PG8_STAGE(PG8_SB(1, 1), b3 + hstep, voffB); PG8_STAGE(PG8_SA(1, 0), a3, voffA);
            PG8_WAIT_V(8); PG8_WAIT_L(0); PG8_BAR; PG8_MMA(1, 0, At, B0); PG8_MMA(1, 1, At, B1); PG8_BAR; PG8_SCHED;
            } else {
            PG8_LDB(B0, 0, 0); PG8_SCHED; PG8_LDA(At, 0, 0); PG8_STAGE(PG8_SA(1, 1), a1 + hstepA, voffA);
            PG8_WAIT_L(8); PG8_BAR; PG8_WAIT_L(0); PG8_MMA(0, 0, At, B0); PG8_BAR; PG8_SCHED;
            PG8_LDB(B1, 0, 1); PG8_STAGE(PG8_SB(0, 0), b2, voffB);
            PG8_BAR; PG8_WAIT_L(0); PG8_MMA(0, 1, At, B1); PG8_BAR;
            PG8_LDA(At, 0, 1); PG8_STAGE(PG8_SA(0, 0), a2, voffA);
            PG8_BAR; PG8_WAIT_L(0); PG8_MMA(1, 0, At, B0); PG8_BAR; PG8_SCHED;
            PG8_STAGE(PG8_SB(0, 1), b2 + hstep, voffB);
            PG8_WAIT_V(6); PG8_BAR; PG8_MMA(1, 1, At, B1); PG8_BAR;
            PG8_LDB(B0, 1, 0); PG8_SCHED; PG8_LDA(At, 1, 0); PG8_STAGE(PG8_SA(0, 1), a2 + hstepA, voffA);
            PG8_WAIT_L(8); PG8_BAR; PG8_WAIT_L(0); PG8_MMA(0, 0, At, B0); PG8_BAR; PG8_SCHED;
            PG8_LDB(B1, 1, 1); PG8_STAGE(PG8_SB(1, 0), b3, voffB);
            PG8_BAR; PG8_WAIT_L(0); PG8_MMA(0, 1, At, B1); PG8_BAR;
            PG8_LDA(At, 1, 1); PG8_STAGE(PG8_SA(1, 0), a3, voffA);
            PG8_BAR; PG8_WAIT_L(0); PG8_MMA(1, 0, At, B0); PG8_BAR; PG8_SCHED;
            PG8_STAGE(PG8_SB(1, 1), b3 + hstep, voffB);
            PG8_WAIT_V(6); PG8_BAR; PG8_MMA(1, 1, At, B1); PG8_BAR;
            }
        }
        if constexpr (ALIGN_EPI) { if (wr == 0) PG8_BAR; }
        if constexpr (!Epi::AFTER_DRAIN) { E(acc, cur, wr, wc, fr, fq); S.done(cur); }
        if (!has_next) break;
#pragma unroll
        for (int a = 0; a < 2; ++a)
#pragma unroll
            for (int b = 0; b < 2; ++b)
#pragma unroll
                for (int m = 0; m < 4; ++m)
#pragma unroll
                    for (int n = 0; n < 2; ++n) acc[a][b][m][n] = (f32x4){0.f, 0.f, 0.f, 0.f};
        cur = nxt; cA = nA; cB = nB; ++ui;
        if constexpr (ALIGN_EPI) { if (wr == 1) PG8_BAR; }
    }
    PG8_WAIT_V(0);
    if constexpr (!ALIGN_EPI) { if (wr == 0) PG8_BAR; }
    PG8_BAR;
    if constexpr (Epi::AFTER_DRAIN) { E.fused(acc, cur, wr, wc, fr, fq, lds, wid, lane); S.done(cur); }
#undef PG8_SA
#undef PG8_SB
#undef PG8_STAGE
#undef PG8_LDA
#undef PG8_LDB
#undef PG8_MMA
#undef PG8_WAIT_V
#undef PG8_WAIT_L
#undef PG8_BAR
#undef PG8_SCHED
}
}
namespace pg8 {
__device__ __forceinline__ unsigned cvt_pk_bf16(float lo, float hi) { unsigned r; asm volatile("v_cvt_pk_bf16_f32 %0, %1, %2" : "=v"(r) : "v"(lo), "v"(hi)); return r; }
__device__ __forceinline__ float bf_lo(unsigned w) { return __uint_as_float(w << 16); }
__device__ __forceinline__ float bf_hi(unsigned w) { return __uint_as_float(w & 0xffff0000u); }
__device__ __forceinline__ float sigm(float x) { return __builtin_amdgcn_rcpf(1.f + __expf(-x)); }
#define EPI_ROWS_BEGIN \
    const int row0 = u.pm * BM + wr * 64 + fr; const int col0 = u.pn * BM + wc * 32 + 8 * fq; \
    _Pragma("unroll") for (int ai = 0; ai < 2; ++ai) _Pragma("unroll") for (int m = 0; m < 4; ++m) { const int lr = row0 + ai * HALF + m * 16;
#define EPI_ROWS_END }
typedef float f32x2e __attribute__((ext_vector_type(2)));
typedef unsigned u32x2 __attribute__((ext_vector_type(2)));
struct EpiProj {
    static constexpr bool PERM = true, AFTER_DRAIN = false, HAS_MID = false;
    bf16_t* O; int ldc; const float* ss; int grow0; const float* gq; const float* gk; const f32x2e* tax; const f32x2e* t1d; unsigned char* g8;
    __device__ __forceinline__ void operator()(const f32x4 (&acc)[2][2][4][2], const Unit& u, int wr, int wc, int fr_, int fq_) const {
        const int l_ = lane_now(), fr = l_ & 15, fq = l_ >> 4;
        const int pn = u.pn;
        const int kind = pn < 2 ? 1 : (pn == 2 ? (wc < 2 ? 2 : 0) : (pn < 5 ? 0 : (pn < 8 ? 3 : (pn < 11 ? 4 : 0))));
        const int row0 = u.pm * BM + wr * 64 + fr; const int ocol = pn * BM + wc * 64 + 8 * fq;
        const float C2v = 0.125f * 1.4426950408889634f;
        if (pn >= 15) {
            const int gcol = (pn - 15) * BM + wc * 64 + 8 * fq;
#pragma unroll
            for (int ai = 0; ai < 2; ++ai)
#pragma unroll
                for (int m = 0; m < 4; ++m) { const int lr = row0 + ai * HALF + m * 16;
                    const float rs = __builtin_amdgcn_rsqf(ss[grow0 + lr] * (1.f / 1024.f) + 1e-6f);
const float rs16 = rs * 16.f;
#pragma unroll
                    for (int bj = 0; bj < 2; ++bj) { u32x2 w = (u32x2){0u, 0u};
#pragma unroll
                        for (int i = 0; i < 4; ++i) { w.x = __builtin_amdgcn_cvt_pk_u8_f32(acc[ai][bj][m][0][i] * rs16 + 128.f, i, w.x); w.y = __builtin_amdgcn_cvt_pk_u8_f32(acc[ai][bj][m][1][i] * rs16 + 128.f, i, w.y);   }
                        *(u32x2*)(g8 + (size_t)lr * 2048 + gcol + bj * 32) = w; } }
        } else if (kind == 0) {
#pragma unroll
            for (int ai = 0; ai < 2; ++ai)
#pragma unroll
                for (int m = 0; m < 4; ++m) { const int lr = row0 + ai * HALF + m * 16;
                    const float rs = __builtin_amdgcn_rsqf(ss[grow0 + lr] * (1.f / 1024.f) + 1e-6f);
                    bf16_t* rowp = O + (size_t)lr * ldc + ocol;
#pragma unroll
                    for (int bj = 0; bj < 2; ++bj) { const f32x4 v0 = acc[ai][bj][m][0] * rs, v1 = acc[ai][bj][m][1] * rs;
                        u32x4 w; w.x = cvt_pk_bf16(v0[0], v0[1]); w.y = cvt_pk_bf16(v0[2], v0[3]); w.z = cvt_pk_bf16(v1[0], v1[1]); w.w = cvt_pk_bf16(v1[2], v1[3]);
                        *(u32x4*)(rowp + bj * 32) = w; } }
        } else if (kind <= 2) {
            const float* gp = (kind == 1 ? gq : gk) + 8 * fq; const float osc = kind == 1 ? C2v : 1.f;
            float gv[2][8];
#pragma unroll
            for (int bj = 0; bj < 2; ++bj)
#pragma unroll
                for (int i = 0; i < 8; ++i) gv[bj][i] = gp[bj * 32 + i] * osc;
            const float sgn = fq < 2 ? -1.f : 1.f;
#pragma unroll
            for (int ai = 0; ai < 2; ++ai)
#pragma unroll
                for (int m = 0; m < 4; ++m) { const int lr = row0 + ai * HALF + m * 16; const int t = lr & 4095;
                    const float rs = __builtin_amdgcn_rsqf(ss[grow0 + lr] * (1.f / 1024.f) + 1e-6f);
                    float x[2][8]; float sq = 0.f;
#pragma unroll
                    for (int bj = 0; bj < 2; ++bj)
#pragma unroll
                        for (int i = 0; i < 8; ++i) { x[bj][i] = acc[ai][bj][m][i >> 2][i & 3] * rs; sq += x[bj][i] * x[bj][i]; }
                    sq += shx(sq, l_, 16); sq += shx(sq, l_, 32);
                    const float rn = __builtin_amdgcn_rsqf(sq * (1.f / 64.f) + 1e-6f);
                    bf16_t* rowp = O + (size_t)lr * ldc + ocol;
#pragma unroll
                    for (int bj = 0; bj < 2; ++bj) { const f32x2e* tb = tax + (bj == 0 ? (t >> 6) : (t & 63)) * 16 + 8 * (fq & 1);
                        float y[8];
#pragma unroll
                        for (int i = 0; i < 8; ++i) { const float xv = x[bj][i] * rn * gv[bj][i]; const float xp = shx(xv, l_, 32); const f32x2e cs = tb[i]; y[i] = xv * cs.x + sgn * xp * cs.y; }
                        u32x4 w; w.x = cvt_pk_bf16(y[0], y[1]); w.y = cvt_pk_bf16(y[2], y[3]); w.z = cvt_pk_bf16(y[4], y[5]); w.w = cvt_pk_bf16(y[6], y[7]);
                        *(u32x4*)(rowp + bj * 32) = w; } }
        } else {
            const float osc = kind == 3 ? C2v : 1.f;
#pragma unroll
            for (int ai = 0; ai < 2; ++ai)
#pragma unroll
                for (int m = 0; m < 4; ++m) { const int lr = row0 + ai * HALF + m * 16; const int t = lr & 4095;
                    const float rs = __builtin_amdgcn_rsqf(ss[grow0 + lr] * (1.f / 1024.f) + 1e-6f) * osc;
                    const f32x2e* tb = t1d + t * 32 + 8 * fq;
                    float y0[8], y1[8];
#pragma unroll
                    for (int i = 0; i < 8; ++i) { const float x0 = acc[ai][0][m][i >> 2][i & 3] * rs, x1 = acc[ai][1][m][i >> 2][i & 3] * rs; const f32x2e cs = tb[i];
                        y0[i] = x0 * cs.x - x1 * cs.y; y1[i] = x1 * cs.x + x0 * cs.y; }
                    bf16_t* rowp = O + (size_t)lr * ldc + ocol;
                    u32x4 w; w.x = cvt_pk_bf16(y0[0], y0[1]); w.y = cvt_pk_bf16(y0[2], y0[3]); w.z = cvt_pk_bf16(y0[4], y0[5]); w.w = cvt_pk_bf16(y0[6], y0[7]);
                    *(u32x4*)(rowp) = w;
                    w.x = cvt_pk_bf16(y1[0], y1[1]); w.y = cvt_pk_bf16(y1[2], y1[3]); w.z = cvt_pk_bf16(y1[4], y1[5]); w.w = cvt_pk_bf16(y1[6], y1[7]);
                    *(u32x4*)(rowp + 32) = w; }
        }
    }
};
template <bool ADD> struct EpiGate {
    static constexpr bool PERM = true, AFTER_DRAIN = false, HAS_MID = false;
    bf16_t* O; int ldc; const unsigned char* G;
    __device__ __forceinline__ void operator()(const f32x4 (&acc)[2][2][4][2], const Unit& u, int wr, int wc, int fr_, int fq_) const { const int l_ = lane_now(), fr = l_ & 15, fq = l_ >> 4;
        const int row0 = u.pm * BM + wr * 64 + fr; const int col0 = u.pn * BM + wc * 32 + 8 * fq;
#pragma unroll
        for (int ai = 0; ai < 2; ++ai)
#pragma unroll
        for (int mh = 0; mh < 4; mh += 2) {
            u32x2 gw[4][2]; u32x4 pv[4][2];
#pragma unroll
            for (int m = mh; m < mh + 2; ++m) { const int lr = row0 + ai * HALF + m * 16;
#pragma unroll
                for (int bj = 0; bj < 2; ++bj) { gw[m][bj] = *(const u32x2*)(G + (size_t)lr * 2048 + col0 + bj * HALF); pv[m][bj] = (u32x4){0u, 0u, 0u, 0u}; if (ADD) pv[m][bj] = *(const u32x4*)(O + (size_t)lr * ldc + col0 + bj * HALF); } }
#pragma unroll
            for (int m = mh; m < mh + 2; ++m) { const int lr = row0 + ai * HALF + m * 16; bf16_t* rowp = O + (size_t)lr * ldc + col0;
#pragma unroll
                for (int bj = 0; bj < 2; ++bj) { const u32x2 g_ = gw[m][bj]; const u32x4 p_ = pv[m][bj]; const f32x4 a0 = acc[ai][bj][m][0], a1 = acc[ai][bj][m][1]; u32x4 w;
#define G8S(w_, sh_) sigm((float)(((w_) >> (sh_)) & 255u) * 0.0625f - 8.f)
                    w.x = cvt_pk_bf16(bf_lo(p_.x) + G8S(g_.x, 0) * a0[0], bf_hi(p_.x) + G8S(g_.x, 8) * a0[1]);
                    w.y = cvt_pk_bf16(bf_lo(p_.y) + G8S(g_.x, 16) * a0[2], bf_hi(p_.y) + G8S(g_.x, 24) * a0[3]);
                    w.z = cvt_pk_bf16(bf_lo(p_.z) + G8S(g_.y, 0) * a1[0], bf_hi(p_.z) + G8S(g_.y, 8) * a1[1]);
                    w.w = cvt_pk_bf16(bf_lo(p_.w) + G8S(g_.y, 16) * a1[2], bf_hi(p_.w) + G8S(g_.y, 24) * a1[3]);
#undef G8S
                    *(u32x4*)(rowp + bj * HALF) = w; } }
        }
    }
};
struct EpiNull {
    static constexpr bool PERM = true, AFTER_DRAIN = false, HAS_MID = false;
    __device__ __forceinline__ void operator()(const f32x4 (&acc)[2][2][4][2], const Unit& u, int wr, int wc, int fr_, int fq_) const {
#pragma unroll
        for (int a = 0; a < 2; ++a)
#pragma unroll
            for (int b = 0; b < 2; ++b)
#pragma unroll
                for (int m = 0; m < 4; ++m)
#pragma unroll
                    for (int n = 0; n < 2; ++n) asm volatile("" :: "v"(acc[a][b][m][n]));
    }
};
struct EpiPlain {
    static constexpr bool PERM = true, AFTER_DRAIN = false, HAS_MID = false;
    bf16_t* O; int ldc;
    __device__ __forceinline__ void operator()(const f32x4 (&acc)[2][2][4][2], const Unit& u, int wr, int wc, int fr_, int fq_) const { const int l_ = lane_now(), fr = l_ & 15, fq = l_ >> 4;
        EPI_ROWS_BEGIN
            bf16_t* rowp = O + (size_t)lr * ldc + col0;
#pragma unroll
            for (int bj = 0; bj < 2; ++bj) { const f32x4 v0 = acc[ai][bj][m][0], v1 = acc[ai][bj][m][1];
                u32x4 w; w.x = cvt_pk_bf16(v0[0], v0[1]); w.y = cvt_pk_bf16(v0[2], v0[3]); w.z = cvt_pk_bf16(v1[0], v1[1]); w.w = cvt_pk_bf16(v1[2], v1[3]);
                *(u32x4*)(rowp + bj * HALF) = w; }
        EPI_ROWS_END
    }
};
__device__ __forceinline__ void split_hl(const f32x4& h0, const f32x4& h1, u32x4& whi, u32x4& wlo) {
    whi.x = cvt_pk_bf16(h0[0], h0[1]); whi.y = cvt_pk_bf16(h0[2], h0[3]); whi.z = cvt_pk_bf16(h1[0], h1[1]); whi.w = cvt_pk_bf16(h1[2], h1[3]);
    wlo.x = cvt_pk_bf16(h0[0] - bf_lo(whi.x), h0[1] - bf_hi(whi.x)); wlo.y = cvt_pk_bf16(h0[2] - bf_lo(whi.y), h0[3] - bf_hi(whi.y));
    wlo.z = cvt_pk_bf16(h1[0] - bf_lo(whi.z), h1[1] - bf_hi(whi.z)); wlo.w = cvt_pk_bf16(h1[2] - bf_lo(whi.w), h1[3] - bf_hi(whi.w));
}
struct EpiMix {
    static constexpr bool PERM = true, AFTER_DRAIN = false, HAS_MID = false;
    const bf16_t* HI; int ldi; bf16_t* LO; bf16_t* HO; int ldo; float* ss_out; int grow0; bool st;
    __device__ __forceinline__ void operator()(const f32x4 (&acc)[2][2][4][2], const Unit& u, int wr, int wc, int fr_, int fq_) const { const int l_ = lane_now(), fr = l_ & 15, fq = l_ >> 4;
        const int row0 = u.pm * BM + wr * 64 + fr; const int col0 = u.pn * BM + wc * 32 + 8 * fq;
#pragma unroll
        for (int ai = 0; ai < 2; ++ai) {
            u32x4 hv[4][2], lv[4][2];
#pragma unroll
            for (int m = 0; m < 4; ++m) { const int lr = row0 + ai * HALF + m * 16;
#pragma unroll
                for (int bj = 0; bj < 2; ++bj) { hv[m][bj] = *(const u32x4*)(HI + (size_t)lr * ldi + col0 + bj * HALF); lv[m][bj] = *(const u32x4*)(LO + (size_t)lr * 1024 + col0 + bj * HALF); } }
#pragma unroll
            for (int m = 0; m < 4; ++m) { const int lr = row0 + ai * HALF + m * 16, gr = grow0 + lr; float sq = 0.f;
#pragma unroll
                for (int bj = 0; bj < 2; ++bj) { const u32x4 a_ = hv[m][bj], b_ = lv[m][bj];
                    f32x4 h0 = (f32x4){bf_lo(a_.x) + bf_lo(b_.x), bf_hi(a_.x) + bf_hi(b_.x), bf_lo(a_.y) + bf_lo(b_.y), bf_hi(a_.y) + bf_hi(b_.y)};
                    f32x4 h1 = (f32x4){bf_lo(a_.z) + bf_lo(b_.z), bf_hi(a_.z) + bf_hi(b_.z), bf_lo(a_.w) + bf_lo(b_.w), bf_hi(a_.w) + bf_hi(b_.w)};
                    h0 = h0 + acc[ai][bj][m][0]; h1 = h1 + acc[ai][bj][m][1];
                    sq += (h0[0] * h0[0] + h0[1] * h0[1]) + (h0[2] * h0[2] + h0[3] * h0[3]) + (h1[0] * h1[0] + h1[1] * h1[1]) + (h1[2] * h1[2] + h1[3] * h1[3]);
                    u32x4 whi, wlo; split_hl(h0, h1, whi, wlo);
                    if (st) { *(u32x4*)(HO + (size_t)lr * ldo + col0 + bj * HALF) = whi; *(u32x4*)(LO + (size_t)lr * 1024 + col0 + bj * HALF) = wlo; } }
                sq += shx(sq, l_, 16); sq += shx(sq, l_, 32);
                if (fq == 0 && st) unsafeAtomicAdd(ss_out + gr, sq);
            }
        }
    }
};
struct EpiPle {
    static constexpr bool PERM = true, AFTER_DRAIN = false, HAS_MID = true; static constexpr int MID_T = 16;
    const bf16_t* HI; int ldi; bf16_t* LO; bf16_t* HO; float* HF; const float* ss_in; float* ss_out; int grow0; unsigned* scr; bool st;
    __device__ __forceinline__ void mid(f32x4 (&acc)[2][2][4][2], const Unit& u, int wr, int wc) const { const int l_ = lane_now(), fr = l_ & 15; const int tid = (wr * 4 + wc) * 64 + l_;
        const int row0 = u.pm * BM + wr * 64 + fr;
        float sv[8];
#pragma unroll
        for (int r = 0; r < 8; ++r) sv[r] = ss_in[grow0 + row0 + (r >> 2) * HALF + (r & 3) * 16];
#pragma unroll
        for (int ai = 0; ai < 2; ++ai)
#pragma unroll
            for (int m = 0; m < 4; ++m) { const float rs = __builtin_amdgcn_rsqf(sv[ai * 4 + m] * (1.f / 1024.f) + 1e-6f);
#pragma unroll
                for (int bj = 0; bj < 2; ++bj) { unsigned w0 = 0u, w1 = 0u;
#pragma unroll
                    for (int i = 0; i < 4; ++i) { w0 = __builtin_amdgcn_cvt_pk_u8_f32(sigm(acc[ai][bj][m][0][i] * rs) * 255.f, i, w0); w1 = __builtin_amdgcn_cvt_pk_u8_f32(sigm(acc[ai][bj][m][1][i] * rs) * 255.f, i, w1);
                        acc[ai][bj][m][0][i] = 0.f; acc[ai][bj][m][1][i] = 0.f; }
                    const int j = ((ai * 4 + m) * 2 + bj) * 2;
                    scr[(j + 0) * 512 + tid] = w0; scr[(j + 1) * 512 + tid] = w1; } }
    }
    __device__ __forceinline__ void operator()(const f32x4 (&acc)[2][2][4][2], const Unit& u, int wr, int wc, int fr_, int fq_) const { const int l_ = lane_now(), fr = l_ & 15, fq = l_ >> 4; const int tid = (wr * 4 + wc) * 64 + l_;
        const int row0 = u.pm * BM + wr * 64 + fr; const int col0 = u.pn * BM + wc * 32 + 8 * fq;
#pragma unroll
        for (int ai = 0; ai < 2; ++ai)
#pragma unroll
        for (int mh = 0; mh < 4; mh += 2) {
            u32x4 hv[4][2], lv[4][2]; unsigned gq[4][2][2];
#pragma unroll
            for (int m = mh; m < mh + 2; ++m) { const int lr = row0 + ai * HALF + m * 16;
#pragma unroll
                for (int bj = 0; bj < 2; ++bj) { hv[m][bj] = *(const u32x4*)(HI + (size_t)lr * ldi + col0 + bj * HALF); lv[m][bj] = *(const u32x4*)(LO + (size_t)lr * 1024 + col0 + bj * HALF);
                    const int j = ((ai * 4 + m) * 2 + bj) * 2;
                    gq[m][bj][0] = __hip_atomic_load(scr + (j + 0) * 512 + tid, __ATOMIC_RELAXED, __HIP_MEMORY_SCOPE_AGENT); gq[m][bj][1] = __hip_atomic_load(scr + (j + 1) * 512 + tid, __ATOMIC_RELAXED, __HIP_MEMORY_SCOPE_AGENT); } }
#pragma unroll
            for (int m = mh; m < mh + 2; ++m) { const int lr = row0 + ai * HALF + m * 16, gr = grow0 + lr;
                float sq = 0.f; const float k_ = 1.f / 255.f;
#pragma unroll
                for (int bj = 0; bj < 2; ++bj) {
                    const u32x4 a_ = hv[m][bj], b_ = lv[m][bj];
                    f32x4 h0 = (f32x4){bf_lo(a_.x) + bf_lo(b_.x), bf_hi(a_.x) + bf_hi(b_.x), bf_lo(a_.y) + bf_lo(b_.y), bf_hi(a_.y) + bf_hi(b_.y)};
                    f32x4 h1 = (f32x4){bf_lo(a_.z) + bf_lo(b_.z), bf_hi(a_.z) + bf_hi(b_.z), bf_lo(a_.w) + bf_lo(b_.w), bf_hi(a_.w) + bf_hi(b_.w)};
                    const f32x4 a0 = acc[ai][bj][m][0], a1 = acc[ai][bj][m][1]; const unsigned g0 = gq[m][bj][0], g1 = gq[m][bj][1];
                    h0[0] += (float)(g0 & 255u) * k_ * a0[0]; h0[1] += (float)((g0 >> 8) & 255u) * k_ * a0[1]; h0[2] += (float)((g0 >> 16) & 255u) * k_ * a0[2]; h0[3] += (float)(g0 >> 24) * k_ * a0[3];
                    h1[0] += (float)(g1 & 255u) * k_ * a1[0]; h1[1] += (float)((g1 >> 8) & 255u) * k_ * a1[1]; h1[2] += (float)((g1 >> 16) & 255u) * k_ * a1[2]; h1[3] += (float)(g1 >> 24) * k_ * a1[3];
                    sq += (h0[0] * h0[0] + h0[1] * h0[1]) + (h0[2] * h0[2] + h0[3] * h0[3]) + (h1[0] * h1[0] + h1[1] * h1[1]) + (h1[2] * h1[2] + h1[3] * h1[3]);
                    if (HO) { u32x4 whi, wlo; split_hl(h0, h1, whi, wlo);
                        if (st) { *(u32x4*)(HO + (size_t)lr * 1024 + col0 + bj * HALF) = whi; *(u32x4*)(LO + (size_t)lr * 1024 + col0 + bj * HALF) = wlo; } }
                    else if (st) { float* hp = HF + (size_t)gr * 1024 + col0 + bj * HALF; *(f32x4*)hp = h0; *(f32x4*)(hp + 4) = h1; }
                }
                sq += shx(sq, l_, 16); sq += shx(sq, l_, 32);
                if (fq == 0 && st) unsafeAtomicAdd(ss_out + gr, sq);
            }
        }
    }
};
struct EpiMerge {
    static constexpr bool PERM = true, AFTER_DRAIN = false, HAS_MID = true; static constexpr int MID_T = 8;
    bf16_t* O; int ldc; const unsigned char* G;
    const PG8_LAS float* T;
    __device__ __forceinline__ static float dec(unsigned w, int sh) { return (float)((w >> sh) & 255u) * 0.0625f - 8.f; }
    __device__ __forceinline__ void mid(f32x4 (&acc)[2][2][4][2], const Unit& u, int wr, int wc) const { const int l_ = lane_now(), fr = l_ & 15, fq = l_ >> 4;
        const int row0 = u.pm * BM + wr * 64 + fr; const int col0 = u.pn * BM + wc * 32 + 8 * fq;
#pragma unroll
        for (int ai = 0; ai < 2; ++ai) {
            u32x2 ga[4][2], gb[4][2];
#pragma unroll
            for (int m = 0; m < 4; ++m) { const unsigned char* gp = G + (size_t)(row0 + ai * HALF + m * 16) * 2048 + col0;
#pragma unroll
                for (int bj = 0; bj < 2; ++bj) { ga[m][bj] = *(const u32x2*)(gp + bj * HALF); gb[m][bj] = *(const u32x2*)(gp + 1024 + bj * HALF); } }
#pragma unroll
            for (int m = 0; m < 4; ++m)
#pragma unroll
                for (int bj = 0; bj < 2; ++bj)
#pragma unroll
                    for (int i = 0; i < 8; ++i) { const unsigned wa = i < 4 ? ga[m][bj].x : ga[m][bj].y, wb = i < 4 ? gb[m][bj].x : gb[m][bj].y; const int sh = 8 * (i & 3);
                        acc[ai][bj][m][i >> 2][i & 3] *= T[(wa >> sh) & 255u] * T[256 + ((wb >> sh) & 255u)]; }
        }
    }
    __device__ __forceinline__ void operator()(const f32x4 (&acc)[2][2][4][2], const Unit& u, int wr, int wc, int fr_, int fq_) const { const int l_ = lane_now(), fr = l_ & 15, fq = l_ >> 4;
        const int row0 = u.pm * BM + wr * 64 + fr; const int col0 = u.pn * BM + wc * 32 + 8 * fq;
#pragma unroll
        for (int ai = 0; ai < 2; ++ai) {
            u32x2 gb[4][2];
#pragma unroll
            for (int m = 0; m < 4; ++m)
#pragma unroll
                for (int bj = 0; bj < 2; ++bj) gb[m][bj] = *(const u32x2*)(G + (size_t)(row0 + ai * HALF + m * 16) * 2048 + 1024 + col0 + bj * HALF);
#pragma unroll
            for (int m = 0; m < 4; ++m) { bf16_t* rowp = O + (size_t)(row0 + ai * HALF + m * 16) * ldc + col0;
#pragma unroll
                for (int bj = 0; bj < 2; ++bj) { const u32x2 g_ = gb[m][bj]; const f32x4 a0 = acc[ai][bj][m][0], a1 = acc[ai][bj][m][1]; u32x4 w;
#define TS(w_, sh_) T[((w_) >> (sh_)) & 255u]
                    w.x = cvt_pk_bf16(TS(g_.x, 0) * a0[0], TS(g_.x, 8) * a0[1]); w.y = cvt_pk_bf16(TS(g_.x, 16) * a0[2], TS(g_.x, 24) * a0[3]);
                    w.z = cvt_pk_bf16(TS(g_.y, 0) * a1[0], TS(g_.y, 8) * a1[1]); w.w = cvt_pk_bf16(TS(g_.y, 16) * a1[2], TS(g_.y, 24) * a1[3]);
#undef TS
                    *(u32x4*)(rowp + bj * HALF) = w; } }
        }
    }
};
}
#include <hip/hip_bf16.h>
#include <cmath>
namespace attn_body {
using bf16=__hip_bfloat16;
using bf16x8=__attribute__((ext_vector_type(8)))short;
using s16x4=__attribute__((ext_vector_type(4)))short;
using f32x16=__attribute__((ext_vector_type(16)))float;
using u32x4=__attribute__((ext_vector_type(4)))unsigned;
constexpr int NHEAD=8,SEQ=4096,D=64,DM=3840;
constexpr int NW=8,QBLK=32,QB=QBLK*NW,KVBLK=64,NQB=SEQ/QB;
constexpr int ATTN_PITCH=DM, ATTN_UNIT_ROWS=QB;
__device__ __forceinline__ int crow(int r,int hi){return (r&3)+8*(r>>2)+4*hi;}
#define SBAR() __builtin_amdgcn_sched_barrier(0)
__device__ __forceinline__ void cmask(f32x16&p0,f32x16&p1,int jb,int qrel,int hi){
  const float NEG=-INFINITY; int kb=64*jb+4*hi;
  #pragma unroll
  for(int r=0;r<16;++r){int kv=kb+(r&3)+8*(r>>2); if(kv>qrel)p0[r]=NEG; if(kv+32>qrel)p1[r]=NEG;}
}

constexpr int NSLOT=3, SLOTB=8192;
constexpr int LDS_K=0, LDS_V=NSLOT*SLOTB, LDS_WS=2*NSLOT*SLOTB, LDS_OST=LDS_WS+NW*64*4, LDS_BYTES=LDS_OST+NW*4096;
constexpr float C2=0.125f*1.4426950408889634f;
__device__ __forceinline__ void glds16(const void*gsrc,unsigned lds_dst){unsigned keep;
  asm volatile("s_mov_b32 %0, m0\n\ts_mov_b32 m0, %2\n\ts_nop 0\n\tglobal_load_lds_dwordx4 %1, off\n\ts_mov_b32 m0, %0":"=&s"(keep):"v"(gsrc),"s"(lds_dst):"memory");}
__device__ __forceinline__ float max3f(float a,float b,float c){float r;asm("v_max3_f32 %0, %1, %2, %3":"=v"(r):"v"(a),"v"(b),"v"(c));return r;}
__device__ __forceinline__ float max2f(float a,float b){float r;asm("v_max_f32_e32 %0, %1, %2":"=v"(r):"v"(a),"v"(b));return r;}
__device__ __forceinline__ float fadd_s(float a,float b){float r;asm("v_add_f32_e32 %0, %1, %2":"=v"(r):"v"(a),"v"(b));return r;}
__device__ __forceinline__ float fsub_s(float a,float b){float r;asm("v_sub_f32_e32 %0, %1, %2":"=v"(r):"v"(a),"v"(b));return r;}
typedef float f32x2_t __attribute__((ext_vector_type(2))); typedef __bf16 bf16x2_t __attribute__((ext_vector_type(2)));
__device__ __forceinline__ unsigned cvtpk_s(float lo,float hi){f32x2_t v={lo,hi};bf16x2_t b=__builtin_convertvector(v,bf16x2_t);return __builtin_bit_cast(unsigned,b);}
#define WAIT_BAR(N) asm volatile("s_waitcnt vmcnt(" #N ") lgkmcnt(0)\n\ts_barrier":::"memory")

__device__ __forceinline__ void qkt(f32x16&p0,f32x16&p1,const char*Kslot,const bf16x8*qr,const f32x16&negm,int r32,int hi){
  const char*kb=Kslot+hi*1024+r32*16;
  #pragma unroll
  for(int d0=0;d0<4;++d0){
    const bf16x8 b0=*reinterpret_cast<const bf16x8*>(kb+d0*2048);
    const bf16x8 b1=*reinterpret_cast<const bf16x8*>(kb+d0*2048+512);
    if(d0==0){p0=__builtin_amdgcn_mfma_f32_32x32x16_bf16(b0,qr[0],negm,0,0,0);p1=__builtin_amdgcn_mfma_f32_32x32x16_bf16(b1,qr[0],negm,0,0,0);}
    else{p0=__builtin_amdgcn_mfma_f32_32x32x16_bf16(b0,qr[d0],p0,0,0,0);p1=__builtin_amdgcn_mfma_f32_32x32x16_bf16(b1,qr[d0],p1,0,0,0);}}
}
typedef __attribute__((address_space(3))) const char* lds_cptr;
typedef short v4i16_t __attribute__((ext_vector_type(4)));
__device__ __forceinline__ void kload8(bf16x8*kf,lds_cptr kp){
  kf[0]=*(const __attribute__((address_space(3))) bf16x8*)(kp);      kf[1]=*(const __attribute__((address_space(3))) bf16x8*)(kp+512);
  kf[2]=*(const __attribute__((address_space(3))) bf16x8*)(kp+2048); kf[3]=*(const __attribute__((address_space(3))) bf16x8*)(kp+2560);
  kf[4]=*(const __attribute__((address_space(3))) bf16x8*)(kp+4096); kf[5]=*(const __attribute__((address_space(3))) bf16x8*)(kp+4608);
  kf[6]=*(const __attribute__((address_space(3))) bf16x8*)(kp+6144); kf[7]=*(const __attribute__((address_space(3))) bf16x8*)(kp+6656);
}
__device__ __forceinline__ void kload2(bf16x8*kf,lds_cptr kp,int j){ kf[2*j]=*(const __attribute__((address_space(3))) bf16x8*)(kp+j*2048); kf[2*j+1]=*(const __attribute__((address_space(3))) bf16x8*)(kp+j*2048+512); }
__device__ __forceinline__ s16x4 vtr(lds_cptr p){ return __builtin_bit_cast(s16x4,__builtin_amdgcn_ds_read_tr16_b64_v4i16((__attribute__((address_space(3))) v4i16_t*)p)); }
__device__ __forceinline__ float rowmax(const f32x16&p0,const f32x16&p1){
  float a=max3f(p0[0],p0[1],p1[0]),b=max3f(p0[2],p0[3],p1[1]);a=max3f(a,p1[2],p1[3]);
  #pragma unroll
  for(int r=4;r<16;r+=4){a=max3f(a,p0[r],p0[r+1]);b=max3f(b,p0[r+2],p0[r+3]);a=max3f(a,p1[r],p1[r+1]);b=max3f(b,p1[r+2],p1[r+3]);}
  const float m=max2f(a,b);
  auto rr=__builtin_amdgcn_permlane32_swap(__float_as_uint(m),__float_as_uint(m),false,false);
  return max2f(__uint_as_float(rr[0]),__uint_as_float(rr[1]));
}
__device__ __forceinline__ void pv(f32x16*o,int vb,bf16x8 pa0,bf16x8 pa1,bf16x8 pa2,bf16x8 pa3){
  #pragma unroll
  for(int d0=0;d0<2;++d0){s16x4 lo[4],hi[4];
    #pragma unroll
    for(int ks=0;ks<4;++ks){
      asm volatile("ds_read_b64_tr_b16 %0,%1 offset:%c2":"=&v"(lo[ks]):"v"(vb),"i"(d0*4096+ks*1024):"memory");
      asm volatile("ds_read_b64_tr_b16 %0,%1 offset:%c2":"=&v"(hi[ks]):"v"(vb),"i"(d0*4096+ks*1024+512):"memory");}
    asm volatile("s_waitcnt lgkmcnt(0)":::"memory");SBAR();
    #define PK(k) (bf16x8){lo[k][0],lo[k][1],lo[k][2],lo[k][3],hi[k][0],hi[k][1],hi[k][2],hi[k][3]}
    o[d0]=__builtin_amdgcn_mfma_f32_32x32x16_bf16(pa0,PK(0),o[d0],0,0,0);
    o[d0]=__builtin_amdgcn_mfma_f32_32x32x16_bf16(pa1,PK(1),o[d0],0,0,0);
    o[d0]=__builtin_amdgcn_mfma_f32_32x32x16_bf16(pa2,PK(2),o[d0],0,0,0);
    o[d0]=__builtin_amdgcn_mfma_f32_32x32x16_bf16(pa3,PK(3),o[d0],0,0,0);
    #undef PK
  }
}

#ifndef ATTN_STORE16
#define ATTN_STORE16(p,v) (*(u32x4*)(p)=(v))
#endif
template<int THRL> __device__ __forceinline__ void attn_unit(int b,int h,int qb,const bf16*Q,const bf16*__restrict__ K,const bf16*__restrict__ V,bf16*O,const bf16*__restrict__ Z,char*shm,const int wave_id,const bool st_){
  const int lane=lane_now(),tid=wave_id*64+lane,r32=lane&31,hi=lane>>5; const int wid=wave_id;
  const long rowbase=(long)b*SEQ; const int q0=qb*QB;
  const bf16*Qw=Q+(rowbase+q0+wid*QBLK)*DM+h*D;
  const bf16*Kh=K+rowbase*DM+(h>>2)*D,*Vh=V+rowbase*DM+(h>>2)*D;
  const unsigned lds0=(unsigned)(uintptr_t)shm;
  float*wsf=(float*)(shm+LDS_WS)+wid*64;
  const bf16*ksrc=Kh+(long)lane*DM+wid*8;
  const bf16*vsrc=Vh+(long)(16*(wid&3)+(lane>>2))*DM+(wid>>2)*32+(lane&3)*8;
  const unsigned kdst=lds0+LDS_K+wid*1024, vdst=lds0+LDS_V+wid*1024;
  #define DMA_K(t,slot) glds16(ksrc+(long)(t)*KVBLK*DM,(unsigned)__builtin_amdgcn_readfirstlane(kdst+(slot)))
  #define DMA_V(t,slot) glds16(vsrc+(long)(t)*KVBLK*DM,(unsigned)__builtin_amdgcn_readfirstlane(vdst+(slot)))
  const int vb0=(int)(lds0+LDS_V)+((lane>>4)&1)*32+(lane&3)*8+(4*hi+((lane&15)>>2))*64;
  const char*Kbase=shm+LDS_K; bf16x8 kf[8];
  const lds_cptr shm3=(lds_cptr)shm; const lds_cptr kp0=shm3+LDS_K+hi*1024+r32*16; const lds_cptr vp0=shm3+LDS_V+((lane>>4)&1)*32+(lane&3)*8+(4*hi+((lane&15)>>2))*64;
  constexpr int NT=SEQ/KVBLK;
  DMA_K(0,0);DMA_V(0,0);DMA_K(1,SLOTB);
  bf16x8 qr[4];
  #pragma unroll
  for(int d0=0;d0<4;++d0)qr[d0]=*reinterpret_cast<const bf16x8*>(&Qw[(long)r32*DM+d0*16+hi*8]);
  float mhat=0.f,l_reg=0.f;f32x16 o[2];{float zz=0.f;asm volatile("":"+v"(zz));_Pragma("unroll") for(int r=0;r<16;++r){o[0][r]=zz;o[1][r]=zz;}}f32x16 negm;{float zz=0.f;asm volatile("":"+v"(zz));_Pragma("unroll") for(int r=0;r<16;++r)negm[r]=zz;}asm volatile("":"+v"(negm));
  const int qrel=wid*QBLK+r32;
  #define CMASK(P0,P1,t) do{}while(0)
  bool resc=false;
  #define START(P0,P1) do{ const float rm=rowmax(P0,P1); resc=false; \
    { const float dl=rm; mhat=fadd_s(mhat,dl); \
      _Pragma("unroll") for(int r=0;r<16;++r){P0[r]=fsub_s(P0[r],dl);P1[r]=fsub_s(P1[r],dl);} \
      _Pragma("unroll") for(int r=0;r<16;++r)negm[r]=-mhat; asm volatile("":"+v"(negm)); } \
    _Pragma("unroll") for(int r=0;r<16;++r)P0[r]=__builtin_amdgcn_exp2f(P0[r]); }while(0)
  #define RESC() do{ if(resc){ asm volatile("s_waitcnt lgkmcnt(0)":::"memory"); \
      _Pragma("unroll") for(int d_=0;d_<2;++d_) _Pragma("unroll") for(int r=0;r<16;++r)o[d_][r]*=wsf[crow(r,hi)]; } }while(0)
  f32x16 pA0,pA1,pB0,pB1;
  int sl_prev=0,sl_cur=0,sl_next=SLOTB;
  #define ROT() do{sl_prev=sl_cur;sl_cur=sl_next;sl_next=(sl_next==(NSLOT-1)*SLOTB)?0:sl_next+SLOTB;}while(0)
  DMA_K(2,2*SLOTB);
  WAIT_BAR(3);
  qkt(pA0,pA1,Kbase,qr,negm,r32,hi);asm volatile("s_nop 15\n\ts_nop 7":"+v"(pA0),"+v"(pA1));CMASK(pA0,pA1,0);
  START(pA0,pA1);
  _Pragma("unroll") for(int r=0;r<16;++r)pA1[r]=__builtin_amdgcn_exp2f(pA1[r]);
  WAIT_BAR(0);
  DMA_K(3,0);DMA_V(1,SLOTB);
  ROT();
  kload8(kf,kp0+sl_cur);
  WAIT_BAR(2);
  s16x4 vlo[8],vhi[8]; u32x4 pw0,pw1,pw2,pw3;
  #define PKW(P,B) cvtpk_s(P[B],P[B+1])
  #define PAF(k) __builtin_bit_cast(bf16x8,pw##k)
  #define VFR(i) (bf16x8){vlo[i][0],vlo[i][1],vlo[i][2],vlo[i][3],vhi[i][0],vhi[i][1],vhi[i][2],vhi[i][3]}
  #define PIN(x) asm volatile("":"+v"(x))
  #define MX3(a,b,c) __builtin_fmaxf(__builtin_fmaxf((a),(b)),(c))
  #define GAPA(MF,A0,A1,A2,A3,W0,W1,PW) do{ MF; sacc+=A0; sacc+=A1; sacc+=A2; sacc+=A3; PIN(sacc); W0; W1; PIN(PW); SBAR(); }while(0)
  #define EX(v) __builtin_amdgcn_exp2f(v)
  #define GAPB(MF,X,B) do{ MF; X[B]=EX(X[B]); X[B+1]=EX(X[B+1]); X[B+2]=EX(X[B+2]); X[B+3]=EX(X[B+3]); PIN(X); SBAR(); }while(0)
  #define VRD(i) do{ vlo[i]=vtr(vp_+(((i)>>2)*4096+((i)&3)*1024)); vhi[i]=vtr(vp_+(((i)>>2)*4096+((i)&3)*1024+512)); }while(0)
  #define KRD(G,j) do{ if(G){ kload2(kf,kp0+sl_next,j); SBAR(); } }while(0)
  #define STEP(C0,C1,P0,P1,t,GK,GV,GL) do{ SBAR(); \
    const lds_cptr vp_=vp0+sl_prev; \
    VRD(0); SBAR(); float sacc=(P0[0]+P0[1]); \
    GAPA(C0=__builtin_amdgcn_mfma_f32_32x32x16_bf16(kf[0],qr[0],negm,0,0,0), P0[2],P0[3],P0[4],P0[5],     pw0[0]=PKW(P0,0), pw0[1]=PKW(P0,2), pw0); \
    VRD(4); SBAR(); GAPA(C1=__builtin_amdgcn_mfma_f32_32x32x16_bf16(kf[1],qr[0],negm,0,0,0), P0[6],P0[7],P0[8],P0[9],     pw0[2]=PKW(P0,4), pw0[3]=PKW(P0,6), pw0); \
    VRD(1); SBAR(); GAPA(C0=__builtin_amdgcn_mfma_f32_32x32x16_bf16(kf[2],qr[1],C0,0,0,0),   P0[10],P0[11],P0[12],P0[13], pw1[0]=PKW(P0,8), pw1[1]=PKW(P0,10), pw1); \
    VRD(5); SBAR(); GAPA(C1=__builtin_amdgcn_mfma_f32_32x32x16_bf16(kf[3],qr[1],C1,0,0,0),   P0[14],P0[15],P1[0],P1[1],   pw1[2]=PKW(P0,12),pw1[3]=PKW(P0,14), pw1); \
    VRD(2); SBAR(); GAPA(C0=__builtin_amdgcn_mfma_f32_32x32x16_bf16(kf[4],qr[2],C0,0,0,0),   P1[2],P1[3],P1[4],P1[5],     pw2[0]=PKW(P1,0), pw2[1]=PKW(P1,2), pw2); \
    VRD(6); SBAR(); GAPA(C1=__builtin_amdgcn_mfma_f32_32x32x16_bf16(kf[5],qr[2],C1,0,0,0),   P1[6],P1[7],P1[8],P1[9],     pw2[2]=PKW(P1,4), pw2[3]=PKW(P1,6), pw2); \
    VRD(3); SBAR(); GAPA(C0=__builtin_amdgcn_mfma_f32_32x32x16_bf16(kf[6],qr[3],C0,0,0,0),   P1[10],P1[11],P1[12],P1[13], pw3[0]=PKW(P1,8), pw3[1]=PKW(P1,10), pw3); \
    VRD(7); SBAR(); GAPA(C1=__builtin_amdgcn_mfma_f32_32x32x16_bf16(kf[7],qr[3],C1,0,0,0),   P1[14],P1[15],0.f,0.f,       pw3[2]=PKW(P1,12),pw3[3]=PKW(P1,14), pw3); \
    l_reg+=sacc; \
    if(GK){DMA_K((t)+3,sl_cur);} if(GV){DMA_V((t)+1,sl_next);} \
    CMASK(C0,C1,t); \
    { float a=MX3(C0[0],C0[1],C1[0]),b=MX3(C0[2],C0[3],C1[1]); a=MX3(a,C1[2],C1[3]); \
      _Pragma("unroll") for(int r=4;r<16;r+=4){a=MX3(a,C0[r],C0[r+1]);b=MX3(b,C0[r+2],C0[r+3]);a=MX3(a,C1[r],C1[r+1]);b=MX3(b,C1[r+2],C1[r+3]);} \
      float rm=__builtin_fmaxf(a,b); { auto rr=__builtin_amdgcn_permlane32_swap(__float_as_uint(rm),__float_as_uint(rm),false,false); rm=__builtin_fmaxf(__uint_as_float(rr[0]),__uint_as_float(rr[1])); } \
      resc=false; \
      if(__builtin_expect(__any(rm>(float)THRL),0)){ const float dl=__builtin_fmaxf(rm,0.f); mhat+=dl; \
        _Pragma("unroll") for(int r=0;r<16;++r){C0[r]-=dl;C1[r]-=dl;} \
        _Pragma("unroll") for(int r=0;r<16;++r)negm[r]=-mhat; asm volatile("":"+v"(negm)); \
        const float f=__builtin_amdgcn_exp2f(-dl); l_reg*=f; if(hi==0)wsf[r32]=f; resc=true; } } \
    SBAR(); \
    GAPB(o[0]=__builtin_amdgcn_mfma_f32_32x32x16_bf16(PAF(0),VFR(0),o[0],0,0,0), C0,0); \
    GAPB(o[1]=__builtin_amdgcn_mfma_f32_32x32x16_bf16(PAF(0),VFR(4),o[1],0,0,0), C0,4); \
    KRD(GL,0); GAPB(o[0]=__builtin_amdgcn_mfma_f32_32x32x16_bf16(PAF(1),VFR(1),o[0],0,0,0), C0,8); \
    KRD(GL,1); GAPB(o[1]=__builtin_amdgcn_mfma_f32_32x32x16_bf16(PAF(1),VFR(5),o[1],0,0,0), C0,12); \
    KRD(GL,2); GAPB(o[0]=__builtin_amdgcn_mfma_f32_32x32x16_bf16(PAF(2),VFR(2),o[0],0,0,0), C1,0); \
    KRD(GL,3); GAPB(o[1]=__builtin_amdgcn_mfma_f32_32x32x16_bf16(PAF(2),VFR(6),o[1],0,0,0), C1,4); \
    GAPB(o[0]=__builtin_amdgcn_mfma_f32_32x32x16_bf16(PAF(3),VFR(3),o[0],0,0,0), C1,8); \
    GAPB(o[1]=__builtin_amdgcn_mfma_f32_32x32x16_bf16(PAF(3),VFR(7),o[1],0,0,0), C1,12); \
    }while(0)
  int t=1;
  #undef CMASK
  #define CMASK(P0,P1,t) do{}while(0)
  for(;t+5<NT;t+=2){
    STEP(pB0,pB1,pA0,pA1,t,true,true,true);     WAIT_BAR(2); RESC(); ROT();
    STEP(pA0,pA1,pB0,pB1,t+1,true,true,true);   WAIT_BAR(2); RESC(); ROT();
  }
  #undef CMASK
  #define CMASK(P0,P1,t) do{}while(0)
  #define ENDW(tt) do{ if((tt)+3<NT){WAIT_BAR(2);} else if((tt)+2<NT){WAIT_BAR(1);} else {WAIT_BAR(0);} }while(0)
  for(;t+1<NT;t+=2){
    STEP(pB0,pB1,pA0,pA1,t,(t+3<NT),(t+1<NT),(t+1<NT));       ENDW(t);   RESC(); ROT();
    STEP(pA0,pA1,pB0,pB1,t+1,(t+4<NT),(t+2<NT),(t+2<NT));     ENDW(t+1); RESC(); ROT();
  }
  STEP(pB0,pB1,pA0,pA1,NT-1,false,false,false); RESC();
  { float sacc=pB0[0]+pB0[1]; _Pragma("unroll") for(int r=2;r<16;++r)sacc+=pB0[r]; _Pragma("unroll") for(int r=0;r<16;++r)sacc+=pB1[r]; l_reg+=sacc;
    pw0=(u32x4){PKW(pB0,0),PKW(pB0,2),PKW(pB0,4),PKW(pB0,6)};pw1=(u32x4){PKW(pB0,8),PKW(pB0,10),PKW(pB0,12),PKW(pB0,14)};pw2=(u32x4){PKW(pB1,0),PKW(pB1,2),PKW(pB1,4),PKW(pB1,6)};pw3=(u32x4){PKW(pB1,8),PKW(pB1,10),PKW(pB1,12),PKW(pB1,14)};
    SBAR(); pv(o,vb0+sl_cur,PAF(0),PAF(1),PAF(2),PAF(3)); }
  #undef PKW
  #undef PAF
  #undef VFR
  #undef PIN
  #undef MX3
  #undef GAPA
  #undef GAPB
  #undef EX
  #undef VRD
  #undef KRD
  #undef STEP
  #undef ENDW
  {auto rr=__builtin_amdgcn_permlane32_swap(__float_as_uint(l_reg),__float_as_uint(l_reg),false,false);l_reg=__uint_as_float(rr[0])+__uint_as_float(rr[1]);}
  if(hi==0)wsf[32+r32]=l_reg;asm volatile("s_waitcnt lgkmcnt(0)":::"memory");
  float rli[16];
  #pragma unroll
  for(int r=0;r<16;++r)rli[r]=__builtin_amdgcn_rcpf(wsf[32+crow(r,hi)]);
  constexpr int OP=768; bf16*Ow=O+(rowbase+q0+wid*QBLK)*OP+h*D;
  { bf16*stg=(bf16*)(shm+LDS_OST)+wid*2048;
    #pragma unroll
    for(int r=0;r<16;++r){const int orow=crow(r,hi);
      #pragma unroll
      for(int d0=0;d0<2;++d0)stg[orow*64+d0*32+r32]=__float2bfloat16(o[d0][r]*rli[r]);}
    asm volatile("s_waitcnt lgkmcnt(0)":::"memory");
    const bf16*Zw=Z+(rowbase+q0+wid*QBLK)*DM+h*D;
    #pragma unroll
    for(int i=0;i<4;++i){const int row=i*8+(lane>>3),ch=lane&7; u32x4 v=*(const u32x4*)(stg+row*64+ch*8); const u32x4 z=*(const u32x4*)(Zw+(long)row*DM+ch*8);
      _Pragma("unroll") for(int e=0;e<4;++e){ const float z0=__uint_as_float(z[e]<<16), z1=__uint_as_float(z[e]&0xffff0000u); const float v0=__uint_as_float(v[e]<<16), v1=__uint_as_float(v[e]&0xffff0000u);
        const float g0=z0*__builtin_amdgcn_rcpf(1.f+__expf(-z0)), g1=z1*__builtin_amdgcn_rcpf(1.f+__expf(-z1)); v[e]=cvtpk_s(v0*g0,v1*g1); }
      if(st_)ATTN_STORE16(Ow+(long)row*OP+ch*8,v);} }
  asm volatile("s_waitcnt lgkmcnt(0)\n\ts_barrier":::"memory");
  #undef DMA_K
  #undef DMA_V
  #undef CMASK
  #undef START
  #undef RESC
  #undef ROT
}
constexpr int ATTN_LDS_BYTES=LDS_BYTES;
struct AttnTensors { const bf16* Q; const bf16* K; const bf16* V; bf16* O; const bf16* Z; };
struct AttnUnit { int b; int h; int qb; };
template<int THRL=8> __device__ __forceinline__ void attn_phase(char*lds,const AttnTensors&T,int vcu,int G,const int wave_id,const bool st_){
  const int x=vcu>>5,c=vcu&31;
  #pragma unroll 1
  for(int i=0;i<6;++i){ const int pair=x*3+(i>>1),u=(i&1)*32+c; attn_unit<THRL>(pair>>1,(pair&1)*4+(u>>4),u&15,T.Q,T.K,T.V,T.O,T.Z,lds,wave_id,st_); }
}
#undef SBAR
#undef WAIT_BAR
}
constexpr int NWAVES = 8;
constexpr int DM_ = 1024, DEPTH = 4, SEQ_ = 4096, MTOT = 98304, MH = 49152, NPROMPT = 65536, PITCH = 3840, NIN = 5888, PLE = 256;
constexpr int C_QA = 0, C_KA = 512, C_VA = 640, C_ZA = 768, C_QB = 1280, C_KB = 2048, C_VB = 2816, C_ZB = 3584, C_GA = 3840, C_GB = 4864;
constexpr size_t MiB = 1u << 20;
constexpr size_t WS_SS = 0;
constexpr size_t WS_TAX = 4 * MiB;
constexpr size_t WS_T1D = 4 * MiB + 65536;
constexpr size_t WS_BAR = 6 * MiB, BAR_BYTES = 16384;
constexpr size_t WS_W = 8 * MiB;
constexpr size_t WL_IN = 0, WL_A = (size_t)5888 * 1024 * 2, WL_B = WL_A + 1 * MiB, WL_O = WL_B + MiB / 2, WL_PGC = WL_O + 2 * MiB  , WL_STRIDE = WL_PGC + 2 * MiB + MiB / 2;
constexpr size_t WS_LSE = 80 * MiB;
constexpr size_t WS_OBG = 84 * MiB;
constexpr size_t WS_BUFA = 132 * MiB;
constexpr size_t WS_PROJ = 228 * MiB;
constexpr size_t WS_GQ8 = 588 * MiB;
constexpr size_t WS_ACAT = 684 * MiB;
constexpr size_t WS_GSCR = 804 * MiB;
constexpr size_t WS_XCAT = 820 * MiB;
constexpr size_t WS_LO = 892 * MiB;
constexpr size_t WS_END = 988 * MiB;
static_assert(WS_W + 4 * WL_STRIDE <= WS_LSE, "weights");
constexpr int LDS_BYTES = 147456;
#define LAS __attribute__((address_space(3)))
typedef unsigned short bf16;
typedef unsigned v4u __attribute__((ext_vector_type(4)));
typedef float f32x4 __attribute__((ext_vector_type(4)));
typedef float f32x16 __attribute__((ext_vector_type(16)));
typedef short bf16x8 __attribute__((ext_vector_type(8)));
typedef short s16x4 __attribute__((ext_vector_type(4)));
typedef float f32x2 __attribute__((ext_vector_type(2)));
__device__ __forceinline__ unsigned f2bf(float f) { unsigned u = __builtin_bit_cast(unsigned, f); return (u + 0x7fffu + ((u >> 16) & 1u)) >> 16; }
__device__ __forceinline__ unsigned pk2(float lo, float hi) { return f2bf(lo) | (f2bf(hi) << 16); }
__device__ __forceinline__ float blo(unsigned w) { return __uint_as_float(w << 16); }
__device__ __forceinline__ float bhi(unsigned w) { return __uint_as_float(w & 0xffff0000u); }
__device__ __forceinline__ float wave_sum(float v, int lane) {
#pragma unroll
    for (int o = 1; o < 64; o <<= 1) v += shx(v, lane, o);
    return v;
}
constexpr float C2F = 0.125f * 1.4426950408889634f;

#ifndef PROBE_P1
#define PROBE_P1 0
#endif
#ifndef PROBE_AA
#define PROBE_AA 0
#endif
#ifndef PROBE_AB
#define PROBE_AB 0
#endif
#ifndef PROBE_P2
#define PROBE_P2 0
#endif
#ifndef PROBE_P4
#define PROBE_P4 0
#endif
#ifndef PROBE_P5
#define PROBE_P5 0
#endif
#ifndef PROBE_P6
#define PROBE_P6 0
#endif
#ifndef PROBE_P7
#define PROBE_P7 0
#endif
#ifndef PROBE_SYNC
#define PROBE_SYNC 0
#endif
#define GSYNC() do { xcd_barrier(xbar); if (PROBE_SYNC) xcd_barrier(xbar); } while (0)
#ifndef STAG1
#define STAG1 110
#endif
__device__ __forceinline__ void stagger_wait(unsigned ticks) { const unsigned long long t0 = __builtin_amdgcn_s_memrealtime(); while (__builtin_amdgcn_s_memrealtime() - t0 < ticks) __builtin_amdgcn_s_sleep(4); }
struct Args { const float* in[15]; float* out; unsigned char* ws; };

template <bool HEADPERM> __device__ __forceinline__ void transpose_item(const float* W, int K, int N, bf16* WT, int ldw, LAS float* scr, int item, int lane, const float* gs = nullptr) {
    const int nblk = N / 32, kb = item / nblk, nb = item % nblk, k0 = 64 * kb, n0 = 32 * nb;
    { f32x4 wv[8];
#pragma unroll
      for (int i = 0; i < 8; ++i) { const int idx = lane + 64 * i, kk = idx >> 3, c4 = idx & 7; wv[i] = __builtin_nontemporal_load((const f32x4*)(W + (size_t)(k0 + kk) * N + n0 + 4 * c4)); }
#pragma unroll
      for (int i = 0; i < 8; ++i) { const int idx = lane + 64 * i, kk = idx >> 3, c4 = idx & 7; const float g_ = gs ? gs[k0 + kk] : 1.f;
          LAS float* d = scr + kk * 33 + 4 * c4; d[0] = wv[i].x * g_; d[1] = wv[i].y * g_; d[2] = wv[i].z * g_; d[3] = wv[i].w * g_; } }
    asm volatile("s_waitcnt lgkmcnt(0)" ::: "memory");
    const int c = lane & 7;
#pragma unroll
    for (int j = 0; j < 4; ++j) { const int n = (lane >> 3) + 8 * j; const LAS float* s = scr + (8 * c) * 33 + n;
        v4u o; o.x = pk2(s[0 * 33], s[1 * 33]); o.y = pk2(s[2 * 33], s[3 * 33]); o.z = pk2(s[4 * 33], s[5 * 33]); o.w = pk2(s[6 * 33], s[7 * 33]);
        int nr = n0 + n; if (HEADPERM) { const int w_ = nr & 255; nr = (nr & ~255) + ((w_ >> 5) & 1) * 128 + (w_ >> 6) * 32 + (w_ & 31); }
        *(v4u*)(WT + (size_t)nr * ldw + k0 + 8 * c) = o; }
    asm volatile("s_waitcnt lgkmcnt(0)" ::: "memory");
}

__device__ __forceinline__ int crow(int r, int hi) { return (r & 3) + 8 * (r >> 2) + 4 * hi; }
__device__ __forceinline__ s16x4 vtr(const LAS char* p) { typedef short v4i16_t __attribute__((ext_vector_type(4))); return __builtin_bit_cast(s16x4, __builtin_amdgcn_ds_read_tr16_b64_v4i16((LAS v4i16_t*)p)); }
__device__ __forceinline__ unsigned cvtpk(float lo, float hi) { typedef __bf16 bf16x2_t __attribute__((ext_vector_type(2))); f32x2 v = {lo, hi}; bf16x2_t b = __builtin_convertvector(v, bf16x2_t); return __builtin_bit_cast(unsigned, b); }
constexpr int AB_KIMG = 0, AB_VIMG = 384 * 144, AB_WST = AB_VIMG + 12 * 4096, AB_LDS = AB_WST + 8 * 4352;
static_assert(AB_LDS <= 143360, "branch-B LDS map");
struct AbRegs { v4u kk[6], vv[6]; bf16x8 qf[4]; };
__device__ __forceinline__ void attnb_load(AbRegs& R, const bf16* P, int b, int hb, int blk, const int wave) {
    const int lane = lane_now(); const int tid = wave * 64 + lane;
    const int g = hb >> 2, sh = 2 * g, L = 4096 >> sh, bprs = 4 - sh;
    const int r = blk >> bprs, M0 = 256 * (blk & ((1 << bprs) - 1));
    const int r32 = lane & 31, hi = lane >> 5;
    const size_t rowbase = (size_t)b * 4096;
#pragma unroll
    for (int s = 0; s < 6; ++s) { const int idx = tid + 512 * s, key = idx >> 3, c = idx & 7; int mk = M0 - 64 + key; mk = mk < 0 ? 0 : (mk > L - 1 ? L - 1 : mk);
        const bf16* rp = P + (rowbase + r + (mk << sh)) * PITCH + hb * 64 + c * 8; R.kk[s] = *(const v4u*)(rp + C_KB); R.vv[s] = *(const v4u*)(rp + C_VB); }
    const int tq = r + ((M0 + 32 * wave + r32) << sh);
    const bf16* qp = P + (rowbase + tq) * PITCH + C_QB + hb * 64 + hi * 8;
#pragma unroll
    for (int d0 = 0; d0 < 4; ++d0) R.qf[d0] = *(const bf16x8*)(qp + d0 * 16);
}
__device__ __forceinline__ void attnb_wg_unit(AbRegs& R, bf16* P, float* LSE, int b, int hb, int blk, bool has_next, int nb, int nhb, int nblk, LAS char* lds_in, const int wave, const bool st_) {
    const int lane = lane_now(); unsigned ldu = (unsigned)(uintptr_t)lds_in; asm volatile("" : "+v"(ldu)); LAS char* lb = (LAS char*)(uintptr_t)ldu;
    const int tid = wave * 64 + lane;
    const int g = hb >> 2, sh = 2 * g, L = 4096 >> sh, bprs = 4 - sh;
    const int r = blk >> bprs, M0 = 256 * (blk & ((1 << bprs) - 1));
    const int r32 = lane & 31, hi = lane >> 5;
    const size_t rowbase = (size_t)b * 4096;
    const int m0 = M0 + 32 * wave;
    const int tq = r + ((m0 + r32) << sh);
#pragma unroll
    for (int s = 0; s < 6; ++s) { const int idx = tid + 512 * s, key = idx >> 3, c = idx & 7;
        *(LAS v4u*)(lb + AB_KIMG + key * 144 + c * 16) = R.kk[s];
        *(LAS v4u*)(lb + AB_VIMG + (key >> 5) * 4096 + (c >> 2) * 2048 + ((key & 31) >> 3) * 512 + (key & 7) * 64 + (c & 3) * 16) = R.vv[s]; }
    bf16x8 qf[4];
#pragma unroll
    for (int d0 = 0; d0 < 4; ++d0) qf[d0] = R.qf[d0];
    __syncthreads();
    if (has_next) attnb_load(R, P, nb, nhb, nblk, wave);
    f32x16 S[5];
#pragma unroll
    for (int kb = 0; kb < 5; ++kb) {
        const LAS char* kp = lb + AB_KIMG + (32 * wave + 32 * kb + r32) * 144 + hi * 16;
        f32x16 s = {};
#pragma unroll
        for (int d0 = 0; d0 < 4; ++d0) s = __builtin_amdgcn_mfma_f32_32x32x16_bf16(*(const LAS bf16x8*)(kp + d0 * 32), qf[d0], s, 0, 0, 0);
        S[kb] = s;
    }
    const int mq = m0 + r32; float mx = -INFINITY;
    if (m0 >= 64 && m0 + 96 <= L) {
        const int rr = r32 - 4 * hi;
#pragma unroll
        for (int q = 0; q < 16; ++q) { const int ck = (q & 3) + 8 * (q >> 2);
            const float v0 = (ck >= rr) ? S[0][q] : -INFINITY, v4 = (ck <= rr) ? S[4][q] : -INFINITY; S[0][q] = v0; S[4][q] = v4;
            mx = fmaxf(mx, fmaxf(fmaxf(v0, v4), fmaxf(S[1][q], fmaxf(S[2][q], S[3][q])))); }
    } else {
#pragma unroll
        for (int kb = 0; kb < 5; ++kb)
#pragma unroll
            for (int q = 0; q < 16; ++q) { const int mk = m0 - 64 + 32 * kb + crow(q, hi); const int dd = mk - mq; const bool ok = (mk >= 0) && (mk < L) && (dd <= 64) && (dd >= -64);
                const float v = ok ? S[kb][q] : -INFINITY; S[kb][q] = v; mx = fmaxf(mx, v); }
    }
    mx = fmaxf(mx, shx(mx, lane, 32));
    float l = 0.f;
#pragma unroll
    for (int kb = 0; kb < 5; ++kb)
#pragma unroll
        for (int q = 0; q < 16; ++q) { const float p = __builtin_amdgcn_exp2f(S[kb][q] - mx); S[kb][q] = p; l += p; }
    l += shx(l, lane, 32);
    f32x16 o0 = {}, o1 = {};
    const LAS char* vrd = lb + AB_VIMG + wave * 4096 + ((lane >> 4) & 1) * 32 + (lane & 3) * 8 + (4 * hi + ((lane & 15) >> 2)) * 64;
#pragma unroll
    for (int kb = 0; kb < 5; ++kb)
#pragma unroll
        for (int s = 0; s < 2; ++s) {
            v4u pw; pw.x = cvtpk(S[kb][8 * s + 0], S[kb][8 * s + 1]); pw.y = cvtpk(S[kb][8 * s + 2], S[kb][8 * s + 3]); pw.z = cvtpk(S[kb][8 * s + 4], S[kb][8 * s + 5]); pw.w = cvtpk(S[kb][8 * s + 6], S[kb][8 * s + 7]);
            const bf16x8 pa = __builtin_bit_cast(bf16x8, pw);
            { const s16x4 lo = vtr(vrd + kb * 4096 + (2 * s) * 512), hh = vtr(vrd + kb * 4096 + (2 * s + 1) * 512);
              const bf16x8 vf = (bf16x8){lo[0], lo[1], lo[2], lo[3], hh[0], hh[1], hh[2], hh[3]};
              o0 = __builtin_amdgcn_mfma_f32_32x32x16_bf16(pa, vf, o0, 0, 0, 0); }
            { const s16x4 lo = vtr(vrd + kb * 4096 + 2048 + (2 * s) * 512), hh = vtr(vrd + kb * 4096 + 2048 + (2 * s + 1) * 512);
              const bf16x8 vf = (bf16x8){lo[0], lo[1], lo[2], lo[3], hh[0], hh[1], hh[2], hh[3]};
              o1 = __builtin_amdgcn_mfma_f32_32x32x16_bf16(pa, vf, o1, 0, 0, 0); }
        }
    LAS char* wl = lb + AB_WST + wave * 4352;
    LAS float* wsf = (LAS float*)(wl + 4096);
    if (hi == 0) { wsf[r32] = l; if (st_) LSE[(rowbase + tq) * 12 + hb] = mx + __builtin_amdgcn_logf(l); }
    asm volatile("s_waitcnt lgkmcnt(0)" ::: "memory");
    LAS bf16* stg = (LAS bf16*)wl;
#pragma unroll
    for (int q = 0; q < 16; ++q) { const int orow = crow(q, hi); const float rl = __builtin_amdgcn_rcpf(wsf[orow]);
        stg[orow * 64 + r32] = (bf16)f2bf(o0[q] * rl); stg[orow * 64 + 32 + r32] = (bf16)f2bf(o1[q] * rl); }
    asm volatile("s_waitcnt lgkmcnt(0)" ::: "memory");
#pragma unroll
    for (int i = 0; i < 4; ++i) { const int row = i * 8 + (lane >> 3), ch = lane & 7; const v4u v = *(const LAS v4u*)(wl + row * 128 + ch * 16);
        if (st_) *(v4u*)(P + (rowbase + r + ((m0 + row) << sh)) * PITCH + C_QB + hb * 64 + ch * 8) = v; }
    asm volatile("s_waitcnt lgkmcnt(0)" ::: "memory");
    __syncthreads();
}

#define XB_TMO      128
#define XB_XCNT(j)  (256  + 64 * (j))
#define XB_XSUB(j)  (1280 + 64 * (j))
#define XB_XGEN(j)  (2304 + 64 * (j))
#define XB_TOP      3328
#define XB_TOPGEN   3392
#define XCD_BAR_WORDS 3456
#define XB_SPIN_CAP (1u << 18)

__device__ __forceinline__ unsigned xb_ld(unsigned* p)              { return __hip_atomic_load(p, __ATOMIC_RELAXED, __HIP_MEMORY_SCOPE_AGENT); }
__device__ __forceinline__ unsigned xb_add(unsigned* p, unsigned v) { return __hip_atomic_fetch_add(p, v, __ATOMIC_RELAXED, __HIP_MEMORY_SCOPE_AGENT); }
__device__ __forceinline__ unsigned xb_xcc_id() { return (unsigned)__builtin_amdgcn_s_getreg((3 << 11) | 20) & 0xFu; }
#define XB_SPIN(cond, bar) do { unsigned _sp = 0; while (cond) { __builtin_amdgcn_s_sleep(1); \
    if ((++_sp & 255u) == 0u) { if (xb_ld(&(bar)[XB_TMO])) break; if (_sp > XB_SPIN_CAP) { atomicAdd(&(bar)[XB_TMO], 1u); break; } } } } while (0)

struct XcdBarrier {
    unsigned* bar; unsigned x;
    volatile LAS unsigned* st;
};

__device__ __forceinline__ XcdBarrier xcd_barrier_post(unsigned* bar, volatile LAS unsigned* st) {
    XcdBarrier b; b.bar = bar; b.x = xb_xcc_id(); b.st = st;
    if (threadIdx.x == 0) (void)xb_add(&bar[XB_XCNT(b.x)], 1u);
    return b;
}
__device__ __forceinline__ void xcd_barrier_complete(unsigned* bar, unsigned x, unsigned& nloc, unsigned& nx) {
    const unsigned G = gridDim.x * gridDim.y * gridDim.z;
    unsigned sum, cnt, mine, sp = 0u;
    for (;;) {
        sum = 0u; cnt = 0u; mine = 0u;
#pragma unroll
        for (unsigned j = 0; j < 16; ++j) { const unsigned c = xb_ld(&bar[XB_XCNT(j)]); sum += c; cnt += (c > 0u) ? 1u : 0u; mine = (j == x) ? c : mine; }
        if (sum == G) break;
        __builtin_amdgcn_s_sleep(1);
        if ((++sp & 255u) == 0u) { if (xb_ld(&bar[XB_TMO])) break; if (sp > XB_SPIN_CAP) { atomicAdd(&bar[XB_TMO], 1u); break; } }
    }
    nloc = mine > 0u ? mine : 1u; nx = cnt > 0u ? cnt : 1u;
}

__device__ __forceinline__ void xcd_barrier(const XcdBarrier& b) {
    asm volatile("s_waitcnt vmcnt(0)" ::: "memory");
    __syncthreads();
    if (threadIdx.x == 0) {
        unsigned* bar = b.bar;
        __builtin_amdgcn_s_waitcnt(0);
        unsigned nloc = b.st[0], nx = b.st[1];
        if (nloc == 0u) { xcd_barrier_complete(bar, b.x, nloc, nx); b.st[0] = nloc; b.st[1] = nx; }
        const unsigned old = xb_add(&bar[XB_XSUB(b.x)], 1u);
        const unsigned gen = old / nloc;
        if (old + 1u == (gen + 1u) * nloc) {
            __builtin_amdgcn_fence(__ATOMIC_RELEASE, "agent");
            asm volatile("s_waitcnt vmcnt(0)" ::: "memory");
            const unsigned og = xb_add(&bar[XB_TOP], 1u);
            const unsigned tg = og / nx;
            if (og + 1u == (tg + 1u) * nx) xb_add(&bar[XB_TOPGEN], 1u);
            else XB_SPIN(xb_ld(&bar[XB_TOPGEN]) == tg, bar);
            __builtin_amdgcn_fence(__ATOMIC_ACQUIRE, "agent");
            xb_add(&bar[XB_XGEN(b.x)], 1u);
            asm volatile("s_waitcnt vmcnt(0)" ::: "memory");
        } else {
            XB_SPIN(xb_ld(&bar[XB_XGEN(b.x)]) == gen, bar);
            __builtin_amdgcn_fence(__ATOMIC_ACQUIRE, "agent");
            asm volatile("s_waitcnt vmcnt(0)" ::: "memory");
        }
    }
    __syncthreads();
}

__global__ void __launch_bounds__(NWAVES * 64, 2) fwd_mega(Args args) {
    extern __shared__ __attribute__((aligned(16))) unsigned char lds[];
    cg::grid_group grid = cg::this_grid();
    LAS unsigned char* ldsl = (LAS unsigned char*)lds;
    const int wave = __builtin_amdgcn_readfirstlane(threadIdx.x >> 6); int tidv = wave * 64 + lane_now();
#define LAUNDER() do { tidv = wave * 64 + lane_now(); asm volatile("" : "+s"(bxv)); } while (0)
#define lane (tidv & 63)
#define gt (bx * (NWAVES * 64) + tidv)
    const int G = gridDim.x; int bxv = blockIdx.x; asm volatile("" : "+s"(bxv));
#define bx bxv
#define vcu ((bxv % 8) * (G / 8) + bxv / 8)
#define gw (vcu * NWAVES + wave)
    const int NGW = G * NWAVES;
    const int NGT = G * NWAVES * 64;
    unsigned char* ws = args.ws;
    const float* x_prompt = args.in[0]; const float* x_sample = args.in[1]; const float* p_prompt = args.in[2]; const float* p_sample = args.in[3];
    const float* g_norm = args.in[4]; const float* w_in = args.in[5]; const float* g_q = args.in[6]; const float* g_k = args.in[7];
    const float* w_a = args.in[8]; const float* w_b = args.in[9]; const float* w_o = args.in[10]; const float* w_ple = args.in[11];
    const float* g_ple = args.in[12]; const float* w_pg = args.in[13]; const float* g_final = args.in[14];
    float* H = args.out;
    const bool never = (args.ws == nullptr);
    float* SS = (float*)(ws + WS_SS);
    f32x2* TAX = (f32x2*)(ws + WS_TAX); f32x2* T1D = (f32x2*)(ws + WS_T1D);
    float* LSE = (float*)(ws + WS_LSE);
    bf16* XCAT = (bf16*)(ws + WS_XCAT); bf16* HI0 = (bf16*)(ws + WS_BUFA); bf16* PROJ = (bf16*)(ws + WS_PROJ); bf16* MRG = PROJ; bf16* LO = (bf16*)(ws + WS_LO);
    bf16* ACAT = (bf16*)(ws + WS_ACAT); unsigned* GSCR = (unsigned*)(ws + WS_GSCR); unsigned char* GQ8 = ws + WS_GQ8;

    volatile LAS unsigned* bst = (volatile LAS unsigned*)(ldsl + 143360);
    if (threadIdx.x < 2) bst[threadIdx.x] = 0u;
    __syncthreads();
    XcdBarrier xbar; xbar.bar = (unsigned*)(ws + WS_BAR); xbar.x = 0; xbar.st = bst;
    if (blockIdx.x == 0) for (int i = threadIdx.x; i < (int)(BAR_BYTES / 4); i += NWAVES * 64) ((unsigned*)(ws + WS_BAR))[i] = 0u;
    for (int i = gt + MTOT / 4; i < 9 * MTOT / 4; i += NGT) ((f32x4*)SS)[i] = (f32x4){0.f, 0.f, 0.f, 0.f};
    for (int i = gt; i < 64 * 16 + 4096 * 32; i += NGT) {
        int pos, k; float ex; f32x2* dst;
        if (i < 1024) { pos = i >> 4; k = i & 15; ex = (float)(2 * k) / 32.f; dst = TAX + i; }
        else { const int j = i - 1024; pos = j >> 5; k = j & 31; ex = (float)(2 * k) / 64.f; dst = T1D + j; }
        const float freq = exp2f(-ex * 13.287712379549449f);
        double rev = (double)pos * (double)freq * 0.15915494309189535; rev -= floor(rev);
        const float rf = (float)rev;
        *dst = (f32x2){__builtin_amdgcn_cosf(rf), __builtin_amdgcn_sinf(rf)};
    }
    {
        LAS float* scr = (LAS float*)(ldsl + wave * 16384);
        constexpr int I_IN = 16 * 184, I_A = 8 * 32, I_B = 4 * 32, I_O = 16 * 32, I_PLE = 4 * 32, I_PG = 16 * 32, I_L = I_IN + I_A + I_B + I_O + I_PLE + I_PG;
        for (int it = gw; it < DEPTH * I_L; it += NGW) {
            const int layer = it / I_L; int r = it % I_L; unsigned char* wl = ws + WS_W + (size_t)layer * WL_STRIDE;
            if (r < I_IN) { transpose_item<true>(w_in + (size_t)layer * 1024 * 5888, 1024, 5888, (bf16*)(wl + WL_IN), 1024, scr, r, lane, g_norm + layer * 1024); continue; } r -= I_IN;
            if (r < I_A) { transpose_item<false>(w_a + (size_t)layer * 512 * 1024, 512, 1024, (bf16*)(wl + WL_A), 768, scr, r, lane); continue; } r -= I_A;
            if (r < I_B) { transpose_item<false>(w_b + (size_t)layer * 256 * 1024, 256, 1024, (bf16*)(wl + WL_A) + 512, 768, scr, r, lane); continue; } r -= I_B;
            if (r < I_O) { transpose_item<false>(w_o + (size_t)layer * 1024 * 1024, 1024, 1024, (bf16*)(wl + WL_O), 1024, scr, r, lane); continue; } r -= I_O;
            if (r < I_PLE) { transpose_item<false>(w_ple + (size_t)layer * 256 * 1024, 256, 1024, (bf16*)(wl + WL_PGC) + 1024, 1280, scr, r, lane); continue; } r -= I_PLE;
            transpose_item<false>(w_pg + (size_t)layer * 1024 * 1024, 1024, 1024, (bf16*)(wl + WL_PGC), 1280, scr, r, lane, g_ple + layer * 1024);
        }
    }

#pragma unroll 1
    for (int half = 0; half < 2; ++half) {
        const int grow0 = half * MH;
            LAUNDER();
        for (int lr0 = gw; lr0 < MH; lr0 += 2 * NGW) {
            f32x4 v[2][4]; const f32x4* xr[2];
#pragma unroll
            for (int k = 0; k < 2; ++k) { const int lr = lr0 + k * NGW < MH ? lr0 + k * NGW : lr0; const int gr = grow0 + lr;
                xr[k] = (const f32x4*)(gr < NPROMPT ? x_prompt + (size_t)gr * 1024 : x_sample + (size_t)(gr - NPROMPT) * 1024); }
#pragma unroll
            for (int k = 0; k < 2; ++k)
#pragma unroll
                for (int j = 0; j < 4; ++j) v[k][j] = __builtin_nontemporal_load(xr[k] + lane + 64 * j);
#pragma unroll
            for (int k = 0; k < 2; ++k) { const int lr = lr0 + k * NGW; if (lr < MH) { const int gr = grow0 + lr; float s = 0.f;
#pragma unroll
                for (int j = 0; j < 4; ++j) s += (v[k][j].x * v[k][j].x + v[k][j].y * v[k][j].y) + (v[k][j].z * v[k][j].z + v[k][j].w * v[k][j].w);
                s = wave_sum(s, lane); if (lane == 0) SS[gr] = s;
#pragma unroll
                for (int j = 0; j < 4; ++j) { const f32x4 x_ = v[k][j]; const unsigned h0 = pk2(x_.x, x_.y), h1 = pk2(x_.z, x_.w);
                    const unsigned l0 = pk2(x_.x - blo(h0), x_.y - bhi(h0)), l1 = pk2(x_.z - blo(h1), x_.w - bhi(h1));
                    ((unsigned long long*)(HI0 + (size_t)lr * 1024))[lane + 64 * j] = (unsigned long long)h0 | ((unsigned long long)h1 << 32);
                    ((unsigned long long*)(LO + (size_t)lr * 1024))[lane + 64 * j] = (unsigned long long)l0 | ((unsigned long long)l1 << 32); } } }
        }
        if (half == 0) { grid.sync(); xbar = xcd_barrier_post((unsigned*)(ws + WS_BAR), bst); } else GSYNC();
#pragma unroll 1
        for (int layer = 0; layer < DEPTH; ++layer) {
            unsigned char* wl = ws + WS_W + (size_t)layer * WL_STRIDE;
            LAUNDER();
            { pg8::Gemm g{HI0, (const bf16*)(wl + WL_IN), MH, NIN, 1024, 1024}; pg8::StaticOrder S; S.init(MH, NIN, G, bx);
              pg8::EpiProj E{PROJ, PITCH, SS + (size_t)layer * MTOT, grow0, g_q + layer * 64, g_k + layer * 64, (const pg8::f32x2e*)TAX, (const pg8::f32x2e*)T1D, GQ8};
#ifndef PROBE_P1K
#define PROBE_P1K 0
#endif
              if (PROBE_P1K) { LAUNDER(); pg8::EpiNull EN{}; pg8::gemm_phase<pg8::EpiNull, pg8::StaticOrder, true, true>(ldsl, g, S, EN, wave); }
              for (int rep_ = 0; rep_ < 1 + PROBE_P1; ++rep_) { LAUNDER(); pg8::gemm_phase<pg8::EpiProj, pg8::StaticOrder, true, true>(ldsl, g, S, E, wave); } }
            GSYNC();
            LAUNDER();
            { const attn_body::AttnTensors AT{(const attn_body::bf16*)(PROJ + C_QA), (const attn_body::bf16*)(PROJ + C_KA), (const attn_body::bf16*)(PROJ + C_VA), (attn_body::bf16*)XCAT, (const attn_body::bf16*)(PROJ + C_ZA)};
              for (int rep_ = PROBE_AA ? 0 : 1; rep_ < 2; ++rep_) { LAUNDER(); attn_body::attn_phase<8>((char*)lds, AT, vcu, G, wave, rep_ == 1 || never); } }
            __syncthreads();
            LAUNDER();
            { for (int rep_ = PROBE_AB ? 0 : 1; rep_ < 2; ++rep_) { LAUNDER();
              const int cx = vcu & 31, xq = vcu >> 5;
              AbRegs R; { const int pair = xq * 18 + (cx >> 4); attnb_load(R, PROJ, pair / 12, pair % 12, cx & 15, wave); }
#pragma unroll 1
              for (int i = 0; i < 9; ++i) { const int pair = xq * 18 + i * 2 + (cx >> 4); const int b = pair / 12, hb = pair - b * 12; const int np = pair + 2, nb = np / 12, nhb = np - nb * 12;
                  attnb_wg_unit(R, PROJ, LSE, b, hb, cx & 15, i < 8, nb, nhb, cx & 15, (LAS char*)ldsl, wave, rep_ == 1 || never); } } }
            GSYNC();
            LAUNDER();
            for (int rep_ = 0; rep_ < 1 + PROBE_P4; ++rep_) { LAUNDER();
            for (int it0 = gt; it0 < MH * 32; it0 += 4 * NGT) {
                v4u a[4], bq[4], cq[4], z[4]; float l0[4], l1[4], l2[4];
#pragma unroll
                for (int k = 0; k < 4; ++k) { const int it = it0 + k * NGT < MH * 32 ? it0 + k * NGT : it0; const int lr = it >> 5, cc = it & 31, hh = cc >> 3, c = cc & 7;
                    const bf16* rp = PROJ + (size_t)lr * PITCH;
                    a[k] = *(const v4u*)(rp + C_QB + hh * 64 + c * 8); bq[k] = *(const v4u*)(rp + C_QB + (4 + hh) * 64 + c * 8); cq[k] = *(const v4u*)(rp + C_QB + (8 + hh) * 64 + c * 8); z[k] = *(const v4u*)(rp + C_ZB + hh * 64 + c * 8);
                    l0[k] = LSE[(size_t)lr * 12 + hh]; l1[k] = LSE[(size_t)lr * 12 + 4 + hh]; l2[k] = LSE[(size_t)lr * 12 + 8 + hh]; }
#pragma unroll
                for (int k = 0; k < 4; ++k) { const int it = it0 + k * NGT; if (it < MH * 32) { const int lr = it >> 5, cc = it & 31;
                    const float mx = fmaxf(l0[k], fmaxf(l1[k], l2[k])); float w0 = __builtin_amdgcn_exp2f(l0[k] - mx), w1 = __builtin_amdgcn_exp2f(l1[k] - mx), w2 = __builtin_amdgcn_exp2f(l2[k] - mx);
                    const float inv = __builtin_amdgcn_rcpf(w0 + w1 + w2); w0 *= inv; w1 *= inv; w2 *= inv;
                    v4u o;
#pragma unroll
                    for (int e = 0; e < 4; ++e) { const float z0 = blo(z[k][e]), z1 = bhi(z[k][e]);
                        const float s0 = z0 * __builtin_amdgcn_rcpf(1.f + __expf(-z0)), s1 = z1 * __builtin_amdgcn_rcpf(1.f + __expf(-z1));
                        o[e] = pk2((w0 * blo(a[k][e]) + w1 * blo(bq[k][e]) + w2 * blo(cq[k][e])) * s0, (w0 * bhi(a[k][e]) + w1 * bhi(bq[k][e]) + w2 * bhi(cq[k][e])) * s1); }
                    *(v4u*)(XCAT + (size_t)lr * 768 + 512 + cc * 8) = o; } }
            } }
            LAUNDER();
            for (int it0 = gt; it0 < MH * 32; it0 += 4 * NGT) {
                f32x4 a[4], bq[4];
#pragma unroll
                for (int k = 0; k < 4; ++k) { const int it = it0 + k * NGT < MH * 32 ? it0 + k * NGT : it0; const int lr = it >> 5, c = it & 31, gr = grow0 + lr;
                    const float* pr = gr < NPROMPT ? p_prompt + ((size_t)layer * NPROMPT + gr) * PLE : p_sample + ((size_t)layer * (MTOT - NPROMPT) + (gr - NPROMPT)) * PLE;
                    a[k] = __builtin_nontemporal_load((const f32x4*)pr + 2 * c); bq[k] = __builtin_nontemporal_load((const f32x4*)pr + 2 * c + 1); }
#pragma unroll
                for (int k = 0; k < 4; ++k) { const int it = it0 + k * NGT; if (it < MH * 32) { const int lr = it >> 5, c = it & 31;
                    v4u o; o.x = pk2(a[k].x, a[k].y); o.y = pk2(a[k].z, a[k].w); o.z = pk2(bq[k].x, bq[k].y); o.w = pk2(bq[k].z, bq[k].w); *(v4u*)(ACAT + (size_t)lr * 1280 + 1024 + c * 8) = o; } }
            }
            GSYNC();
            LAUNDER();
            for (int rep_ = 0; rep_ < 1 + PROBE_P5; ++rep_) {
            LAUNDER();
            { LAS float* gtab = (LAS float*)(ldsl + 131072);
              if (tidv < 256) { const float ex_ = __expf(-((float)tidv * 0.0625f - 8.f)); gtab[tidv] = __builtin_amdgcn_rcpf(1.f + ex_); gtab[256 + tidv] = 1.f + ex_; }
              __syncthreads(); }
            { pg8::Gemm g{XCAT, (const bf16*)(wl + WL_A), MH, 1024, 768, 768}; pg8::StaticOrder S; S.init(MH, 1024, G, bx, true);
              pg8::EpiMerge E{MRG, 1024, GQ8, (const LAS float*)(ldsl + 131072)};
              pg8::gemm_phase<pg8::EpiMerge, pg8::StaticOrder, true, true>(ldsl, g, S, E, wave); } }
            GSYNC();
            LAUNDER();
            for (int rep_ = PROBE_P6 ? 0 : 1; rep_ < 2; ++rep_) {
            LAUNDER();
            { pg8::Gemm g{MRG, (const bf16*)(wl + WL_O), MH, 1024, 1024, 1024}; pg8::StaticOrder S; S.init(MH, 1024, G, bx);
              pg8::EpiMix E{HI0, 1024, LO, ACAT, 1280, SS + (size_t)(5 + layer) * MTOT, grow0, rep_ == 1 || never};
              pg8::gemm_phase<pg8::EpiMix, pg8::StaticOrder, true, true>(ldsl, g, S, E, wave); }
            }
            GSYNC();
            LAUNDER();
            for (int rep_ = PROBE_P7 ? 0 : 1; rep_ < 2; ++rep_) {
            LAUNDER();
            { pg8::Gemm g{ACAT, (const bf16*)(wl + WL_PGC), MH, 1024, 1280, 1280}; pg8::StaticOrder S; S.init(MH, 1024, G, bx, true);
              pg8::EpiPle E{ACAT, 1280, LO, layer < DEPTH - 1 ? HI0 : nullptr, H, SS + (size_t)(5 + layer) * MTOT, SS + (size_t)(layer + 1) * MTOT, grow0, GSCR + (size_t)bx * (32 * 512), rep_ == 1 || never};
              pg8::gemm_phase<pg8::EpiPle, pg8::StaticOrder, true, true>(ldsl, g, S, E, wave); } }
            GSYNC();
        }
        LAUNDER();
        for (int lr0 = gw; lr0 < MH; lr0 += 4 * NGW) {
            f32x4 v[4][4]; float rs[4];
#pragma unroll
            for (int k = 0; k < 4; ++k) { const int gr = grow0 + (lr0 + k * NGW < MH ? lr0 + k * NGW : lr0); rs[k] = SS[(size_t)4 * MTOT + gr];
#pragma unroll
                for (int j = 0; j < 4; ++j) v[k][j] = ((const f32x4*)(H + (size_t)gr * 1024))[lane + 64 * j]; }
#pragma unroll
            for (int k = 0; k < 4; ++k) { const int lr = lr0 + k * NGW; if (lr < MH) { const int gr = grow0 + lr; const float r_ = __builtin_amdgcn_rsqf(rs[k] * (1.f / 1024.f) + 1e-6f);
#pragma unroll
                for (int j = 0; j < 4; ++j) { const f32x4 gg = ((const f32x4*)g_final)[lane + 64 * j]; __builtin_nontemporal_store(v[k][j] * gg * r_, (f32x4*)(H + (size_t)gr * 1024) + lane + 64 * j); } } }
        }
    }
}

#undef lane
#undef gt
#undef bx
#undef vcu
#undef gw
extern "C" void kernel_launch(void* const* d_in, const int* in_sizes, int n_in, void* d_out, int out_size, void* d_ws, size_t ws_size, hipStream_t stream) {
    static int grid = 0;
    if (grid == 0) {
        if (n_in != 15 || out_size != MTOT * DM_ || ws_size < WS_END) { fprintf(stderr, "kernel_launch: unexpected shapes (n_in %d out %d ws %zu)\n", n_in, out_size, ws_size); grid = -1; return; }
        int dev = 0, cus = 0, per_cu = 0;
        (void)hipGetDevice(&dev); (void)hipDeviceGetAttribute(&cus, hipDeviceAttributeMultiprocessorCount, dev);
        (void)hipFuncSetAttribute((const void*)fwd_mega, hipFuncAttributeMaxDynamicSharedMemorySize, LDS_BYTES);
        (void)hipOccupancyMaxActiveBlocksPerMultiprocessor(&per_cu, (const void*)fwd_mega, NWAVES * 64, LDS_BYTES);
        if (per_cu < 1) per_cu = 1;
        grid = cus * per_cu;
        (void)hipGetLastError();
    }
    if (grid < 0) return;
    Args a{};
    for (int i = 0; i < 15; ++i) a.in[i] = (const float*)d_in[i];
    a.out = (float*)d_out; a.ws = (unsigned char*)d_ws;
    void* kargs[] = {&a};
    hipError_t e = hipLaunchCooperativeKernel((const void*)fwd_mega, dim3(grid), dim3(NWAVES * 64), kargs, LDS_BYTES, stream);
    if (e != hipSuccess) fprintf(stderr, "cooperative launch failed: %s (grid %d)\n", hipGetErrorString(e), grid);
}
```

```cpp
#include <hip/hip_runtime.h>
#include <hip/hip_cooperative_groups.h>
namespace cg = cooperative_groups;
__device__ __forceinline__ float shx(float v, int lane, int m) { return __builtin_bit_cast(float, __builtin_amdgcn_ds_bpermute((lane ^ m) << 2, __builtin_bit_cast(int, v))); }
__device__ __forceinline__ int lane_now() { int l; asm volatile("v_mbcnt_lo_u32_b32 %0, -1, 0\n\tv_mbcnt_hi_u32_b32 %0, -1, %0" : "=v"(l)); return l; }
#include <hip/hip_runtime.h>
#include <cstdio>
#include <cstdint>
namespace pg8 {
#define PG8_LAS __attribute__((address_space(3)))
typedef unsigned short bf16_t;
typedef short bf16x8 __attribute__((ext_vector_type(8)));
typedef float f32x4 __attribute__((ext_vector_type(4)));
typedef unsigned u32x4 __attribute__((ext_vector_type(4)));
constexpr int BM = 256, BK = 64, HALF = 128, HTB = HALF * BK * 2  , STAGE_BYTES = 8 * HTB, NXCD = 8, WGM = 4;

__host__ __device__ __forceinline__ int lds_byte(int r, int c) { const int st = (r >> 4) * 2 + (c >> 5), rr = r & 15, cc = c & 31, ob = rr * 64 + cc * 2; return st * 1024 + (ob ^ (((ob >> 9) & 1) << 5)); }
__host__ __device__ __forceinline__ void stage_rc(int b, int& R, int& C) { const int st = b / 1024, sb = b % 1024, swz = sb ^ (((sb >> 9) & 1) << 5); R = (st >> 1) * 16 + swz / 64; C = (st & 1) * 32 + (swz % 64) / 2; }
__host__ __device__ __forceinline__ int perm32(int rho) { const int n = rho >> 4, i = rho & 15; return 8 * (i >> 2) + 4 * n + (i & 3); }

struct Unit { int pm, pn; };
struct Gemm { const bf16_t* A; const bf16_t* Bt; int M, N, K, lda; };

struct StaticOrder {
    int nM, nN, nwg, G, c, cnt; bool rev;
    __host__ __device__ void init(int M, int N, int G_, int c_, bool rev_ = false) { nM = M / BM; nN = N / BM; nwg = nM * nN; G = G_; c = c_; rev = rev_; cnt = c < nwg ? (nwg - c + G - 1) / G : 0; }
    __host__ __device__ bool next(int i, Unit& u) const {
        if (i >= cnt) return false; const long L = (long)(rev ? cnt - 1 - i : i) * G + c;
        int wgid = (int)L; { const int q = nwg / NXCD, r = nwg % NXCD, xcd = wgid % NXCD, off = wgid / NXCD; wgid = (xcd < r ? xcd * (q + 1) : r * (q + 1) + (xcd - r) * q) + off; }
        const int nig = WGM * nN, gid = wgid / nig, fm = gid * WGM, gsz = (nM - fm) < WGM ? (nM - fm) : WGM;
        u.pm = fm + ((wgid % nig) % gsz); u.pn = (wgid % nig) / gsz; return true;
    }
    __device__ __forceinline__ void a_ready(const Unit&) const {}
    __device__ __forceinline__ void done(const Unit&) const {}
};

template <class Epi, class Sched, bool ALIGN_EPI = false, bool SP2 = false>
__device__ __forceinline__ void gemm_phase(PG8_LAS unsigned char* lds, const Gemm g, const Sched& S, const Epi& E, const int wave_id) {
    const int tid = wave_id * 64 + lane_now(), wid = wave_id, lane = tid & 63, wr = wid >> 2, wc = wid & 3, fr = lane & 15, fq = lane >> 4;
    const int K = g.K, nt = K / BK;
    unsigned voffA[2], voffB[2];
#pragma unroll
    for (int i = 0; i < 2; ++i) { int R, C; stage_rc(tid * 16 + i * 8192, R, C); const int Rb = Epi::PERM ? ((R & ~31) + perm32(R & 31)) : R;
        voffA[i] = (unsigned)(R * g.lda + C) * 2u; voffB[i] = (unsigned)(Rb * K + C) * 2u; }
    const size_t kstep = (size_t)(BK * 2);
    const size_t hstep = (size_t)HALF * K * 2;
    const size_t tstep = 2 * hstep; const size_t hstepA = (size_t)HALF * g.lda * 2, tstepA = 2 * hstepA;
    const unsigned ldsw = (unsigned)wid * 1024u;
    const int aoff = lds_byte(wr * 64 + fr, fq * 8), boff = lds_byte(wc * 32 + fr, fq * 8);
#define PG8_SA(b, h) (((b) * 2 + (h)) * HTB)
#define PG8_SB(b, h) ((4 + (b) * 2 + (h)) * HTB)
#define PG8_STAGE(bufoff, gbase, voff) do { _Pragma("unroll") for (int _i = 0; _i < 2; ++_i) \
        __builtin_amdgcn_global_load_lds((const unsigned*)((const char*)(gbase) + (voff)[_i]), (PG8_LAS unsigned*)(lds + (bufoff) + ldsw + _i * 8192), 16, 0, 0); } while (0)
#define PG8_LDA(dst, b, h) do { _Pragma("unroll") for (int m = 0; m < 4; ++m) _Pragma("unroll") for (int k = 0; k < 2; ++k) dst[m][k] = *(const PG8_LAS bf16x8*)(lds + PG8_SA(b, h) + aoff + m * 2048 + k * 1024); } while (0)
#define PG8_LDB(dst, b, h) do { _Pragma("unroll") for (int n = 0; n < 2; ++n) _Pragma("unroll") for (int k = 0; k < 2; ++k) dst[n][k] = *(const PG8_LAS bf16x8*)(lds + PG8_SB(b, h) + boff + n * 2048 + k * 1024); } while (0)
#define PG8_MMA(ai, bj, At, Bt) do { __builtin_amdgcn_s_setprio(1); _Pragma("unroll") for (int m = 0; m < 4; ++m) _Pragma("unroll") for (int n = 0; n < 2; ++n) _Pragma("unroll") for (int k = 0; k < 2; ++k) \
        acc[ai][bj][m][n] = __builtin_amdgcn_mfma_f32_16x16x32_bf16(Bt[n][k], At[m][k], acc[ai][bj][m][n], 0, 0, 0); __builtin_amdgcn_s_setprio(0); } while (0)
#define PG8_WAIT_V(n) asm volatile("s_waitcnt vmcnt(" #n ")" ::: "memory")
#define PG8_WAIT_L(n) asm volatile("s_waitcnt lgkmcnt(" #n ")" ::: "memory")
#define PG8_BAR __builtin_amdgcn_s_barrier()
#define PG8_SCHED __builtin_amdgcn_sched_barrier(0)
    Unit cur, nxt; int ui = 0;
    if (!S.next(0, cur)) return;
    f32x4 acc[2][2][4][2];
#pragma unroll
    for (int a = 0; a < 2; ++a)
#pragma unroll
        for (int b = 0; b < 2; ++b)
#pragma unroll
            for (int m = 0; m < 4; ++m)
#pragma unroll
                for (int n = 0; n < 2; ++n) acc[a][b][m][n] = (f32x4){0.f, 0.f, 0.f, 0.f};
    bf16x8 At[4][2], B0[2][2], B1[2][2];
    const char* cA = (const char*)g.A + (size_t)cur.pm * tstepA; const char* cB = (const char*)g.Bt + (size_t)cur.pn * tstep;
    S.a_ready(cur);
    if constexpr (SP2) {
        PG8_STAGE(PG8_SB(0, 0), cB, voffB); PG8_STAGE(PG8_SB(0, 1), cB + hstep, voffB); PG8_STAGE(PG8_SA(0, 0), cA, voffA); PG8_STAGE(PG8_SA(0, 1), cA + hstepA, voffA);
        if (wr == 1) PG8_BAR;
        PG8_WAIT_V(2); PG8_BAR;
        PG8_STAGE(PG8_SB(1, 0), cB + kstep, voffB); PG8_STAGE(PG8_SA(1, 0), cA + kstep, voffA); PG8_STAGE(PG8_SB(1, 1), cB + hstep + kstep, voffB);
        PG8_WAIT_V(6); PG8_BAR;
    } else {
        PG8_STAGE(PG8_SB(0, 0), cB, voffB); PG8_STAGE(PG8_SA(0, 0), cA, voffA); PG8_STAGE(PG8_SB(0, 1), cB + hstep, voffB); PG8_STAGE(PG8_SA(0, 1), cA + hstepA, voffA);
        if (wr == 1) PG8_BAR;
        PG8_WAIT_V(4); PG8_BAR;
        PG8_STAGE(PG8_SB(1, 0), cB + kstep, voffB); PG8_STAGE(PG8_SA(1, 0), cA + kstep, voffA); PG8_STAGE(PG8_SB(1, 1), cB + hstep + kstep, voffB);
        PG8_WAIT_V(6); PG8_BAR;
    }
    for (;;) {
        const bool has_next = S.next(ui + 1, nxt);
        const char* nA = has_next ? (const char*)g.A + (size_t)nxt.pm * tstepA : cA; const char* nB = has_next ? (const char*)g.Bt + (size_t)nxt.pn * tstep : cB;
        for (int t = 0; t < nt; t += 2) {
            const bool last = (t == nt - 2);
            if constexpr (Epi::HAS_MID) { if (t == Epi::MID_T) E.mid(acc, cur, wr, wc); }
            const char* a1 = cA + (size_t)(t + 1) * kstep;
            const char* a2 = last ? nA : cA + (size_t)(t + 2) * kstep; const char* b2 = last ? nB : cB + (size_t)(t + 2) * kstep;
            const char* a3 = a2 + kstep; const char* b3 = b2 + kstep;
            if (last && has_next) S.a_ready(nxt);
            if constexpr (SP2) {
            PG8_LDB(B0, 0, 0); PG8_LDB(B1, 0, 1); PG8_SCHED; PG8_LDA(At, 0, 0); PG8_STAGE(PG8_SA(1, 1), a1 + hstepA, voffA);
            PG8_WAIT_V(8); PG8_WAIT_L(0); PG8_BAR; PG8_MMA(0, 0, At, B0); PG8_MMA(0, 1, At, B1); PG8_BAR; PG8_SCHED;
            PG8_LDA(At, 0, 1); PG8_STAGE(PG8_SB(0, 0), b2, voffB); PG8_STAGE(PG8_SB(0, 1), b2 + hstep, voffB); PG8_STAGE(PG8_SA(0, 0), a2, voffA);
            PG8_WAIT_V(8); PG8_WAIT_L(0); PG8_BAR; PG8_MMA(1, 0, At, B0); PG8_MMA(1, 1, At, B1); PG8_BAR; PG8_SCHED;
            PG8_LDB(B0, 1, 0); PG8_LDB(B1, 1, 1); PG8_SCHED; PG8_LDA(At, 1, 0); PG8_STAGE(PG8_SA(0, 1), a2 + hstepA, voffA);
            PG8_WAIT_V(8); PG8_WAIT_L(0); PG8_BAR; PG8_MMA(0, 0, At, B0); PG8_MMA(0, 1, At, B1); PG8_BAR; PG8_SCHED;
            PG8_LDA(At, 1, 1); PG8_STAGE(PG8_SB(1, 0), b3, voffB); PG8_STAGE(PG8_SB(1, 1), b3 + hstep, voffB); PG8_STAGE(PG8_SA(1, 0), a3, voffA);
            PG8_WAIT_V(8); PG8_WAIT_L(0); PG8_BAR; PG8_MMA(1, 0, At, B0); PG8_MMA(1, 1, At, B1); PG8_BAR; PG8_SCHED;
            } else {
            PG8_LDB(B0, 0, 0); PG8_SCHED; PG8_LDA(At, 0, 0); PG8_STAGE(PG8_SA(1, 1), a1 + hstepA, voffA);
            PG8_WAIT_L(8); PG8_BAR; PG8_WAIT_L(0); PG8_MMA(0, 0, At, B0); PG8_BAR; PG8_SCHED;
            PG8_LDB(B1, 0, 1); PG8_STAGE(PG8_SB(0, 0), b2, voffB);
            PG8_BAR; PG8_WAIT_L(0); PG8_MMA(0, 1, At, B1); PG8_BAR;
            PG8_LDA(At, 0, 1); PG8_STAGE(PG8_SA(0, 0), a2, voffA);
            PG8_BAR; PG8_WAIT_L(0); PG8_MMA(1, 0, At, B0); PG8_BAR; PG8_SCHED;
            PG8_STAGE(PG8_SB(0, 1), b2 + hstep, voffB);
            PG8_WAIT_V(6); PG8_BAR; PG8_MMA(1, 1, At, B1); PG8_BAR;
            PG8_LDB(B0, 1, 0); PG8_SCHED; PG8_LDA(At, 1, 0); PG8_STAGE(PG8_SA(0, 1), a2 + hstepA, voffA);
            PG8_WAIT_L(8); PG8_BAR; PG8_WAIT_L(0); PG8_MMA(0, 0, At, B0); PG8_BAR; PG8_SCHED;
            PG8_LDB(B1, 1, 1); PG8_STAGE(PG8_SB(1, 0), b3, voffB);
            PG8_BAR; PG8_WAIT_L(0); PG8_MMA(0, 1, At, B1); PG8_BAR;
            PG8_LDA(At, 1, 1); PG8_STAGE(PG8_SA(1, 0), a3, voffA);
            PG8_BAR; PG8_WAIT_L(0); PG8_MMA(1, 0, At, B0); PG8_BAR; PG8_SCHED;
            PG8_STAGE(PG8_SB(1, 1), b3 + hstep, voffB);
            PG8_WAIT_V(6); PG8_BAR; PG8_MMA(1, 1, At, B1); PG8_BAR;
            }
        }
        if constexpr (ALIGN_EPI) { if (wr == 0) PG8_BAR; }
        if constexpr (!Epi::AFTER_DRAIN) { E(acc, cur, wr, wc, fr, fq); S.done(cur); }
        if (!has_next) break;
#pragma unroll
        for (int a = 0; a < 2; ++a)
#pragma unroll
            for (int b = 0; b < 2; ++b)
#pragma unroll
                for (int m = 0; m < 4; ++m)
#pragma unroll
                    for (int n = 0; n < 2; ++n) acc[a][b][m][n] = (f32x4){0.f, 0.f, 0.f, 0.f};
        cur = nxt; cA = nA; cB = nB; ++ui;
        if constexpr (ALIGN_EPI) { if (wr == 1) PG8_BAR; }
    }
    PG8_WAIT_V(0);
    if constexpr (!ALIGN_EPI) { if (wr == 0) PG8_BAR; }
    PG8_BAR;
    if constexpr (Epi::AFTER_DRAIN) { E.fused(acc, cur, wr, wc, fr, fq, lds, wid, lane); S.done(cur); }
#undef PG8_SA
#undef PG8_SB
#undef PG8_STAGE
#undef PG8_LDA
#undef PG8_LDB
#undef PG8_MMA
#undef PG8_WAIT_V
#undef PG8_WAIT_L
#undef PG8_BAR
#undef PG8_SCHED
}
}
namespace pg8 {
__device__ __forceinline__ unsigned cvt_pk_bf16(float lo, float hi) { unsigned r; asm volatile("v_cvt_pk_bf16_f32 %0, %1, %2" : "=v"(r) : "v"(lo), "v"(hi)); return r; }
__device__ __forceinline__ float bf_lo(unsigned w) { return __uint_as_float(w << 16); }
__device__ __forceinline__ float bf_hi(unsigned w) { return __uint_as_float(w & 0xffff0000u); }
__device__ __forceinline__ float sigm(float x) { return __builtin_amdgcn_rcpf(1.f + __expf(-x)); }
#define EPI_ROWS_BEGIN \
    const int row0 = u.pm * BM + wr * 64 + fr; const int col0 = u.pn * BM + wc * 32 + 8 * fq; \
    _Pragma("unroll") for (int ai = 0; ai < 2; ++ai) _Pragma("unroll") for (int m = 0; m < 4; ++m) { const int lr = row0 + ai * HALF + m * 16;
#define EPI_ROWS_END }
typedef float f32x2e __attribute__((ext_vector_type(2)));
typedef unsigned u32x2 __attribute__((ext_vector_type(2)));
struct EpiProj {
    static constexpr bool PERM = true, AFTER_DRAIN = false, HAS_MID = false;
    bf16_t* O; int ldc; const float* ss; int grow0; const float* gq; const float* gk; const f32x2e* tax; const f32x2e* t1d; unsigned char* g8;
    __device__ __forceinline__ void operator()(const f32x4 (&acc)[2][2][4][2], const Unit& u, int wr, int wc, int fr_, int fq_) const {
        const int l_ = lane_now(), fr = l_ & 15, fq = l_ >> 4;
        const int pn = u.pn;
        const int kind = pn < 2 ? 1 : (pn == 2 ? (wc < 2 ? 2 : 0) : (pn < 5 ? 0 : (pn < 8 ? 3 : (pn < 11 ? 4 : 0))));
        const int row0 = u.pm * BM + wr * 64 + fr; const int ocol = pn * BM + wc * 64 + 8 * fq;
        const float C2v = 0.125f * 1.4426950408889634f;
        if (pn >= 15) {
            const int gcol = (pn - 15) * BM + wc * 64 + 8 * fq;
#pragma unroll
            for (int ai = 0; ai < 2; ++ai)
#pragma unroll
                for (int m = 0; m < 4; ++m) { const int lr = row0 + ai * HALF + m * 16;
                    const float rs = __builtin_amdgcn_rsqf(ss[grow0 + lr] * (1.f / 1024.f) + 1e-6f);
const float rs16 = rs * 16.f;
#pragma unroll
                    for (int bj = 0; bj < 2; ++bj) { u32x2 w = (u32x2){0u, 0u};
#pragma unroll
                        for (int i = 0; i < 4; ++i) { w.x = __builtin_amdgcn_cvt_pk_u8_f32(acc[ai][bj][m][0][i] * rs16 + 128.f, i, w.x); w.y = __builtin_amdgcn_cvt_pk_u8_f32(acc[ai][bj][m][1][i] * rs16 + 128.f, i, w.y);   }
                        *(u32x2*)(g8 + (size_t)lr * 2048 + gcol + bj * 32) = w; } }
        } else if (kind == 0) {
#pragma unroll
            for (int ai = 0; ai < 2; ++ai)
#pragma unroll
                for (int m = 0; m < 4; ++m) { const int lr = row0 + ai * HALF + m * 16;
                    const float rs = __builtin_amdgcn_rsqf(ss[grow0 + lr] * (1.f / 1024.f) + 1e-6f);
                    bf16_t* rowp = O + (size_t)lr * ldc + ocol;
#pragma unroll
                    for (int bj = 0; bj < 2; ++bj) { const f32x4 v0 = acc[ai][bj][m][0] * rs, v1 = acc[ai][bj][m][1] * rs;
                        u32x4 w; w.x = cvt_pk_bf16(v0[0], v0[1]); w.y = cvt_pk_bf16(v0[2], v0[3]); w.z = cvt_pk_bf16(v1[0], v1[1]); w.w = cvt_pk_bf16(v1[2], v1[3]);
                        *(u32x4*)(rowp + bj * 32) = w; } }
        } else if (kind <= 2) {
            const float* gp = (kind == 1 ? gq : gk) + 8 * fq; const float osc = kind == 1 ? C2v : 1.f;
            float gv[2][8];
#pragma unroll
            for (int bj = 0; bj < 2; ++bj)
#pragma unroll
                for (int i = 0; i < 8; ++i) gv[bj][i] = gp[bj * 32 + i] * osc;
            const float sgn = fq < 2 ? -1.f : 1.f;
#pragma unroll
            for (int ai = 0; ai < 2; ++ai)
#pragma unroll
                for (int m = 0; m < 4; ++m) { const int lr = row0 + ai * HALF + m * 16; const int t = lr & 4095;
                    const float rs = __builtin_amdgcn_rsqf(ss[grow0 + lr] * (1.f / 1024.f) + 1e-6f);
                    float x[2][8]; float sq = 0.f;
#pragma unroll
                    for (int bj = 0; bj < 2; ++bj)
#pragma unroll
                        for (int i = 0; i < 8; ++i) { x[bj][i] = acc[ai][bj][m][i >> 2][i & 3] * rs; sq += x[bj][i] * x[bj][i]; }
                    sq += shx(sq, l_, 16); sq += shx(sq, l_, 32);
                    const float rn = __builtin_amdgcn_rsqf(sq * (1.f / 64.f) + 1e-6f);
                    bf16_t* rowp = O + (size_t)lr * ldc + ocol;
#pragma unroll
                    for (int bj = 0; bj < 2; ++bj) { const f32x2e* tb = tax + (bj == 0 ? (t >> 6) : (t & 63)) * 16 + 8 * (fq & 1);
                        float y[8];
#pragma unroll
                        for (int i = 0; i < 8; ++i) { const float xv = x[bj][i] * rn * gv[bj][i]; const float xp = shx(xv, l_, 32); const f32x2e cs = tb[i]; y[i] = xv * cs.x + sgn * xp * cs.y; }
                        u32x4 w; w.x = cvt_pk_bf16(y[0], y[1]); w.y = cvt_pk_bf16(y[2], y[3]); w.z = cvt_pk_bf16(y[4], y[5]); w.w = cvt_pk_bf16(y[6], y[7]);
                        *(u32x4*)(rowp + bj * 32) = w; } }
        } else {
            const float osc = kind == 3 ? C2v : 1.f;
#pragma unroll
            for (int ai = 0; ai < 2; ++ai)
#pragma unroll
                for (int m = 0; m < 4; ++m) { const int lr = row0 + ai * HALF + m * 16; const int t = lr & 4095;
                    const float rs = __builtin_amdgcn_rsqf(ss[grow0 + lr] * (1.f / 1024.f) + 1e-6f) * osc;
                    const f32x2e* tb = t1d + t * 32 + 8 * fq;
                    float y0[8], y1[8];
#pragma unroll
                    for (int i = 0; i < 8; ++i) { const float x0 = acc[ai][0][m][i >> 2][i & 3] * rs, x1 = acc[ai][1][m][i >> 2][i & 3] * rs; const f32x2e cs = tb[i];
                        y0[i] = x0 * cs.x - x1 * cs.y; y1[i] = x1 * cs.x + x0 * cs.y; }
                    bf16_t* rowp = O + (size_t)lr * ldc + ocol;
                    u32x4 w; w.x = cvt_pk_bf16(y0[0], y0[1]); w.y = cvt_pk_bf16(y0[2], y0[3]); w.z = cvt_pk_bf16(y0[4], y0[5]); w.w = cvt_pk_bf16(y0[6], y0[7]);
                    *(u32x4*)(rowp) = w;
                    w.x = cvt_pk_bf16(y1[0], y1[1]); w.y = cvt_pk_bf16(y1[2], y1[3]); w.z = cvt_pk_bf16(y1[4], y1[5]); w.w = cvt_pk_bf16(y1[6], y1[7]);
                    *(u32x4*)(rowp + 32) = w; }
        }
    }
};
template <bool ADD> struct EpiGate {
    static constexpr bool PERM = true, AFTER_DRAIN = false, HAS_MID = false;
    bf16_t* O; int ldc; const unsigned char* G;
    __device__ __forceinline__ void operator()(const f32x4 (&acc)[2][2][4][2], const Unit& u, int wr, int wc, int fr_, int fq_) const { const int l_ = lane_now(), fr = l_ & 15, fq = l_ >> 4;
        const int row0 = u.pm * BM + wr * 64 + fr; const int col0 = u.pn * BM + wc * 32 + 8 * fq;
#pragma unroll
        for (int ai = 0; ai < 2; ++ai)
#pragma unroll
        for (int mh = 0; mh < 4; mh += 2) {
            u32x2 gw[4][2]; u32x4 pv[4][2];
#pragma unroll
            for (int m = mh; m < mh + 2; ++m) { const int lr = row0 + ai * HALF + m * 16;
#pragma unroll
                for (int bj = 0; bj < 2; ++bj) { gw[m][bj] = *(const u32x2*)(G + (size_t)lr * 2048 + col0 + bj * HALF); pv[m][bj] = (u32x4){0u, 0u, 0u, 0u}; if (ADD) pv[m][bj] = *(const u32x4*)(O + (size_t)lr * ldc + col0 + bj * HALF); } }
#pragma unroll
            for (int m = mh; m < mh + 2; ++m) { const int lr = row0 + ai * HALF + m * 16; bf16_t* rowp = O + (size_t)lr * ldc + col0;
#pragma unroll
                for (int bj = 0; bj < 2; ++bj) { const u32x2 g_ = gw[m][bj]; const u32x4 p_ = pv[m][bj]; const f32x4 a0 = acc[ai][bj][m][0], a1 = acc[ai][bj][m][1]; u32x4 w;
#define G8S(w_, sh_) sigm((float)(((w_) >> (sh_)) & 255u) * 0.0625f - 8.f)
                    w.x = cvt_pk_bf16(bf_lo(p_.x) + G8S(g_.x, 0) * a0[0], bf_hi(p_.x) + G8S(g_.x, 8) * a0[1]);
                    w.y = cvt_pk_bf16(bf_lo(p_.y) + G8S(g_.x, 16) * a0[2], bf_hi(p_.y) + G8S(g_.x, 24) * a0[3]);
                    w.z = cvt_pk_bf16(bf_lo(p_.z) + G8S(g_.y, 0) * a1[0], bf_hi(p_.z) + G8S(g_.y, 8) * a1[1]);
                    w.w = cvt_pk_bf16(bf_lo(p_.w) + G8S(g_.y, 16) * a1[2], bf_hi(p_.w) + G8S(g_.y, 24) * a1[3]);
#undef G8S
                    *(u32x4*)(rowp + bj * HALF) = w; } }
        }
    }
};
struct EpiNull {
    static constexpr bool PERM = true, AFTER_DRAIN = false, HAS_MID = false;
    __device__ __forceinline__ void operator()(const f32x4 (&acc)[2][2][4][2], const Unit& u, int wr, int wc, int fr_, int fq_) const {
#pragma unroll
        for (int a = 0; a < 2; ++a)
#pragma unroll
            for (int b = 0; b < 2; ++b)
#pragma unroll
                for (int m = 0; m < 4; ++m)
#pragma unroll
                    for (int n = 0; n < 2; ++n) asm volatile("" :: "v"(acc[a][b][m][n]));
    }
};
struct EpiPlain {
    static constexpr bool PERM = true, AFTER_DRAIN = false, HAS_MID = false;
    bf16_t* O; int ldc;
    __device__ __forceinline__ void operator()(const f32x4 (&acc)[2][2][4][2], const Unit& u, int wr, int wc, int fr_, int fq_) const { const int l_ = lane_now(), fr = l_ & 15, fq = l_ >> 4;
        EPI_ROWS_BEGIN
            bf16_t* rowp = O + (size_t)lr * ldc + col0;
#pragma unroll
            for (int bj = 0; bj < 2; ++bj) { const f32x4 v0 = acc[ai][bj][m][0], v1 = acc[ai][bj][m][1];
                u32x4 w; w.x = cvt_pk_bf16(v0[0], v0[1]); w.y = cvt_pk_bf16(v0[2], v0[3]); w.z = cvt_pk_bf16(v1[0], v1[1]); w.w = cvt_pk_bf16(v1[2], v1[3]);
                *(u32x4*)(rowp + bj * HALF) = w; }
        EPI_ROWS_END
    }
};
__device__ __forceinline__ void split_hl(const f32x4& h0, const f32x4& h1, u32x4& whi, u32x4& wlo) {
    whi.x = cvt_pk_bf16(h0[0], h0[1]); whi.y = cvt_pk_bf16(h0[2], h0[3]); whi.z = cvt_pk_bf16(h1[0], h1[1]); whi.w = cvt_pk_bf16(h1[2], h1[3]);
    wlo.x = cvt_pk_bf16(h0[0] - bf_lo(whi.x), h0[1] - bf_hi(whi.x)); wlo.y = cvt_pk_bf16(h0[2] - bf_lo(whi.y), h0[3] - bf_hi(whi.y));
    wlo.z = cvt_pk_bf16(h1[0] - bf_lo(whi.z), h1[1] - bf_hi(whi.z)); wlo.w = cvt_pk_bf16(h1[2] - bf_lo(whi.w), h1[3] - bf_hi(whi.w));
}
struct EpiMix {
    static constexpr bool PERM = true, AFTER_DRAIN = false, HAS_MID = false;
    const bf16_t* HI; int ldi; bf16_t* LO; bf16_t* HO; int ldo; float* ss_out; int grow0; bool st;
    __device__ __forceinline__ void operator()(const f32x4 (&acc)[2][2][4][2], const Unit& u, int wr, int wc, int fr_, int fq_) const { const int l_ = lane_now(), fr = l_ & 15, fq = l_ >> 4;
        const int row0 = u.pm * BM + wr * 64 + fr; const int col0 = u.pn * BM + wc * 32 + 8 * fq;
#pragma unroll
        for (int ai = 0; ai < 2; ++ai) {
            u32x4 hv[4][2], lv[4][2];
#pragma unroll
            for (int m = 0; m < 4; ++m) { const int lr = row0 + ai * HALF + m * 16;
#pragma unroll
                for (int bj = 0; bj < 2; ++bj) { hv[m][bj] = *(const u32x4*)(HI + (size_t)lr * ldi + col0 + bj * HALF); lv[m][bj] = *(const u32x4*)(LO + (size_t)lr * 1024 + col0 + bj * HALF); } }
#pragma unroll
            for (int m = 0; m < 4; ++m) { const int lr = row0 + ai * HALF + m * 16, gr = grow0 + lr; float sq = 0.f;
#pragma unroll
                for (int bj = 0; bj < 2; ++bj) { const u32x4 a_ = hv[m][bj], b_ = lv[m][bj];
                    f32x4 h0 = (f32x4){bf_lo(a_.x) + bf_lo(b_.x), bf_hi(a_.x) + bf_hi(b_.x), bf_lo(a_.y) + bf_lo(b_.y), bf_hi(a_.y) + bf_hi(b_.y)};
                    f32x4 h1 = (f32x4){bf_lo(a_.z) + bf_lo(b_.z), bf_hi(a_.z) + bf_hi(b_.z), bf_lo(a_.w) + bf_lo(b_.w), bf_hi(a_.w) + bf_hi(b_.w)};
                    h0 = h0 + acc[ai][bj][m][0]; h1 = h1 + acc[ai][bj][m][1];
                    sq += (h0[0] * h0[0] + h0[1] * h0[1]) + (h0[2] * h0[2] + h0[3] * h0[3]) + (h1[0] * h1[0] + h1[1] * h1[1]) + (h1[2] * h1[2] + h1[3] * h1[3]);
                    u32x4 whi, wlo; split_hl(h0, h1, whi, wlo);
                    if (st) { *(u32x4*)(HO + (size_t)lr * ldo + col0 + bj * HALF) = whi; *(u32x4*)(LO + (size_t)lr * 1024 + col0 + bj * HALF) = wlo; } }
                sq += shx(sq, l_, 16); sq += shx(sq, l_, 32);
                if (fq == 0 && st) unsafeAtomicAdd(ss_out + gr, sq);
            }
        }
    }
};
struct EpiPle {
    static constexpr bool PERM = true, AFTER_DRAIN = false, HAS_MID = true; static constexpr int MID_T = 16;
    const bf16_t* HI; int ldi; bf16_t* LO; bf16_t* HO; float* HF; const float* ss_in; float* ss_out; int grow0; unsigned* scr; bool st;
    __device__ __forceinline__ void mid(f32x4 (&acc)[2][2][4][2], const Unit& u, int wr, int wc) const { const int l_ = lane_now(), fr = l_ & 15; const int tid = (wr * 4 + wc) * 64 + l_;
        const int row0 = u.pm * BM + wr * 64 + fr;
        float sv[8];
#pragma unroll
        for (int r = 0; r < 8; ++r) sv[r] = ss_in[grow0 + row0 + (r >> 2) * HALF + (r & 3) * 16];
#pragma unroll
        for (int ai = 0; ai < 2; ++ai)
#pragma unroll
            for (int m = 0; m < 4; ++m) { const float rs = __builtin_amdgcn_rsqf(sv[ai * 4 + m] * (1.f / 1024.f) + 1e-6f);
#pragma unroll
                for (int bj = 0; bj < 2; ++bj) { unsigned w0 = 0u, w1 = 0u;
#pragma unroll
                    for (int i = 0; i < 4; ++i) { w0 = __builtin_amdgcn_cvt_pk_u8_f32(sigm(acc[ai][bj][m][0][i] * rs) * 255.f, i, w0); w1 = __builtin_amdgcn_cvt_pk_u8_f32(sigm(acc[ai][bj][m][1][i] * rs) * 255.f, i, w1);
                        acc[ai][bj][m][0][i] = 0.f; acc[ai][bj][m][1][i] = 0.f; }
                    const int j = ((ai * 4 + m) * 2 + bj) * 2;
                    scr[(j + 0) * 512 + tid] = w0; scr[(j + 1) * 512 + tid] = w1; } }
    }
    __device__ __forceinline__ void operator()(const f32x4 (&acc)[2][2][4][2], const Unit& u, int wr, int wc, int fr_, int fq_) const { const int l_ = lane_now(), fr = l_ & 15, fq = l_ >> 4; const int tid = (wr * 4 + wc) * 64 + l_;
        const int row0 = u.pm * BM + wr * 64 + fr; const int col0 = u.pn * BM + wc * 32 + 8 * fq;
#pragma unroll
        for (int ai = 0; ai < 2; ++ai)
#pragma unroll
        for (int mh = 0; mh < 4; mh += 2) {
            u32x4 hv[4][2], lv[4][2]; unsigned gq[4][2][2];
#pragma unroll
            for (int m = mh; m < mh + 2; ++m) { const int lr = row0 + ai * HALF + m * 16;
#pragma unroll
                for (int bj = 0; bj < 2; ++bj) { hv[m][bj] = *(const u32x4*)(HI + (size_t)lr * ldi + col0 + bj * HALF); lv[m][bj] = *(const u32x4*)(LO + (size_t)lr * 1024 + col0 + bj * HALF);
                    const int j = ((ai * 4 + m) * 2 + bj) * 2;
                    gq[m][bj][0] = __hip_atomic_load(scr + (j + 0) * 512 + tid, __ATOMIC_RELAXED, __HIP_MEMORY_SCOPE_AGENT); gq[m][bj][1] = __hip_atomic_load(scr + (j + 1) * 512 + tid, __ATOMIC_RELAXED, __HIP_MEMORY_SCOPE_AGENT); } }
#pragma unroll
            for (int m = mh; m < mh + 2; ++m) { const int lr = row0 + ai * HALF + m * 16, gr = grow0 + lr;
                float sq = 0.f; const float k_ = 1.f / 255.f;
#pragma unroll
                for (int bj = 0; bj < 2; ++bj) {
                    const u32x4 a_ = hv[m][bj], b_ = lv[m][bj];
                    f32x4 h0 = (f32x4){bf_lo(a_.x) + bf_lo(b_.x), bf_hi(a_.x) + bf_hi(b_.x), bf_lo(a_.y) + bf_lo(b_.y), bf_hi(a_.y) + bf_hi(b_.y)};
                    f32x4 h1 = (f32x4){bf_lo(a_.z) + bf_lo(b_.z), bf_hi(a_.z) + bf_hi(b_.z), bf_lo(a_.w) + bf_lo(b_.w), bf_hi(a_.w) + bf_hi(b_.w)};
                    const f32x4 a0 = acc[ai][bj][m][0], a1 = acc[ai][bj][m][1]; const unsigned g0 = gq[m][bj][0], g1 = gq[m][bj][1];
                    h0[0] += (float)(g0 & 255u) * k_ * a0[0]; h0[1] += (float)((g0 >> 8) & 255u) * k_ * a0[1]; h0[2] += (float)((g0 >> 16) & 255u) * k_ * a0[2]; h0[3] += (float)(g0 >> 24) * k_ * a0[3];
                    h1[0] += (float)(g1 & 255u) * k_ * a1[0]; h1[1] += (float)((g1 >> 8) & 255u) * k_ * a1[1]; h1[2] += (float)((g1 >> 16) & 255u) * k_ * a1[2]; h1[3] += (float)(g1 >> 24) * k_ * a1[3];
                    sq += (h0[0] * h0[0] + h0[1] * h0[1]) + (h0[2] * h0[2] + h0[3] * h0[3]) + (h1[0] * h1[0] + h1[1] * h1[1]) + (h1[2] * h1[2] + h1[3] * h1[3]);
                    if (HO) { u32x4 whi, wlo; split_hl(h0, h1, whi, wlo);
                        if (st) { *(u32x4*)(HO + (size_t)lr * 1024 + col0 + bj * HALF) = whi; *(u32x4*)(LO + (size_t)lr * 1024 + col0 + bj * HALF) = wlo; } }
                    else if (st) { float* hp = HF + (size_t)gr * 1024 + col0 + bj * HALF; *(f32x4*)hp = h0; *(f32x4*)(hp + 4) = h1; }
                }
                sq += shx(sq, l_, 16); sq += shx(sq, l_, 32);
                if (fq == 0 && st) unsafeAtomicAdd(ss_out + gr, sq);
            }
        }
    }
};
struct EpiMerge {
    static constexpr bool PERM = true, AFTER_DRAIN = false, HAS_MID = true; static constexpr int MID_T = 8;
    bf16_t* O; int ldc; const unsigned char* G;
    const PG8_LAS float* T;
    __device__ __forceinline__ static float dec(unsigned w, int sh) { return (float)((w >> sh) & 255u) * 0.0625f - 8.f; }
    __device__ __forceinline__ void mid(f32x4 (&acc)[2][2][4][2], const Unit& u, int wr, int wc) const { const int l_ = lane_now(), fr = l_ & 15, fq = l_ >> 4;
        const int row0 = u.pm * BM + wr * 64 + fr; const int col0 = u.pn * BM + wc * 32 + 8 * fq;
#pragma unroll
        for (int ai = 0; ai < 2; ++ai) {
            u32x2 ga[4][2], gb[4][2];
#pragma unroll
            for (int m = 0; m < 4; ++m) { const unsigned char* gp = G + (size_t)(row0 + ai * HALF + m * 16) * 2048 + col0;
#pragma unroll
                for (int bj = 0; bj < 2; ++bj) { ga[m][bj] = *(const u32x2*)(gp + bj * HALF); gb[m][bj] = *(const u32x2*)(gp + 1024 + bj * HALF); } }
#pragma unroll
            for (int m = 0; m < 4; ++m)
#pragma unroll
                for (int bj = 0; bj < 2; ++bj)
#pragma unroll
                    for (int i = 0; i < 8; ++i) { const unsigned wa = i < 4 ? ga[m][bj].x : ga[m][bj].y, wb = i < 4 ? gb[m][bj].x : gb[m][bj].y; const int sh = 8 * (i & 3);
                        acc[ai][bj][m][i >> 2][i & 3] *= T[(wa >> sh) & 255u] * T[256 + ((wb >> sh) & 255u)]; }
        }
    }
    __device__ __forceinline__ void operator()(const f32x4 (&acc)[2][2][4][2], const Unit& u, int wr, int wc, int fr_, int fq_) const { const int l_ = lane_now(), fr = l_ & 15, fq = l_ >> 4;
        const int row0 = u.pm * BM + wr * 64 + fr; const int col0 = u.pn * BM + wc * 32 + 8 * fq;
#pragma unroll
        for (int ai = 0; ai < 2; ++ai) {
            u32x2 gb[4][2];
#pragma unroll
            for (int m = 0; m < 4; ++m)
#pragma unroll
                for (int bj = 0; bj < 2; ++bj) gb[m][bj] = *(const u32x2*)(G + (size_t)(row0 + ai * HALF + m * 16) * 2048 + 1024 + col0 + bj * HALF);
#pragma unroll
            for (int m = 0; m < 4; ++m) { bf16_t* rowp = O + (size_t)(row0 + ai * HALF + m * 16) * ldc + col0;
#pragma unroll
                for (int bj = 0; bj < 2; ++bj) { const u32x2 g_ = gb[m][bj]; const f32x4 a0 = acc[ai][bj][m][0], a1 = acc[ai][bj][m][1]; u32x4 w;
#define TS(w_, sh_) T[((w_) >> (sh_)) & 255u]
                    w.x = cvt_pk_bf16(TS(g_.x, 0) * a0[0], TS(g_.x, 8) * a0[1]); w.y = cvt_pk_bf16(TS(g_.x, 16) * a0[2], TS(g_.x, 24) * a0[3]);
                    w.z = cvt_pk_bf16(TS(g_.y, 0) * a1[0], TS(g_.y, 8) * a1[1]); w.w = cvt_pk_bf16(TS(g_.y, 16) * a1[2], TS(g_.y, 24) * a1[3]);
#undef TS
                    *(u32x4*)(rowp + bj * HALF) = w; } }
        }
    }
};
}
#include <hip/hip_bf16.h>
#include <cmath>
namespace attn_body {
using bf16=__hip_bfloat16;
using bf16x8=__attribute__((ext_vector_type(8)))short;
using s16x4=__attribute__((ext_vector_type(4)))short;
using f32x16=__attribute__((ext_vector_type(16)))float;
using u32x4=__attribute__((ext_vector_type(4)))unsigned;
constexpr int NHEAD=8,SEQ=4096,D=64,DM=3840;
constexpr int NW=8,QBLK=32,QB=QBLK*NW,KVBLK=64,NQB=SEQ/QB;
constexpr int ATTN_PITCH=DM, ATTN_UNIT_ROWS=QB;
__device__ __forceinline__ int crow(int r,int hi){return (r&3)+8*(r>>2)+4*hi;}
#define SBAR() __builtin_amdgcn_sched_barrier(0)
__device__ __forceinline__ void cmask(f32x16&p0,f32x16&p1,int jb,int qrel,int hi){
  const float NEG=-INFINITY; int kb=64*jb+4*hi;
  #pragma unroll
  for(int r=0;r<16;++r){int kv=kb+(r&3)+8*(r>>2); if(kv>qrel)p0[r]=NEG; if(kv+32>qrel)p1[r]=NEG;}
}

constexpr int NSLOT=3, SLOTB=8192;
constexpr int LDS_K=0, LDS_V=NSLOT*SLOTB, LDS_WS=2*NSLOT*SLOTB, LDS_OST=LDS_WS+NW*64*4, LDS_BYTES=LDS_OST+NW*4096;
constexpr float C2=0.125f*1.4426950408889634f;
__device__ __forceinline__ void glds16(const void*gsrc,unsigned lds_dst){unsigned keep;
  asm volatile("s_mov_b32 %0, m0\n\ts_mov_b32 m0, %2\n\ts_nop 0\n\tglobal_load_lds_dwordx4 %1, off\n\ts_mov_b32 m0, %0":"=&s"(keep):"v"(gsrc),"s"(lds_dst):"memory");}
__device__ __forceinline__ float max3f(float a,float b,float c){float r;asm("v_max3_f32 %0, %1, %2, %3":"=v"(r):"v"(a),"v"(b),"v"(c));return r;}
__device__ __forceinline__ float max2f(float a,float b){float r;asm("v_max_f32_e32 %0, %1, %2":"=v"(r):"v"(a),"v"(b));return r;}
__device__ __forceinline__ float fadd_s(float a,float b){float r;asm("v_add_f32_e32 %0, %1, %2":"=v"(r):"v"(a),"v"(b));return r;}
__device__ __forceinline__ float fsub_s(float a,float b){float r;asm("v_sub_f32_e32 %0, %1, %2":"=v"(r):"v"(a),"v"(b));return r;}
typedef float f32x2_t __attribute__((ext_vector_type(2))); typedef __bf16 bf16x2_t __attribute__((ext_vector_type(2)));
__device__ __forceinline__ unsigned cvtpk_s(float lo,float hi){f32x2_t v={lo,hi};bf16x2_t b=__builtin_convertvector(v,bf16x2_t);return __builtin_bit_cast(unsigned,b);}
#define WAIT_BAR(N) asm volatile("s_waitcnt vmcnt(" #N ") lgkmcnt(0)\n\ts_barrier":::"memory")

__device__ __forceinline__ void qkt(f32x16&p0,f32x16&p1,const char*Kslot,const bf16x8*qr,const f32x16&negm,int r32,int hi){
  const char*kb=Kslot+hi*1024+r32*16;
  #pragma unroll
  for(int d0=0;d0<4;++d0){
    const bf16x8 b0=*reinterpret_cast<const bf16x8*>(kb+d0*2048);
    const bf16x8 b1=*reinterpret_cast<const bf16x8*>(kb+d0*2048+512);
    if(d0==0){p0=__builtin_amdgcn_mfma_f32_32x32x16_bf16(b0,qr[0],negm,0,0,0);p1=__builtin_amdgcn_mfma_f32_32x32x16_bf16(b1,qr[0],negm,0,0,0);}
    else{p0=__builtin_amdgcn_mfma_f32_32x32x16_bf16(b0,qr[d0],p0,0,0,0);p1=__builtin_amdgcn_mfma_f32_32x32x16_bf16(b1,qr[d0],p1,0,0,0);}}
}
typedef __attribute__((address_space(3))) const char* lds_cptr;
typedef short v4i16_t __attribute__((ext_vector_type(4)));
__device__ __forceinline__ void kload8(bf16x8*kf,lds_cptr kp){
  kf[0]=*(const __attribute__((address_space(3))) bf16x8*)(kp);      kf[1]=*(const __attribute__((address_space(3))) bf16x8*)(kp+512);
  kf[2]=*(const __attribute__((address_space(3))) bf16x8*)(kp+2048); kf[3]=*(const __attribute__((address_space(3))) bf16x8*)(kp+2560);
  kf[4]=*(const __attribute__((address_space(3))) bf16x8*)(kp+4096); kf[5]=*(const __attribute__((address_space(3))) bf16x8*)(kp+4608);
  kf[6]=*(const __attribute__((address_space(3))) bf16x8*)(kp+6144); kf[7]=*(const __attribute__((address_space(3))) bf16x8*)(kp+6656);
}
__device__ __forceinline__ void kload2(bf16x8*kf,lds_cptr kp,int j){ kf[2*j]=*(const __attribute__((address_space(3))) bf16x8*)(kp+j*2048); kf[2*j+1]=*(const __attribute__((address_space(3))) bf16x8*)(kp+j*2048+512); }
__device__ __forceinline__ s16x4 vtr(lds_cptr p){ return __builtin_bit_cast(s16x4,__builtin_amdgcn_ds_read_tr16_b64_v4i16((__attribute__((address_space(3))) v4i16_t*)p)); }
__device__ __forceinline__ float rowmax(const f32x16&p0,const f32x16&p1){
  float a=max3f(p0[0],p0[1],p1[0]),b=max3f(p0[2],p0[3],p1[1]);a=max3f(a,p1[2],p1[3]);
  #pragma unroll
  for(int r=4;r<16;r+=4){a=max3f(a,p0[r],p0[r+1]);b=max3f(b,p0[r+2],p0[r+3]);a=max3f(a,p1[r],p1[r+1]);b=max3f(b,p1[r+2],p1[r+3]);}
  const float m=max2f(a,b);
  auto rr=__builtin_amdgcn_permlane32_swap(__float_as_uint(m),__float_as_uint(m),false,false);
  return max2f(__uint_as_float(rr[0]),__uint_as_float(rr[1]));
}
__device__ __forceinline__ void pv(f32x16*o,int vb,bf16x8 pa0,bf16x8 pa1,bf16x8 pa2,bf16x8 pa3){
  #pragma unroll
  for(int d0=0;d0<2;++d0){s16x4 lo[4],hi[4];
    #pragma unroll
    for(int ks=0;ks<4;++ks){
      asm volatile("ds_read_b64_tr_b16 %0,%1 offset:%c2":"=&v"(lo[ks]):"v"(vb),"i"(d0*4096+ks*1024):"memory");
      asm volatile("ds_read_b64_tr_b16 %0,%1 offset:%c2":"=&v"(hi[ks]):"v"(vb),"i"(d0*4096+ks*1024+512):"memory");}
    asm volatile("s_waitcnt lgkmcnt(0)":::"memory");SBAR();
    #define PK(k) (bf16x8){lo[k][0],lo[k][1],lo[k][2],lo[k][3],hi[k][0],hi[k][1],hi[k][2],hi[k][3]}
    o[d0]=__builtin_amdgcn_mfma_f32_32x32x16_bf16(pa0,PK(0),o[d0],0,0,0);
    o[d0]=__builtin_amdgcn_mfma_f32_32x32x16_bf16(pa1,PK(1),o[d0],0,0,0);
    o[d0]=__builtin_amdgcn_mfma_f32_32x32x16_bf16(pa2,PK(2),o[d0],0,0,0);
    o[d0]=__builtin_amdgcn_mfma_f32_32x32x16_bf16(pa3,PK(3),o[d0],0,0,0);
    #undef PK
  }
}

#ifndef ATTN_STORE16
#define ATTN_STORE16(p,v) (*(u32x4*)(p)=(v))
#endif
template<int THRL> __device__ __forceinline__ void attn_unit(int b,int h,int qb,const bf16*Q,const bf16*__restrict__ K,const bf16*__restrict__ V,bf16*O,const bf16*__restrict__ Z,char*shm,const int wave_id,const bool st_){
  const int lane=lane_now(),tid=wave_id*64+lane,r32=lane&31,hi=lane>>5; const int wid=wave_id;
  const long rowbase=(long)b*SEQ; const int q0=qb*QB;
  const bf16*Qw=Q+(rowbase+q0+wid*QBLK)*DM+h*D;
  const bf16*Kh=K+rowbase*DM+(h>>2)*D,*Vh=V+rowbase*DM+(h>>2)*D;
  const unsigned lds0=(unsigned)(uintptr_t)shm;
  float*wsf=(float*)(shm+LDS_WS)+wid*64;
  const bf16*ksrc=Kh+(long)lane*DM+wid*8;
  const bf16*vsrc=Vh+(long)(16*(wid&3)+(lane>>2))*DM+(wid>>2)*32+(lane&3)*8;
  const unsigned kdst=lds0+LDS_K+wid*1024, vdst=lds0+LDS_V+wid*1024;
  #define DMA_K(t,slot) glds16(ksrc+(long)(t)*KVBLK*DM,(unsigned)__builtin_amdgcn_readfirstlane(kdst+(slot)))
  #define DMA_V(t,slot) glds16(vsrc+(long)(t)*KVBLK*DM,(unsigned)__builtin_amdgcn_readfirstlane(vdst+(slot)))
  const int vb0=(int)(lds0+LDS_V)+((lane>>4)&1)*32+(lane&3)*8+(4*hi+((lane&15)>>2))*64;
  const char*Kbase=shm+LDS_K; bf16x8 kf[8];
  const lds_cptr shm3=(lds_cptr)shm; const lds_cptr kp0=shm3+LDS_K+hi*1024+r32*16; const lds_cptr vp0=shm3+LDS_V+((lane>>4)&1)*32+(lane&3)*8+(4*hi+((lane&15)>>2))*64;
  constexpr int NT=SEQ/KVBLK;
  DMA_K(0,0);DMA_V(0,0);DMA_K(1,SLOTB);
  bf16x8 qr[4];
  #pragma unroll
  for(int d0=0;d0<4;++d0)qr[d0]=*reinterpret_cast<const bf16x8*>(&Qw[(long)r32*DM+d0*16+hi*8]);
  float mhat=0.f,l_reg=0.f;f32x16 o[2];{float zz=0.f;asm volatile("":"+v"(zz));_Pragma("unroll") for(int r=0;r<16;++r){o[0][r]=zz;o[1][r]=zz;}}f32x16 negm;{float zz=0.f;asm volatile("":"+v"(zz));_Pragma("unroll") for(int r=0;r<16;++r)negm[r]=zz;}asm volatile("":"+v"(negm));
  const int qrel=wid*QBLK+r32;
  #define CMASK(P0,P1,t) do{}while(0)
  bool resc=false;
  #define START(P0,P1) do{ const float rm=rowmax(P0,P1); resc=false; \
    { const float dl=rm; mhat=fadd_s(mhat,dl); \
      _Pragma("unroll") for(int r=0;r<16;++r){P0[r]=fsub_s(P0[r],dl);P1[r]=fsub_s(P1[r],dl);} \
      _Pragma("unroll") for(int r=0;r<16;++r)negm[r]=-mhat; asm volatile("":"+v"(negm)); } \
    _Pragma("unroll") for(int r=0;r<16;++r)P0[r]=__builtin_amdgcn_exp2f(P0[r]); }while(0)
  #define RESC() do{ if(resc){ asm volatile("s_waitcnt lgkmcnt(0)":::"memory"); \
      _Pragma("unroll") for(int d_=0;d_<2;++d_) _Pragma("unroll") for(int r=0;r<16;++r)o[d_][r]*=wsf[crow(r,hi)]; } }while(0)
  f32x16 pA0,pA1,pB0,pB1;
  int sl_prev=0,sl_cur=0,sl_next=SLOTB;
  #define ROT() do{sl_prev=sl_cur;sl_cur=sl_next;sl_next=(sl_next==(NSLOT-1)*SLOTB)?0:sl_next+SLOTB;}while(0)
  DMA_K(2,2*SLOTB);
  WAIT_BAR(3);
  qkt(pA0,pA1,Kbase,qr,negm,r32,hi);asm volatile("s_nop 15\n\ts_nop 7":"+v"(pA0),"+v"(pA1));CMASK(pA0,pA1,0);
  START(pA0,pA1);
  _Pragma("unroll") for(int r=0;r<16;++r)pA1[r]=__builtin_amdgcn_exp2f(pA1[r]);
  WAIT_BAR(0);
  DMA_K(3,0);DMA_V(1,SLOTB);
  ROT();
  kload8(kf,kp0+sl_cur);
  WAIT_BAR(2);
  s16x4 vlo[8],vhi[8]; u32x4 pw0,pw1,pw2,pw3;
  #define PKW(P,B) cvtpk_s(P[B],P[B+1])
  #define PAF(k) __builtin_bit_cast(bf16x8,pw##k)
  #define VFR(i) (bf16x8){vlo[i][0],vlo[i][1],vlo[i][2],vlo[i][3],vhi[i][0],vhi[i][1],vhi[i][2],vhi[i][3]}
  #define PIN(x) asm volatile("":"+v"(x))
  #define MX3(a,b,c) __builtin_fmaxf(__builtin_fmaxf((a),(b)),(c))
  #define GAPA(MF,A0,A1,A2,A3,W0,W1,PW) do{ MF; sacc+=A0; sacc+=A1; sacc+=A2; sacc+=A3; PIN(sacc); W0; W1; PIN(PW); SBAR(); }while(0)
  #define EX(v) __builtin_amdgcn_exp2f(v)
  #define GAPB(MF,X,B) do{ MF; X[B]=EX(X[B]); X[B+1]=EX(X[B+1]); X[B+2]=EX(X[B+2]); X[B+3]=EX(X[B+3]); PIN(X); SBAR(); }while(0)
  #define VRD(i) do{ vlo[i]=vtr(vp_+(((i)>>2)*4096+((i)&3)*1024)); vhi[i]=vtr(vp_+(((i)>>2)*4096+((i)&3)*1024+512)); }while(0)
  #define KRD(G,j) do{ if(G){ kload2(kf,kp0+sl_next,j); SBAR(); } }while(0)
  #define STEP(C0,C1,P0,P1,t,GK,GV,GL) do{ SBAR(); \
    const lds_cptr vp_=vp0+sl_prev; \
    VRD(0); SBAR(); float sacc=(P0[0]+P0[1]); \
    GAPA(C0=__builtin_amdgcn_mfma_f32_32x32x16_bf16(kf[0],qr[0],negm,0,0,0), P0[2],P0[3],P0[4],P0[5],     pw0[0]=PKW(P0,0), pw0[1]=PKW(P0,2), pw0); \
    VRD(4); SBAR(); GAPA(C1=__builtin_amdgcn_mfma_f32_32x32x16_bf16(kf[1],qr[0],negm,0,0,0), P0[6],P0[7],P0[8],P0[9],     pw0[2]=PKW(P0,4), pw0[3]=PKW(P0,6), pw0); \
    VRD(1); SBAR(); GAPA(C0=__builtin_amdgcn_mfma_f32_32x32x16_bf16(kf[2],qr[1],C0,0,0,0),   P0[10],P0[11],P0[12],P0[13], pw1[0]=PKW(P0,8), pw1[1]=PKW(P0,10), pw1); \
    VRD(5); SBAR(); GAPA(C1=__builtin_amdgcn_mfma_f32_32x32x16_bf16(kf[3],qr[1],C1,0,0,0),   P0[14],P0[15],P1[0],P1[1],   pw1[2]=PKW(P0,12),pw1[3]=PKW(P0,14), pw1); \
    VRD(2); SBAR(); GAPA(C0=__builtin_amdgcn_mfma_f32_32x32x16_bf16(kf[4],qr[2],C0,0,0,0),   P1[2],P1[3],P1[4],P1[5],     pw2[0]=PKW(P1,0), pw2[1]=PKW(P1,2), pw2); \
    VRD(6); SBAR(); GAPA(C1=__builtin_amdgcn_mfma_f32_32x32x16_bf16(kf[5],qr[2],C1,0,0,0),   P1[6],P1[7],P1[8],P1[9],     pw2[2]=PKW(P1,4), pw2[3]=PKW(P1,6), pw2); \
    VRD(3); SBAR(); GAPA(C0=__builtin_amdgcn_mfma_f32_32x32x16_bf16(kf[6],qr[3],C0,0,0,0),   P1[10],P1[11],P1[12],P1[13], pw3[0]=PKW(P1,8), pw3[1]=PKW(P1,10), pw3); \
    VRD(7); SBAR(); GAPA(C1=__builtin_amdgcn_mfma_f32_32x32x16_bf16(kf[7],qr[3],C1,0,0,0),   P1[14],P1[15],0.f,0.f,       pw3[2]=PKW(P1,12),pw3[3]=PKW(P1,14), pw3); \
    l_reg+=sacc; \
    if(GK){DMA_K((t)+3,sl_cur);} if(GV){DMA_V((t)+1,sl_next);} \
    CMASK(C0,C1,t); \
    { float a=MX3(C0[0],C0[1],C1[0]),b=MX3(C0[2],C0[3],C1[1]); a=MX3(a,C1[2],C1[3]); \
      _Pragma("unroll") for(int r=4;r<16;r+=4){a=MX3(a,C0[r],C0[r+1]);b=MX3(b,C0[r+2],C0[r+3]);a=MX3(a,C1[r],C1[r+1]);b=MX3(b,C1[r+2],C1[r+3]);} \
      float rm=__builtin_fmaxf(a,b); { auto rr=__builtin_amdgcn_permlane32_swap(__float_as_uint(rm),__float_as_uint(rm),false,false); rm=__builtin_fmaxf(__uint_as_float(rr[0]),__uint_as_float(rr[1])); } \
      resc=false; \
      if(__builtin_expect(__any(rm>(float)THRL),0)){ const float dl=__builtin_fmaxf(rm,0.f); mhat+=dl; \
        _Pragma("unroll") for(int r=0;r<16;++r){C0[r]-=dl;C1[r]-=dl;} \
        _Pragma("unroll") for(int r=0;r<16;++r)negm[r]=-mhat; asm volatile("":"+v"(negm)); \
        const float f=__builtin_amdgcn_exp2f(-dl); l_reg*=f; if(hi==0)wsf[r32]=f; resc=true; } } \
    SBAR(); \
    GAPB(o[0]=__builtin_amdgcn_mfma_f32_32x32x16_bf16(PAF(0),VFR(0),o[0],0,0,0), C0,0); \
    GAPB(o[1]=__builtin_amdgcn_mfma_f32_32x32x16_bf16(PAF(0),VFR(4),o[1],0,0,0), C0,4); \
    KRD(GL,0); GAPB(o[0]=__builtin_amdgcn_mfma_f32_32x32x16_bf16(PAF(1),VFR(1),o[0],0,0,0), C0,8); \
    KRD(GL,1); GAPB(o[1]=__builtin_amdgcn_mfma_f32_32x32x16_bf16(PAF(1),VFR(5),o[1],0,0,0), C0,12); \
    KRD(GL,2); GAPB(o[0]=__builtin_amdgcn_mfma_f32_32x32x16_bf16(PAF(2),VFR(2),o[0],0,0,0), C1,0); \
    KRD(GL,3); GAPB(o[1]=__builtin_amdgcn_mfma_f32_32x32x16_bf16(PAF(2),VFR(6),o[1],0,0,0), C1,4); \
    GAPB(o[0]=__builtin_amdgcn_mfma_f32_32x32x16_bf16(PAF(3),VFR(3),o[0],0,0,0), C1,8); \
    GAPB(o[1]=__builtin_amdgcn_mfma_f32_32x32x16_bf16(PAF(3),VFR(7),o[1],0,0,0), C1,12); \
    }while(0)
  int t=1;
  #undef CMASK
  #define CMASK(P0,P1,t) do{}while(0)
  for(;t+5<NT;t+=2){
    STEP(pB0,pB1,pA0,pA1,t,true,true,true);     WAIT_BAR(2); RESC(); ROT();
    STEP(pA0,pA1,pB0,pB1,t+1,true,true,true);   WAIT_BAR(2); RESC(); ROT();
  }
  #undef CMASK
  #define CMASK(P0,P1,t) do{}while(0)
  #define ENDW(tt) do{ if((tt)+3<NT){WAIT_BAR(2);} else if((tt)+2<NT){WAIT_BAR(1);} else {WAIT_BAR(0);} }while(0)
  for(;t+1<NT;t+=2){
    STEP(pB0,pB1,pA0,pA1,t,(t+3<NT),(t+1<NT),(t+1<NT));       ENDW(t);   RESC(); ROT();
    STEP(pA0,pA1,pB0,pB1,t+1,(t+4<NT),(t+2<NT),(t+2<NT));     ENDW(t+1); RESC(); ROT();
  }
  STEP(pB0,pB1,pA0,pA1,NT-1,false,false,false); RESC();
  { float sacc=pB0[0]+pB0[1]; _Pragma("unroll") for(int r=2;r<16;++r)sacc+=pB0[r]; _Pragma("unroll") for(int r=0;r<16;++r)sacc+=pB1[r]; l_reg+=sacc;
    pw0=(u32x4){PKW(pB0,0),PKW(pB0,2),PKW(pB0,4),PKW(pB0,6)};pw1=(u32x4){PKW(pB0,8),PKW(pB0,10),PKW(pB0,12),PKW(pB0,14)};pw2=(u32x4){PKW(pB1,0),PKW(pB1,2),PKW(pB1,4),PKW(pB1,6)};pw3=(u32x4){PKW(pB1,8),PKW(pB1,10),PKW(pB1,12),PKW(pB1,14)};
    SBAR(); pv(o,vb0+sl_cur,PAF(0),PAF(1),PAF(2),PAF(3)); }
  #undef PKW
  #undef PAF
  #undef VFR
  #undef PIN
  #undef MX3
  #undef GAPA
  #undef GAPB
  #undef EX
  #undef VRD
  #undef KRD
  #undef STEP
  #undef ENDW
  {auto rr=__builtin_amdgcn_permlane32_swap(__float_as_uint(l_reg),__float_as_uint(l_reg),false,false);l_reg=__uint_as_float(rr[0])+__uint_as_float(rr[1]);}
  if(hi==0)wsf[32+r32]=l_reg;asm volatile("s_waitcnt lgkmcnt(0)":::"memory");
  float rli[16];
  #pragma unroll
  for(int r=0;r<16;++r)rli[r]=__builtin_amdgcn_rcpf(wsf[32+crow(r,hi)]);
  constexpr int OP=768; bf16*Ow=O+(rowbase+q0+wid*QBLK)*OP+h*D;
  { bf16*stg=(bf16*)(shm+LDS_OST)+wid*2048;
    #pragma unroll
    for(int r=0;r<16;++r){const int orow=crow(r,hi);
      #pragma unroll
      for(int d0=0;d0<2;++d0)stg[orow*64+d0*32+r32]=__float2bfloat16(o[d0][r]*rli[r]);}
    asm volatile("s_waitcnt lgkmcnt(0)":::"memory");
    const bf16*Zw=Z+(rowbase+q0+wid*QBLK)*DM+h*D;
    #pragma unroll
    for(int i=0;i<4;++i){const int row=i*8+(lane>>3),ch=lane&7; u32x4 v=*(const u32x4*)(stg+row*64+ch*8); const u32x4 z=*(const u32x4*)(Zw+(long)row*DM+ch*8);
      _Pragma("unroll") for(int e=0;e<4;++e){ const float z0=__uint_as_float(z[e]<<16), z1=__uint_as_float(z[e]&0xffff0000u); const float v0=__uint_as_float(v[e]<<16), v1=__uint_as_float(v[e]&0xffff0000u);
        const float g0=z0*__builtin_amdgcn_rcpf(1.f+__expf(-z0)), g1=z1*__builtin_amdgcn_rcpf(1.f+__expf(-z1)); v[e]=cvtpk_s(v0*g0,v1*g1); }
      if(st_)ATTN_STORE16(Ow+(long)row*OP+ch*8,v);} }
  asm volatile("s_waitcnt lgkmcnt(0)\n\ts_barrier":::"memory");
  #undef DMA_K
  #undef DMA_V
  #undef CMASK
  #undef START
  #undef RESC
  #undef ROT
}
constexpr int ATTN_LDS_BYTES=LDS_BYTES;
struct AttnTensors { const bf16* Q; const bf16* K; const bf16* V; bf16* O; const bf16* Z; };
struct AttnUnit { int b; int h; int qb; };
template<int THRL=8> __device__ __forceinline__ void attn_phase(char*lds,const AttnTensors&T,int vcu,int G,const int wave_id,const bool st_){
  const int x=vcu>>5,c=vcu&31;
  #pragma unroll 1
  for(int i=0;i<6;++i){ const int pair=x*3+(i>>1),u=(i&1)*32+c; attn_unit<THRL>(pair>>1,(pair&1)*4+(u>>4),u&15,T.Q,T.K,T.V,T.O,T.Z,lds,wave_id,st_); }
}
#undef SBAR
#undef WAIT_BAR
}
constexpr int NWAVES = 8;
constexpr int DM_ = 1024, DEPTH = 4, SEQ_ = 4096, MTOT = 98304, MH = 49152, NPROMPT = 65536, PITCH = 3840, NIN = 5888, PLE = 256;
constexpr int C_QA = 0, C_KA = 512, C_VA = 640, C_ZA = 768, C_QB = 1280, C_KB = 2048, C_VB = 2816, C_ZB = 3584, C_GA = 3840, C_GB = 4864;
constexpr size_t MiB = 1u << 20;
constexpr size_t WS_SS = 0;
constexpr size_t WS_TAX = 4 * MiB;
constexpr size_t WS_T1D = 4 * MiB + 65536;
constexpr size_t WS_BAR = 6 * MiB, BAR_BYTES = 16384;
constexpr size_t WS_W = 8 * MiB;
constexpr size_t WL_IN = 0, WL_A = (size_t)5888 * 1024 * 2, WL_B = WL_A + 1 * MiB, WL_O = WL_B + MiB / 2, WL_PGC = WL_O + 2 * MiB  , WL_STRIDE = WL_PGC + 2 * MiB + MiB / 2;
constexpr size_t WS_LSE = 80 * MiB;
constexpr size_t WS_BUFA = 132 * MiB;
constexpr size_t WS_PROJ = 228 * MiB;
constexpr size_t WS_GQ8 = 588 * MiB;
constexpr size_t WS_ACAT = 684 * MiB;
constexpr size_t WS_GSCR = 804 * MiB;
constexpr size_t WS_XCAT = 820 * MiB;
constexpr size_t WS_LO = 892 * MiB;
constexpr size_t WS_END = 988 * MiB;
static_assert(WS_W + 4 * WL_STRIDE <= WS_LSE, "weights");
constexpr int LDS_BYTES = 147456;
#define LAS __attribute__((address_space(3)))
typedef unsigned short bf16;
typedef unsigned v4u __attribute__((ext_vector_type(4)));
typedef float f32x4 __attribute__((ext_vector_type(4)));
typedef float f32x16 __attribute__((ext_vector_type(16)));
typedef short bf16x8 __attribute__((ext_vector_type(8)));
typedef short s16x4 __attribute__((ext_vector_type(4)));
typedef float f32x2 __attribute__((ext_vector_type(2)));
__device__ __forceinline__ unsigned f2bf(float f) { unsigned u = __builtin_bit_cast(unsigned, f); return (u + 0x7fffu + ((u >> 16) & 1u)) >> 16; }
__device__ __forceinline__ unsigned pk2(float lo, float hi) { return f2bf(lo) | (f2bf(hi) << 16); }
__device__ __forceinline__ float blo(unsigned w) { return __uint_as_float(w << 16); }
__device__ __forceinline__ float bhi(unsigned w) { return __uint_as_float(w & 0xffff0000u); }
__device__ __forceinline__ float wave_sum(float v, int lane) {
#pragma unroll
    for (int o = 1; o < 64; o <<= 1) v += shx(v, lane, o);
    return v;
}
constexpr float C2F = 0.125f * 1.4426950408889634f;

#ifndef PROBE_P1
#define PROBE_P1 0
#endif
#ifndef PROBE_AA
#define PROBE_AA 0
#endif
#ifndef PROBE_AB
#define PROBE_AB 0
#endif
#ifndef PROBE_P2
#define PROBE_P2 0
#endif
#ifndef PROBE_P4
#define PROBE_P4 0
#endif
#ifndef PROBE_P5
#define PROBE_P5 0
#endif
#ifndef PROBE_P6
#define PROBE_P6 0
#endif
#ifndef PROBE_P7
#define PROBE_P7 0
#endif
#ifndef PROBE_SYNC
#define PROBE_SYNC 0
#endif
#define GSYNC() do { xcd_barrier(xbar); if (PROBE_SYNC) xcd_barrier(xbar); } while (0)
#ifndef STAG1
#define STAG1 110
#endif
__device__ __forceinline__ void stagger_wait(unsigned ticks) { const unsigned long long t0 = __builtin_amdgcn_s_memrealtime(); while (__builtin_amdgcn_s_memrealtime() - t0 < ticks) __builtin_amdgcn_s_sleep(4); }
struct Args { const float* in[15]; float* out; unsigned char* ws; };

template <bool HEADPERM> __device__ __forceinline__ void transpose_item(const float* W, int K, int N, bf16* WT, int ldw, LAS float* scr, int item, int lane, const float* gs = nullptr) {
    const int nblk = N / 32, kb = item / nblk, nb = item % nblk, k0 = 64 * kb, n0 = 32 * nb;
    { f32x4 wv[8];
#pragma unroll
      for (int i = 0; i < 8; ++i) { const int idx = lane + 64 * i, kk = idx >> 3, c4 = idx & 7; wv[i] = __builtin_nontemporal_load((const f32x4*)(W + (size_t)(k0 + kk) * N + n0 + 4 * c4)); }
#pragma unroll
      for (int i = 0; i < 8; ++i) { const int idx = lane + 64 * i, kk = idx >> 3, c4 = idx & 7; const float g_ = gs ? gs[k0 + kk] : 1.f;
          LAS float* d = scr + kk * 33 + 4 * c4; d[0] = wv[i].x * g_; d[1] = wv[i].y * g_; d[2] = wv[i].z * g_; d[3] = wv[i].w * g_; } }
    asm volatile("s_waitcnt lgkmcnt(0)" ::: "memory");
    const int c = lane & 7;
#pragma unroll
    for (int j = 0; j < 4; ++j) { const int n = (lane >> 3) + 8 * j; const LAS float* s = scr + (8 * c) * 33 + n;
        v4u o; o.x = pk2(s[0 * 33], s[1 * 33]); o.y = pk2(s[2 * 33], s[3 * 33]); o.z = pk2(s[4 * 33], s[5 * 33]); o.w = pk2(s[6 * 33], s[7 * 33]);
        int nr = n0 + n; if (HEADPERM) { const int w_ = nr & 255; nr = (nr & ~255) + ((w_ >> 5) & 1) * 128 + (w_ >> 6) * 32 + (w_ & 31); }
        *(v4u*)(WT + (size_t)nr * ldw + k0 + 8 * c) = o; }
    asm volatile("s_waitcnt lgkmcnt(0)" ::: "memory");
}

__device__ __forceinline__ int crow(int r, int hi) { return (r & 3) + 8 * (r >> 2) + 4 * hi; }
__device__ __forceinline__ s16x4 vtr(const LAS char* p) { typedef short v4i16_t __attribute__((ext_vector_type(4))); return __builtin_bit_cast(s16x4, __builtin_amdgcn_ds_read_tr16_b64_v4i16((LAS v4i16_t*)p)); }
__device__ __forceinline__ unsigned cvtpk(float lo, float hi) { typedef __bf16 bf16x2_t __attribute__((ext_vector_type(2))); f32x2 v = {lo, hi}; bf16x2_t b = __builtin_convertvector(v, bf16x2_t); return __builtin_bit_cast(unsigned, b); }
constexpr int AB_KIMG = 0, AB_VIMG = 384 * 144, AB_WST = AB_VIMG + 12 * 4096, AB_LDS = AB_WST + 8 * 4352;
static_assert(AB_LDS <= 143360, "branch-B LDS map");
struct AbRegs { v4u kk[6], vv[6]; bf16x8 qf[4]; };
__device__ __forceinline__ void attnb_load(AbRegs& R, const bf16* P, int b, int hb, int blk, const int wave) {
    const int lane = lane_now(); const int tid = wave * 64 + lane;
    const int g = hb >> 2, sh = 2 * g, L = 4096 >> sh, bprs = 4 - sh;
    const int r = blk >> bprs, M0 = 256 * (blk & ((1 << bprs) - 1));
    const int r32 = lane & 31, hi = lane >> 5;
    const size_t rowbase = (size_t)b * 4096;
#pragma unroll
    for (int s = 0; s < 6; ++s) { const int idx = tid + 512 * s, key = idx >> 3, c = idx & 7; int mk = M0 - 64 + key; mk = mk < 0 ? 0 : (mk > L - 1 ? L - 1 : mk);
        const bf16* rp = P + (rowbase + r + (mk << sh)) * PITCH + hb * 64 + c * 8; R.kk[s] = *(const v4u*)(rp + C_KB); R.vv[s] = *(const v4u*)(rp + C_VB); }
    const int tq = r + ((M0 + 32 * wave + r32) << sh);
    const bf16* qp = P + (rowbase + tq) * PITCH + C_QB + hb * 64 + hi * 8;
#pragma unroll
    for (int d0 = 0; d0 < 4; ++d0) R.qf[d0] = *(const bf16x8*)(qp + d0 * 16);
}
__device__ __forceinline__ void attnb_wg_unit(AbRegs& R, bf16* P, float* LSE, int b, int hb, int blk, bool has_next, int nb, int nhb, int nblk, LAS char* lds_in, const int wave, const bool st_) {
    const int lane = lane_now(); unsigned ldu = (unsigned)(uintptr_t)lds_in; asm volatile("" : "+v"(ldu)); LAS char* lb = (LAS char*)(uintptr_t)ldu;
    const int tid = wave * 64 + lane;
    const int g = hb >> 2, sh = 2 * g, L = 4096 >> sh, bprs = 4 - sh;
    const int r = blk >> bprs, M0 = 256 * (blk & ((1 << bprs) - 1));
    const int r32 = lane & 31, hi = lane >> 5;
    const size_t rowbase = (size_t)b * 4096;
    const int m0 = M0 + 32 * wave;
    const int tq = r + ((m0 + r32) << sh);
#pragma unroll
    for (int s = 0; s < 6; ++s) { const int idx = tid + 512 * s, key = idx >> 3, c = idx & 7;
        *(LAS v4u*)(lb + AB_KIMG + key * 144 + c * 16) = R.kk[s];
        *(LAS v4u*)(lb + AB_VIMG + (key >> 5) * 4096 + (c >> 2) * 2048 + ((key & 31) >> 3) * 512 + (key & 7) * 64 + (c & 3) * 16) = R.vv[s]; }
    bf16x8 qf[4];
#pragma unroll
    for (int d0 = 0; d0 < 4; ++d0) qf[d0] = R.qf[d0];
    __syncthreads();
    if (has_next) attnb_load(R, P, nb, nhb, nblk, wave);
    f32x16 S[5];
#pragma unroll
    for (int kb = 0; kb < 5; ++kb) {
        const LAS char* kp = lb + AB_KIMG + (32 * wave + 32 * kb + r32) * 144 + hi * 16;
        f32x16 s = {};
#pragma unroll
        for (int d0 = 0; d0 < 4; ++d0) s = __builtin_amdgcn_mfma_f32_32x32x16_bf16(*(const LAS bf16x8*)(kp + d0 * 32), qf[d0], s, 0, 0, 0);
        S[kb] = s;
    }
    const int mq = m0 + r32; float mx = -INFINITY;
    if (m0 >= 64 && m0 + 96 <= L) {
        const int rr = r32 - 4 * hi;
#pragma unroll
        for (int q = 0; q < 16; ++q) { const int ck = (q & 3) + 8 * (q >> 2);
            const float v0 = (ck >= rr) ? S[0][q] : -INFINITY, v4 = (ck <= rr) ? S[4][q] : -INFINITY; S[0][q] = v0; S[4][q] = v4;
            mx = fmaxf(mx, fmaxf(fmaxf(v0, v4), fmaxf(S[1][q], fmaxf(S[2][q], S[3][q])))); }
    } else {
#pragma unroll
        for (int kb = 0; kb < 5; ++kb)
#pragma unroll
            for (int q = 0; q < 16; ++q) { const int mk = m0 - 64 + 32 * kb + crow(q, hi); const int dd = mk - mq; const bool ok = (mk >= 0) && (mk < L) && (dd <= 64) && (dd >= -64);
                const float v = ok ? S[kb][q] : -INFINITY; S[kb][q] = v; mx = fmaxf(mx, v); }
    }
    mx = fmaxf(mx, shx(mx, lane, 32));
    float l = 0.f;
#pragma unroll
    for (int kb = 0; kb < 5; ++kb)
#pragma unroll
        for (int q = 0; q < 16; ++q) { const float p = __builtin_amdgcn_exp2f(S[kb][q] - mx); S[kb][q] = p; l += p; }
    l += shx(l, lane, 32);
    f32x16 o0 = {}, o1 = {};
    const LAS char* vrd = lb + AB_VIMG + wave * 4096 + ((lane >> 4) & 1) * 32 + (lane & 3) * 8 + (4 * hi + ((lane & 15) >> 2)) * 64;
#pragma unroll
    for (int kb = 0; kb < 5; ++kb)
#pragma unroll
        for (int s = 0; s < 2; ++s) {
            v4u pw; pw.x = cvtpk(S[kb][8 * s + 0], S[kb][8 * s + 1]); pw.y = cvtpk(S[kb][8 * s + 2], S[kb][8 * s + 3]); pw.z = cvtpk(S[kb][8 * s + 4], S[kb][8 * s + 5]); pw.w = cvtpk(S[kb][8 * s + 6], S[kb][8 * s + 7]);
            const bf16x8 pa = __builtin_bit_cast(bf16x8, pw);
            { const s16x4 lo = vtr(vrd + kb * 4096 + (2 * s) * 512), hh = vtr(vrd + kb * 4096 + (2 * s + 1) * 512);
              const bf16x8 vf = (bf16x8){lo[0], lo[1], lo[2], lo[3], hh[0], hh[1], hh[2], hh[3]};
              o0 = __builtin_amdgcn_mfma_f32_32x32x16_bf16(pa, vf, o0, 0, 0, 0); }
            { const s16x4 lo = vtr(vrd + kb * 4096 + 2048 + (2 * s) * 512), hh = vtr(vrd + kb * 4096 + 2048 + (2 * s + 1) * 512);
              const bf16x8 vf = (bf16x8){lo[0], lo[1], lo[2], lo[3], hh[0], hh[1], hh[2], hh[3]};
              o1 = __builtin_amdgcn_mfma_f32_32x32x16_bf16(pa, vf, o1, 0, 0, 0); }
        }
    LAS char* wl = lb + AB_WST + wave * 4352;
    LAS float* wsf = (LAS float*)(wl + 4096);
    if (hi == 0) { wsf[r32] = l; if (st_) LSE[(rowbase + tq) * 12 + hb] = mx + __builtin_amdgcn_logf(l); }
    asm volatile("s_waitcnt lgkmcnt(0)" ::: "memory");
    LAS bf16* stg = (LAS bf16*)wl;
#pragma unroll
    for (int q = 0; q < 16; ++q) { const int orow = crow(q, hi); const float rl = __builtin_amdgcn_rcpf(wsf[orow]);
        stg[orow * 64 + r32] = (bf16)f2bf(o0[q] * rl); stg[orow * 64 + 32 + r32] = (bf16)f2bf(o1[q] * rl); }
    asm volatile("s_waitcnt lgkmcnt(0)" ::: "memory");
#pragma unroll
    for (int i = 0; i < 4; ++i) { const int row = i * 8 + (lane >> 3), ch = lane & 7; const v4u v = *(const LAS v4u*)(wl + row * 128 + ch * 16);
        if (st_) *(v4u*)(P + (rowbase + r + ((m0 + row) << sh)) * PITCH + C_QB + hb * 64 + ch * 8) = v; }
    asm volatile("s_waitcnt lgkmcnt(0)" ::: "memory");
    __syncthreads();
}

#define XB_TMO      128
#define XB_XCNT(j)  (256  + 64 * (j))
#define XB_XSUB(j)  (1280 + 64 * (j))
#define XB_XGEN(j)  (2304 + 64 * (j))
#define XB_TOP      3328
#define XB_TOPGEN   3392
#define XCD_BAR_WORDS 3456
#define XB_SPIN_CAP (1u << 18)

__device__ __forceinline__ unsigned xb_ld(unsigned* p)              { return __hip_atomic_load(p, __ATOMIC_RELAXED, __HIP_MEMORY_SCOPE_AGENT); }
__device__ __forceinline__ unsigned xb_add(unsigned* p, unsigned v) { return __hip_atomic_fetch_add(p, v, __ATOMIC_RELAXED, __HIP_MEMORY_SCOPE_AGENT); }
__device__ __forceinline__ unsigned xb_xcc_id() { return (unsigned)__builtin_amdgcn_s_getreg((3 << 11) | 20) & 0xFu; }
#define XB_SPIN(cond, bar) do { unsigned _sp = 0; while (cond) { __builtin_amdgcn_s_sleep(1); \
    if ((++_sp & 255u) == 0u) { if (xb_ld(&(bar)[XB_TMO])) break; if (_sp > XB_SPIN_CAP) { atomicAdd(&(bar)[XB_TMO], 1u); break; } } } } while (0)

struct XcdBarrier {
    unsigned* bar; unsigned x;
    volatile LAS unsigned* st;
};

__device__ __forceinline__ XcdBarrier xcd_barrier_post(unsigned* bar, volatile LAS unsigned* st) {
    XcdBarrier b; b.bar = bar; b.x = xb_xcc_id(); b.st = st;
    if (threadIdx.x == 0) (void)xb_add(&bar[XB_XCNT(b.x)], 1u);
    return b;
}
__device__ __forceinline__ void xcd_barrier_complete(unsigned* bar, unsigned x, unsigned& nloc, unsigned& nx) {
    const unsigned G = gridDim.x * gridDim.y * gridDim.z;
    unsigned sum, cnt, mine, sp = 0u;
    for (;;) {
        sum = 0u; cnt = 0u; mine = 0u;
#pragma unroll
        for (unsigned j = 0; j < 16; ++j) { const unsigned c = xb_ld(&bar[XB_XCNT(j)]); sum += c; cnt += (c > 0u) ? 1u : 0u; mine = (j == x) ? c : mine; }
        if (sum == G) break;
        __builtin_amdgcn_s_sleep(1);
        if ((++sp & 255u) == 0u) { if (xb_ld(&bar[XB_TMO])) break; if (sp > XB_SPIN_CAP) { atomicAdd(&bar[XB_TMO], 1u); break; } }
    }
    nloc = mine > 0u ? mine : 1u; nx = cnt > 0u ? cnt : 1u;
}

__device__ __forceinline__ void xcd_barrier(const XcdBarrier& b) {
    asm volatile("s_waitcnt vmcnt(0)" ::: "memory");
    __syncthreads();
    if (threadIdx.x == 0) {
        unsigned* bar = b.bar;
        __builtin_amdgcn_s_waitcnt(0);
        unsigned nloc = b.st[0], nx = b.st[1];
        if (nloc == 0u) { xcd_barrier_complete(bar, b.x, nloc, nx); b.st[0] = nloc; b.st[1] = nx; }
        const unsigned old = xb_add(&bar[XB_XSUB(b.x)], 1u);
        const unsigned gen = old / nloc;
        if (old + 1u == (gen + 1u) * nloc) {
            __builtin_amdgcn_fence(__ATOMIC_RELEASE, "agent");
            asm volatile("s_waitcnt vmcnt(0)" ::: "memory");
            const unsigned og = xb_add(&bar[XB_TOP], 1u);
            const unsigned tg = og / nx;
            if (og + 1u == (tg + 1u) * nx) xb_add(&bar[XB_TOPGEN], 1u);
            else XB_SPIN(xb_ld(&bar[XB_TOPGEN]) == tg, bar);
            __builtin_amdgcn_fence(__ATOMIC_ACQUIRE, "agent");
            xb_add(&bar[XB_XGEN(b.x)], 1u);
            asm volatile("s_waitcnt vmcnt(0)" ::: "memory");
        } else {
            XB_SPIN(xb_ld(&bar[XB_XGEN(b.x)]) == gen, bar);
            __builtin_amdgcn_fence(__ATOMIC_ACQUIRE, "agent");
            asm volatile("s_waitcnt vmcnt(0)" ::: "memory");
        }
    }
    __syncthreads();
}

__global__ void __launch_bounds__(NWAVES * 64, 2) fwd_mega(Args args) {
    extern __shared__ __attribute__((aligned(16))) unsigned char lds[];
    cg::grid_group grid = cg::this_grid();
    LAS unsigned char* ldsl = (LAS unsigned char*)lds;
    const int wave = __builtin_amdgcn_readfirstlane(threadIdx.x >> 6); int tidv = wave * 64 + lane_now();
#define LAUNDER() do { tidv = wave * 64 + lane_now(); asm volatile("" : "+s"(bxv)); } while (0)
#define lane (tidv & 63)
#define gt (bx * (NWAVES * 64) + tidv)
    const int G = gridDim.x; int bxv = blockIdx.x; asm volatile("" : "+s"(bxv));
#define bx bxv
#define vcu ((bxv % 8) * (G / 8) + bxv / 8)
#define gw (vcu * NWAVES + wave)
    const int NGW = G * NWAVES;
    const int NGT = G * NWAVES * 64;
    unsigned char* ws = args.ws;
    const float* x_prompt = args.in[0]; const float* x_sample = args.in[1]; const float* p_prompt = args.in[2]; const float* p_sample = args.in[3];
    const float* g_norm = args.in[4]; const float* w_in = args.in[5]; const float* g_q = args.in[6]; const float* g_k = args.in[7];
    const float* w_a = args.in[8]; const float* w_b = args.in[9]; const float* w_o = args.in[10]; const float* w_ple = args.in[11];
    const float* g_ple = args.in[12]; const float* w_pg = args.in[13]; const float* g_final = args.in[14];
    float* H = args.out;
    const bool never = (args.ws == nullptr);
    float* SS = (float*)(ws + WS_SS);
    f32x2* TAX = (f32x2*)(ws + WS_TAX); f32x2* T1D = (f32x2*)(ws + WS_T1D);
    float* LSE = (float*)(ws + WS_LSE);
    bf16* XCAT = (bf16*)(ws + WS_XCAT); bf16* HI0 = (bf16*)(ws + WS_BUFA); bf16* PROJ = (bf16*)(ws + WS_PROJ); bf16* MRG = PROJ; bf16* LO = (bf16*)(ws + WS_LO);
    bf16* ACAT = (bf16*)(ws + WS_ACAT); unsigned* GSCR = (unsigned*)(ws + WS_GSCR); unsigned char* GQ8 = ws + WS_GQ8;

    volatile LAS unsigned* bst = (volatile LAS unsigned*)(ldsl + 143360);
    if (threadIdx.x < 2) bst[threadIdx.x] = 0u;
    __syncthreads();
    XcdBarrier xbar; xbar.bar = (unsigned*)(ws + WS_BAR); xbar.x = 0; xbar.st = bst;
    if (blockIdx.x == 0) for (int i = threadIdx.x; i < (int)(BAR_BYTES / 4); i += NWAVES * 64) ((unsigned*)(ws + WS_BAR))[i] = 0u;
    for (int i = gt + MTOT / 4; i < 9 * MTOT / 4; i += NGT) ((f32x4*)SS)[i] = (f32x4){0.f, 0.f, 0.f, 0.f};
    for (int i = gt; i < 64 * 16 + 4096 * 32; i += NGT) {
        int pos, k; float ex; f32x2* dst;
        if (i < 1024) { pos = i >> 4; k = i & 15; ex = (float)(2 * k) / 32.f; dst = TAX + i; }
        else { const int j = i - 1024; pos = j >> 5; k = j & 31; ex = (float)(2 * k) / 64.f; dst = T1D + j; }
        const float freq = exp2f(-ex * 13.287712379549449f);
        double rev = (double)pos * (double)freq * 0.15915494309189535; rev -= floor(rev);
        const float rf = (float)rev;
        *dst = (f32x2){__builtin_amdgcn_cosf(rf), __builtin_amdgcn_sinf(rf)};
    }
    {
        LAS float* scr = (LAS float*)(ldsl + wave * 16384);
        constexpr int I_IN = 16 * 184, I_A = 8 * 32, I_B = 4 * 32, I_O = 16 * 32, I_PLE = 4 * 32, I_PG = 16 * 32, I_L = I_IN + I_A + I_B + I_O + I_PLE + I_PG;
        for (int it = gw; it < DEPTH * I_L; it += NGW) {
            const int layer = it / I_L; int r = it % I_L; unsigned char* wl = ws + WS_W + (size_t)layer * WL_STRIDE;
            if (r < I_IN) { transpose_item<true>(w_in + (size_t)layer * 1024 * 5888, 1024, 5888, (bf16*)(wl + WL_IN), 1024, scr, r, lane, g_norm + layer * 1024); continue; } r -= I_IN;
            if (r < I_A) { transpose_item<false>(w_a + (size_t)layer * 512 * 1024, 512, 1024, (bf16*)(wl + WL_A), 768, scr, r, lane); continue; } r -= I_A;
            if (r < I_B) { transpose_item<false>(w_b + (size_t)layer * 256 * 1024, 256, 1024, (bf16*)(wl + WL_A) + 512, 768, scr, r, lane); continue; } r -= I_B;
            if (r < I_O) { transpose_item<false>(w_o + (size_t)layer * 1024 * 1024, 1024, 1024, (bf16*)(wl + WL_O), 1024, scr, r, lane); continue; } r -= I_O;
            if (r < I_PLE) { transpose_item<false>(w_ple + (size_t)layer * 256 * 1024, 256, 1024, (bf16*)(wl + WL_PGC) + 1024, 1280, scr, r, lane); continue; } r -= I_PLE;
            transpose_item<false>(w_pg + (size_t)layer * 1024 * 1024, 1024, 1024, (bf16*)(wl + WL_PGC), 1280, scr, r, lane, g_ple + layer * 1024);
        }
    }

#pragma unroll 1
    for (int half = 0; half < 2; ++half) {
        const int grow0 = half * MH;
            LAUNDER();
        for (int lr0 = gw; lr0 < MH; lr0 += 2 * NGW) {
            f32x4 v[2][4]; const f32x4* xr[2];
#pragma unroll
            for (int k = 0; k < 2; ++k) { const int lr = lr0 + k * NGW < MH ? lr0 + k * NGW : lr0; const int gr = grow0 + lr;
                xr[k] = (const f32x4*)(gr < NPROMPT ? x_prompt + (size_t)gr * 1024 : x_sample + (size_t)(gr - NPROMPT) * 1024); }
#pragma unroll
            for (int k = 0; k < 2; ++k)
#pragma unroll
                for (int j = 0; j < 4; ++j) v[k][j] = __builtin_nontemporal_load(xr[k] + lane + 64 * j);
#pragma unroll
            for (int k = 0; k < 2; ++k) { const int lr = lr0 + k * NGW; if (lr < MH) { const int gr = grow0 + lr; float s = 0.f;
#pragma unroll
                for (int j = 0; j < 4; ++j) s += (v[k][j].x * v[k][j].x + v[k][j].y * v[k][j].y) + (v[k][j].z * v[k][j].z + v[k][j].w * v[k][j].w);
                s = wave_sum(s, lane); if (lane == 0) SS[gr] = s;
#pragma unroll
                for (int j = 0; j < 4; ++j) { const f32x4 x_ = v[k][j]; const unsigned h0 = pk2(x_.x, x_.y), h1 = pk2(x_.z, x_.w);
                    const unsigned l0 = pk2(x_.x - blo(h0), x_.y - bhi(h0)), l1 = pk2(x_.z - blo(h1), x_.w - bhi(h1));
                    ((unsigned long long*)(HI0 + (size_t)lr * 1024))[lane + 64 * j] = (unsigned long long)h0 | ((unsigned long long)h1 << 32);
                    ((unsigned long long*)(LO + (size_t)lr * 1024))[lane + 64 * j] = (unsigned long long)l0 | ((unsigned long long)l1 << 32); } } }
        }
        if (half == 0) { grid.sync(); xbar = xcd_barrier_post((unsigned*)(ws + WS_BAR), bst); } else GSYNC();
#pragma unroll 1
        for (int layer = 0; layer < DEPTH; ++layer) {
            unsigned char* wl = ws + WS_W + (size_t)layer * WL_STRIDE;
            LAUNDER();
            { pg8::Gemm g{HI0, (const bf16*)(wl + WL_IN), MH, NIN, 1024, 1024}; pg8::StaticOrder S; S.init(MH, NIN, G, bx);
              pg8::EpiProj E{PROJ, PITCH, SS + (size_t)layer * MTOT, grow0, g_q + layer * 64, g_k + layer * 64, (const pg8::f32x2e*)TAX, (const pg8::f32x2e*)T1D, GQ8};
#ifndef PROBE_P1K
#define PROBE_P1K 0
#endif
              if (PROBE_P1K) { LAUNDER(); pg8::EpiNull EN{}; pg8::gemm_phase<pg8::EpiNull, pg8::StaticOrder, true, true>(ldsl, g, S, EN, wave); }
              for (int rep_ = 0; rep_ < 1 + PROBE_P1; ++rep_) { LAUNDER(); pg8::gemm_phase<pg8::EpiProj, pg8::StaticOrder, true, true>(ldsl, g, S, E, wave); } }
            GSYNC();
            LAUNDER();
            { const attn_body::AttnTensors AT{(const attn_body::bf16*)(PROJ + C_QA), (const attn_body::bf16*)(PROJ + C_KA), (const attn_body::bf16*)(PROJ + C_VA), (attn_body::bf16*)XCAT, (const attn_body::bf16*)(PROJ + C_ZA)};
              for (int rep_ = PROBE_AA ? 0 : 1; rep_ < 2; ++rep_) { LAUNDER(); attn_body::attn_phase<8>((char*)lds, AT, vcu, G, wave, rep_ == 1 || never); } }
            __syncthreads();
            LAUNDER();
            { for (int rep_ = PROBE_AB ? 0 : 1; rep_ < 2; ++rep_) { LAUNDER();
              const int cx = vcu & 31, xq = vcu >> 5;
              AbRegs R; { const int pair = xq * 18 + (cx >> 4); attnb_load(R, PROJ, pair / 12, pair % 12, cx & 15, wave); }
#pragma unroll 1
              for (int i = 0; i < 9; ++i) { const int pair = xq * 18 + i * 2 + (cx >> 4); const int b = pair / 12, hb = pair - b * 12; const int np = pair + 2, nb = np / 12, nhb = np - nb * 12;
                  attnb_wg_unit(R, PROJ, LSE, b, hb, cx & 15, i < 8, nb, nhb, cx & 15, (LAS char*)ldsl, wave, rep_ == 1 || never); } } }
            GSYNC();
            LAUNDER();
            for (int rep_ = 0; rep_ < 1 + PROBE_P4; ++rep_) { LAUNDER();
            for (int it0 = gt; it0 < MH * 32; it0 += 4 * NGT) {
                v4u a[4], bq[4], cq[4], z[4]; float l0[4], l1[4], l2[4];
#pragma unroll
                for (int k = 0; k < 4; ++k) { const int it = it0 + k * NGT < MH * 32 ? it0 + k * NGT : it0; const int lr = it >> 5, cc = it & 31, hh = cc >> 3, c = cc & 7;
                    const bf16* rp = PROJ + (size_t)lr * PITCH;
                    a[k] = *(const v4u*)(rp + C_QB + hh * 64 + c * 8); bq[k] = *(const v4u*)(rp + C_QB + (4 + hh) * 64 + c * 8); cq[k] = *(const v4u*)(rp + C_QB + (8 + hh) * 64 + c * 8); z[k] = *(const v4u*)(rp + C_ZB + hh * 64 + c * 8);
                    l0[k] = LSE[(size_t)lr * 12 + hh]; l1[k] = LSE[(size_t)lr * 12 + 4 + hh]; l2[k] = LSE[(size_t)lr * 12 + 8 + hh]; }
#pragma unroll
                for (int k = 0; k < 4; ++k) { const int it = it0 + k * NGT; if (it < MH * 32) { const int lr = it >> 5, cc = it & 31;
                    const float mx = fmaxf(l0[k], fmaxf(l1[k], l2[k])); float w0 = __builtin_amdgcn_exp2f(l0[k] - mx), w1 = __builtin_amdgcn_exp2f(l1[k] - mx), w2 = __builtin_amdgcn_exp2f(l2[k] - mx);
                    const float inv = __builtin_amdgcn_rcpf(w0 + w1 + w2); w0 *= inv; w1 *= inv; w2 *= inv;
                    v4u o;
#pragma unroll
                    for (int e = 0; e < 4; ++e) { const float z0 = blo(z[k][e]), z1 = bhi(z[k][e]);
                        const float s0 = z0 * __builtin_amdgcn_rcpf(1.f + __expf(-z0)), s1 = z1 * __builtin_amdgcn_rcpf(1.f + __expf(-z1));
                        o[e] = pk2((w0 * blo(a[k][e]) + w1 * blo(bq[k][e]) + w2 * blo(cq[k][e])) * s0, (w0 * bhi(a[k][e]) + w1 * bhi(bq[k][e]) + w2 * bhi(cq[k][e])) * s1); }
                    *(v4u*)(XCAT + (size_t)lr * 768 + 512 + cc * 8) = o; } }
            } }
            LAUNDER();
            for (int it0 = gt; it0 < MH * 32; it0 += 4 * NGT) {
                f32x4 a[4], bq[4];
#pragma unroll
                for (int k = 0; k < 4; ++k) { const int it = it0 + k * NGT < MH * 32 ? it0 + k * NGT : it0; const int lr = it >> 5, c = it & 31, gr = grow0 + lr;
                    const float* pr = gr < NPROMPT ? p_prompt + ((size_t)layer * NPROMPT + gr) * PLE : p_sample + ((size_t)layer * (MTOT - NPROMPT) + (gr - NPROMPT)) * PLE;
                    a[k] = __builtin_nontemporal_load((const f32x4*)pr + 2 * c); bq[k] = __builtin_nontemporal_load((const f32x4*)pr + 2 * c + 1); }
#pragma unroll
                for (int k = 0; k < 4; ++k) { const int it = it0 + k * NGT; if (it < MH * 32) { const int lr = it >> 5, c = it & 31;
                    v4u o; o.x = pk2(a[k].x, a[k].y); o.y = pk2(a[k].z, a[k].w); o.z = pk2(bq[k].x, bq[k].y); o.w = pk2(bq[k].z, bq[k].w); *(v4u*)(ACAT + (size_t)lr * 1280 + 1024 + c * 8) = o; } }
            }
            GSYNC();
            LAUNDER();
            for (int rep_ = 0; rep_ < 1 + PROBE_P5; ++rep_) {
            LAUNDER();
            { LAS float* gtab = (LAS float*)(ldsl + 131072);
              if (tidv < 256) { const float ex_ = __expf(-((float)tidv * 0.0625f - 8.f)); gtab[tidv] = __builtin_amdgcn_rcpf(1.f + ex_); gtab[256 + tidv] = 1.f + ex_; }
              __syncthreads(); }
            { pg8::Gemm g{XCAT, (const bf16*)(wl + WL_A), MH, 1024, 768, 768}; pg8::StaticOrder S; S.init(MH, 1024, G, bx, true);
              pg8::EpiMerge E{MRG, 1024, GQ8, (const LAS float*)(ldsl + 131072)};
              pg8::gemm_phase<pg8::EpiMerge, pg8::StaticOrder, true, true>(ldsl, g, S, E, wave); } }
            GSYNC();
            LAUNDER();
            for (int rep_ = PROBE_P6 ? 0 : 1; rep_ < 2; ++rep_) {
            LAUNDER();
            { pg8::Gemm g{MRG, (const bf16*)(wl + WL_O), MH, 1024, 1024, 1024}; pg8::StaticOrder S; S.init(MH, 1024, G, bx);
              pg8::EpiMix E{HI0, 1024, LO, ACAT, 1280, SS + (size_t)(5 + layer) * MTOT, grow0, rep_ == 1 || never};
              pg8::gemm_phase<pg8::EpiMix, pg8::StaticOrder, true, true>(ldsl, g, S, E, wave); }
            }
            GSYNC();
            LAUNDER();
            for (int rep_ = PROBE_P7 ? 0 : 1; rep_ < 2; ++rep_) {
            LAUNDER();
            { pg8::Gemm g{ACAT, (const bf16*)(wl + WL_PGC), MH, 1024, 1280, 1280}; pg8::StaticOrder S; S.init(MH, 1024, G, bx, true);
              pg8::EpiPle E{ACAT, 1280, LO, layer < DEPTH - 1 ? HI0 : nullptr, H, SS + (size_t)(5 + layer) * MTOT, SS + (size_t)(layer + 1) * MTOT, grow0, GSCR + (size_t)bx * (32 * 512), rep_ == 1 || never};
              pg8::gemm_phase<pg8::EpiPle, pg8::StaticOrder, true, true>(ldsl, g, S, E, wave); } }
            GSYNC();
        }
        LAUNDER();
        for (int lr0 = gw; lr0 < MH; lr0 += 4 * NGW) {
            f32x4 v[4][4]; float rs[4];
#pragma unroll
            for (int k = 0; k < 4; ++k) { const int gr = grow0 + (lr0 + k * NGW < MH ? lr0 + k * NGW : lr0); rs[k] = SS[(size_t)4 * MTOT + gr];
#pragma unroll
                for (int j = 0; j < 4; ++j) v[k][j] = ((const f32x4*)(H + (size_t)gr * 1024))[lane + 64 * j]; }
#pragma unroll
            for (int k = 0; k < 4; ++k) { const int lr = lr0 + k * NGW; if (lr < MH) { const int gr = grow0 + lr; const float r_ = __builtin_amdgcn_rsqf(rs[k] * (1.f / 1024.f) + 1e-6f);
#pragma unroll
                for (int j = 0; j < 4; ++j) { const f32x4 gg = ((const f32x4*)g_final)[lane + 64 * j]; __builtin_nontemporal_store(v[k][j] * gg * r_, (f32x4*)(H + (size_t)gr * 1024) + lane + 64 * j); } } }
        }
    }
}

#undef lane
#undef gt
#undef bx
#undef vcu
#undef gw
extern "C" void kernel_launch(void* const* d_in, const int* in_sizes, int n_in, void* d_out, int out_size, void* d_ws, size_t ws_size, hipStream_t stream) {
    static int grid = 0;
    if (grid == 0) {
        if (n_in != 15 || out_size != MTOT * DM_ || ws_size < WS_END) { fprintf(stderr, "kernel_launch: unexpected shapes (n_in %d out %d ws %zu)\n", n_in, out_size, ws_size); grid = -1; return; }
        int dev = 0, cus = 0, per_cu = 0;
        (void)hipGetDevice(&dev); (void)hipDeviceGetAttribute(&cus, hipDeviceAttributeMultiprocessorCount, dev);
        (void)hipFuncSetAttribute((const void*)fwd_mega, hipFuncAttributeMaxDynamicSharedMemorySize, LDS_BYTES);
        (void)hipOccupancyMaxActiveBlocksPerMultiprocessor(&per_cu, (const void*)fwd_mega, NWAVES * 64, LDS_BYTES);
        if (per_cu < 1) per_cu = 1;
        grid = cus * per_cu;
        (void)hipGetLastError();
    }
    if (grid < 0) return;
    Args a{};
    for (int i = 0; i < 15; ++i) a.in[i] = (const float*)d_in[i];
    a.out = (float*)d_out; a.ws = (unsigned char*)d_ws;
    void* kargs[] = {&a};
    hipError_t e = hipLaunchCooperativeKernel((const void*)fwd_mega, dim3(grid), dim3(NWAVES * 64), kargs, LDS_BYTES, stream);
    if (e != hipSuccess) fprintf(stderr, "cooperative launch failed: %s (grid %d)\n", hipGetErrorString(e), grid);
}
```
